# Optimizing an MI355X kernel written in HIP

```python
import math
import jax, jax.numpy as jnp
from jax import lax
import numpy as np


D_MODEL = 1024
BATCH = 2
SEQ = 16384
DEPTH = 2

BLOCK = 128
EPS = 1e-6
SB_HEADS = 4
SB_DIM = 64
SB_SUB = 32
MLA_HEADS = 4
MLA_Q_RANK = 256
MLA_KV_RANK = 256
MLA_NOPE = 64
MLA_ROPE = 32
MLA_V = 64
ROPE_THETA = 10000.0
SW_Q_HEADS = 8
SW_KV_HEADS = 2
SW_DIM = 32
SW_WINDOW = 128
DIL_PATTERNS = ((128, 1), (512, 4), (2048, 16))
DIL_HEADS = 4
DIL_DIM = 32
REL_BUCKETS = 32
REL_MAX_DIST = 2048
GATE_RANK = 128
N_BRANCH = 4
D_FF_DENSE = 2048
N_EXPERTS = 8
TOP_K = 2
D_FF_EXPERT = 768
MOE_BLOCK = 512

SB_W = SB_HEADS * SB_DIM
MLA_QK = MLA_NOPE + MLA_ROPE
SW_W = SW_Q_HEADS * SW_DIM
SW_KV_W = SW_KV_HEADS * SW_DIM
N_DIL = len(DIL_PATTERNS)
DIL_W = N_DIL * DIL_HEADS * DIL_DIM
REL_HEADS = SW_Q_HEADS + N_DIL * DIL_HEADS
IN_SIZES = (SB_W, SB_W, SB_W, MLA_Q_RANK, MLA_KV_RANK, MLA_ROPE, SW_W, SW_KV_W, SW_KV_W, DIL_W, DIL_W, DIL_W)
IN_COLS = sum(IN_SIZES)
BR_SIZES = (SB_W, MLA_HEADS * MLA_V, SW_W, DIL_HEADS * DIL_DIM)
BR_ROWS = sum(BR_SIZES)

kernel_name = 'hybrid_parallel_gated_mixers_moe'


def rmsnorm(x, g):
    xf = x.astype(jnp.float32)
    y = xf * lax.rsqrt(jnp.mean(xf * xf, axis=-1, keepdims=True) + EPS)
    return (y * g.astype(jnp.float32)).astype(x.dtype)


def rope(x, pos):
    half = x.shape[-1] // 2
    inv = ROPE_THETA ** (-jnp.arange(half, dtype=jnp.float32) / half)
    ang = pos[:, None] * inv[None, :]
    cos = jnp.cos(ang)[:, None, :]
    sin = jnp.sin(ang)[:, None, :]
    xf = x.astype(jnp.float32)
    x1, x2 = xf[..., :half], xf[..., half:]
    return jnp.concatenate([x1 * cos - x2 * sin, x2 * cos + x1 * sin], axis=-1).astype(x.dtype)


def t5_bucket(dist):
    max_exact = REL_BUCKETS // 2
    d = jnp.maximum(dist, 1).astype(jnp.float32)
    large = max_exact + (jnp.log(d / max_exact) / math.log(REL_MAX_DIST / max_exact) * (REL_BUCKETS - max_exact)).astype(jnp.int32)
    large = jnp.minimum(large, REL_BUCKETS - 1)
    return jnp.where(dist < max_exact, dist, large)


def stick_breaking_attention(q, k, v):
    B_, S, H, Dh = q.shape
    scale = Dh ** -0.5
    qf = q.astype(jnp.float32)
    kf = k.astype(jnp.float32)
    incl = (jnp.arange(SB_SUB)[:, None] >= jnp.arange(SB_SUB)[None, :]).astype(jnp.float32)
    outs = []
    for i in range(S // BLOCK):
        L = (i + 1) * BLOCK
        n_sub = L // SB_SUB
        z = jnp.einsum('bqhd,bkhd->bhqk', qf[:, i * BLOCK:L], kf[:, :L]) * scale
        mask = jnp.arange(L)[None, :] < (i * BLOCK + jnp.arange(BLOCK))[:, None]
        lk = jnp.where(mask, jax.nn.log_sigmoid(-z), 0.0)
        within = jnp.einsum('bhqnj,js->bhqns', lk.reshape(B_, H, BLOCK, n_sub, SB_SUB), incl)
        tot = within[..., 0]
        after = lax.cumsum(tot, axis=3, reverse=True) - tot
        later = (within + after[..., None]).reshape(B_, H, BLOCK, L) - lk
        a = jnp.where(mask, jnp.exp(jax.nn.log_sigmoid(z) + later), 0.0)
        outs.append(jnp.einsum('bhqk,bkhd->bqhd', a.astype(v.dtype), v[:, :L]))
    return jnp.concatenate(outs, axis=1).reshape(B_, S, H * Dh)


def causal_softmax_attention(q, k, v):
    B_, S, H, Dqk = q.shape
    scale = Dqk ** -0.5
    qf = q.astype(jnp.float32)
    kf = k.astype(jnp.float32)
    outs = []
    for i in range(S // BLOCK):
        L = (i + 1) * BLOCK
        s = jnp.einsum('bqhd,bkhd->bhqk', qf[:, i * BLOCK:L], kf[:, :L]) * scale
        mask = jnp.arange(L)[None, :] <= (i * BLOCK + jnp.arange(BLOCK))[:, None]
        p = jax.nn.softmax(jnp.where(mask, s, -jnp.inf), axis=-1)
        outs.append(jnp.einsum('bhqk,bkhd->bqhd', p.astype(v.dtype), v[:, :L]))
    out = jnp.concatenate(outs, axis=1)
    return out.reshape(B_, S, H * v.shape[-1])


def sliding_window_sink_attention(q, k, v, sinks, bias):
    B_, S, Hq, Dh = q.shape
    Hkv = k.shape[2]
    G = Hq // Hkv
    nb = S // BLOCK
    qb = q.reshape(B_, nb, BLOCK, Hkv, G, Dh).astype(jnp.float32)

    def band(t):
        tb = t.reshape(B_, nb, BLOCK, Hkv, Dh)
        prev = jnp.concatenate([jnp.zeros_like(tb[:, :1]), tb[:, :-1]], axis=1)
        return jnp.concatenate([prev, tb], axis=2)

    kb, vb = band(k), band(v)
    s = jnp.einsum('bnqkgd,bnskd->bnkgqs', qb, kb.astype(jnp.float32)) * (Dh ** -0.5)
    s = s + bias.reshape(Hkv, G, BLOCK, 2 * BLOCK).astype(jnp.float32)
    dist = (BLOCK + jnp.arange(BLOCK))[:, None] - jnp.arange(2 * BLOCK)[None, :]
    in_window = (dist >= 0) & (dist < SW_WINDOW)
    kvalid = (jnp.arange(nb)[:, None] * BLOCK + jnp.arange(2 * BLOCK)[None, :] - BLOCK) >= 0
    mask = in_window[None] & kvalid[:, None, :]
    s = jnp.where(mask[None, :, None, None], s, -jnp.inf)
    sink = sinks.astype(jnp.float32).reshape(Hkv, G)[None, None, :, :, None, None]
    m = jnp.maximum(jnp.max(s, axis=-1, keepdims=True), sink)
    p = jnp.exp(s - m)
    denom = jnp.sum(p, axis=-1, keepdims=True) + jnp.exp(sink - m)
    o = jnp.einsum('bnkgqs,bnskd->bnqkgd', (p / denom).astype(v.dtype), vb)
    return o.reshape(B_, S, Hq * Dh)


def dilated_group_attention(q, k, v, bias, window, dil):
    B_, S, H, Dh = q.shape
    M = S // dil
    nb = -(-M // BLOCK)
    Mp = nb * BLOCK
    jmax = window // dil

    def streams(t):
        t = t.astype(jnp.float32).reshape(B_, M, dil, H, Dh).transpose(0, 2, 1, 3, 4)
        t = jnp.pad(t, ((0, 0), (0, 0), (0, Mp - M), (0, 0), (0, 0)))
        return t.reshape(B_, dil, nb, BLOCK, H, Dh)

    def band(t):
        prev = jnp.concatenate([jnp.zeros_like(t[:, :, :1]), t[:, :, :-1]], axis=2)
        return jnp.concatenate([prev, t], axis=3)

    qs = streams(q)
    ks = band(streams(k))
    vs = band(streams(v))
    s = jnp.einsum('brnqhd,brnkhd->brnhqk', qs, ks) * (Dh ** -0.5) + bias.astype(jnp.float32)
    dist = (BLOCK + jnp.arange(BLOCK))[:, None] - jnp.arange(2 * BLOCK)[None, :]
    in_window = (dist >= 0) & (dist <= jmax)
    kvalid = (jnp.arange(nb)[:, None] * BLOCK + jnp.arange(2 * BLOCK)[None, :] - BLOCK) >= 0
    mask = in_window[None] & kvalid[:, None, :]
    s = jnp.where(mask[None, None, :, None], s, -jnp.inf)
    m = jnp.max(s, axis=-1, keepdims=True)
    p = jnp.exp(s - m)
    l = jnp.sum(p, axis=-1, keepdims=True)
    o = jnp.einsum('brnhqk,brnkhd->brnqhd', p / l, vs)
    lse = (m + jnp.log(l))[..., 0].transpose(0, 1, 2, 4, 3)
    o = o.reshape(B_, dil, Mp, H, Dh)[:, :, :M].transpose(0, 2, 1, 3, 4).reshape(B_, S, H, Dh)
    lse = lse.reshape(B_, dil, Mp, H)[:, :, :M].transpose(0, 2, 1, 3).reshape(B_, S, H)
    return o, lse


def dilated_mixture_attention(q, k, v, biases):
    B_, S, _, H, Dh = q.shape
    os_, lses = [], []
    for g, (w, dil) in enumerate(DIL_PATTERNS):
        o, lse = dilated_group_attention(q[:, :, g], k[:, :, g], v[:, :, g], biases[g], w, dil)
        os_.append(o)
        lses.append(lse)
    wgt = jax.nn.softmax(jnp.stack(lses), axis=0)
    out = jnp.sum(wgt[..., None] * jnp.stack(os_), axis=0)
    return out.reshape(B_, S, H * Dh).astype(v.dtype)


def mixer_sublayer(x, norm_g, w_in, g_qa, w_qb, g_kva, w_kvb, qk_g_mla, qk_g_sw, qk_g_dil, sinks, sw_bias, dil_biases, w_gate_a, w_gate_b, b_gate, w_branch, w_out):
    B_, S, D = x.shape
    h = rmsnorm(x, norm_g)
    proj = h @ w_in
    offs = np.cumsum(IN_SIZES)[:-1].tolist()
    (a_q, a_k, a_v, b_cq, b_ckv, b_kpe, c_q, c_k, c_v, d_q, d_k, d_v) = jnp.split(proj, offs, axis=-1)
    pos = jnp.arange(S, dtype=jnp.float32)

    sh = (B_, S, SB_HEADS, SB_DIM)
    out_a = stick_breaking_attention(a_q.reshape(sh), a_k.reshape(sh), a_v.reshape(sh))

    qm = (rmsnorm(b_cq, g_qa) @ w_qb).reshape(B_, S, MLA_HEADS, MLA_QK)
    q_mla = jnp.concatenate([qm[..., :MLA_NOPE], rope(qm[..., MLA_NOPE:], pos)], axis=-1)
    kv = (rmsnorm(b_ckv, g_kva) @ w_kvb).reshape(B_, S, MLA_HEADS, MLA_NOPE + MLA_V)
    k_pe = jnp.broadcast_to(rope(b_kpe[:, :, None, :], pos), (B_, S, MLA_HEADS, MLA_ROPE))
    k_mla = jnp.concatenate([kv[..., :MLA_NOPE], k_pe], axis=-1)
    q_mla = rmsnorm(q_mla, qk_g_mla[0])
    k_mla = rmsnorm(k_mla, qk_g_mla[1])
    out_b = causal_softmax_attention(q_mla, k_mla, kv[..., MLA_NOPE:])

    q_sw = rmsnorm(c_q.reshape(B_, S, SW_Q_HEADS, SW_DIM), qk_g_sw[0])
    k_sw = rmsnorm(c_k.reshape(B_, S, SW_KV_HEADS, SW_DIM), qk_g_sw[1])
    out_c = sliding_window_sink_attention(q_sw, k_sw, c_v.reshape(B_, S, SW_KV_HEADS, SW_DIM), sinks, sw_bias)

    dsh = (B_, S, N_DIL, DIL_HEADS, DIL_DIM)
    q_d = rmsnorm(d_q.reshape(dsh), qk_g_dil[0])
    k_d = rmsnorm(d_k.reshape(dsh), qk_g_dil[1])
    out_d = dilated_mixture_attention(q_d, k_d, d_v.reshape(dsh), dil_biases)

    g_low = h @ w_gate_a
    row_offs = np.concatenate([[0], np.cumsum(BR_SIZES)]).tolist()
    y = None
    for i, o in enumerate((out_a, out_b, out_c, out_d)):
        pre = g_low @ w_gate_b[:, i * D:(i + 1) * D] + b_gate[i * D:(i + 1) * D]
        gate = jax.nn.sigmoid(pre.astype(jnp.float32)).astype(x.dtype)
        term = gate * (o @ w_branch[row_offs[i]:row_offs[i + 1]])
        y = term if y is None else y + term
    return x + y @ w_out


def swiglu(h, w_gu, w_down):
    gu = h @ w_gu
    g, u = jnp.split(gu, 2, axis=-1)
    return (jax.nn.silu(g) * u) @ w_down


def moe_swiglu(h, w_router, b_router, w_gu, w_down):
    D = h.shape[-1]
    tok = h.reshape(-1, D)
    N = tok.shape[0]
    logits = (tok @ w_router).astype(jnp.float32) + b_router.astype(jnp.float32)
    top_val, top_idx = lax.top_k(logits, TOP_K)
    top_w = jax.nn.softmax(top_val, axis=-1)
    NK = N * TOP_K
    slot_e = top_idx.reshape(NK)
    slot_tok = jnp.arange(NK, dtype=jnp.int32) // TOP_K
    slot_w = top_w.reshape(NK)
    order = jnp.argsort(slot_e)
    sorted_e = slot_e[order]
    counts = jnp.zeros((N_EXPERTS,), jnp.int32).at[slot_e].add(1)
    padded = (counts + MOE_BLOCK - 1) // MOE_BLOCK * MOE_BLOCK
    pad_end = jnp.cumsum(padded)
    pad_start = pad_end - padded
    start = jnp.cumsum(counts) - counts
    dest = pad_start[sorted_e] + jnp.arange(NK, dtype=jnp.int32) - start[sorted_e]
    n_blk = -(-NK // MOE_BLOCK) + N_EXPERTS
    P = n_blk * MOE_BLOCK
    row_tok = jnp.zeros((P,), jnp.int32).at[dest].set(slot_tok[order])
    row_w = jnp.zeros((P,), jnp.float32).at[dest].set(slot_w[order])
    blk_start = jnp.arange(n_blk, dtype=jnp.int32) * MOE_BLOCK
    blk_e = jnp.minimum(jnp.sum((pad_end[None, :] <= blk_start[:, None]).astype(jnp.int32), axis=1), N_EXPERTS - 1)
    xs = tok[row_tok].reshape(n_blk, MOE_BLOCK, D)

    def expert_block(args):
        xb, e = args
        return swiglu(xb, w_gu[e], w_down[e])

    yb = lax.map(expert_block, (xs, blk_e)).reshape(P, D)
    y = jax.ops.segment_sum(yb * row_w[:, None].astype(yb.dtype), row_tok, num_segments=N)
    return y.reshape(h.shape)


def setup_inputs(seed: int = 0) -> dict:
    key = jax.random.key(seed)
    ks = jax.random.split(key, 26)
    f32 = jnp.float32

    def nrm(k, shape, scale):
        return jax.random.normal(k, shape, f32) * scale

    def gain(k, shape):
        return 1.0 + 0.05 * jax.random.normal(k, shape, f32)

    n_dense = (DEPTH + 1) // 2
    n_moe = DEPTH // 2
    row_scale = jnp.asarray(np.concatenate([np.full((s,), s ** -0.5, np.float32) for s in BR_SIZES]))
    return {
        'x': nrm(ks[0], (BATCH, SEQ, D_MODEL), 1.0),
        'norm1_g': gain(ks[1], (DEPTH, D_MODEL)),
        'w_in': nrm(ks[2], (DEPTH, D_MODEL, IN_COLS), D_MODEL ** -0.5),
        'g_qa': gain(ks[3], (DEPTH, MLA_Q_RANK)),
        'w_qb': nrm(ks[4], (DEPTH, MLA_Q_RANK, MLA_HEADS * MLA_QK), MLA_Q_RANK ** -0.5),
        'g_kva': gain(ks[5], (DEPTH, MLA_KV_RANK)),
        'w_kvb': nrm(ks[6], (DEPTH, MLA_KV_RANK, MLA_HEADS * (MLA_NOPE + MLA_V)), MLA_KV_RANK ** -0.5),
        'qk_g_mla': gain(ks[7], (DEPTH, 2, MLA_QK)),
        'qk_g_sw': gain(ks[8], (DEPTH, 2, SW_DIM)),
        'qk_g_dil': gain(ks[9], (DEPTH, 2, DIL_DIM)),
        'sinks': nrm(ks[10], (DEPTH, SW_Q_HEADS), 0.5),
        'rel_bias': nrm(ks[11], (REL_BUCKETS, REL_HEADS), 0.5),
        'w_gate_a': nrm(ks[12], (DEPTH, D_MODEL, GATE_RANK), D_MODEL ** -0.5),
        'w_gate_b': nrm(ks[13], (DEPTH, GATE_RANK, N_BRANCH * D_MODEL), GATE_RANK ** -0.5),
        'b_gate': nrm(ks[14], (DEPTH, N_BRANCH * D_MODEL), 0.02),
        'w_branch': nrm(ks[15], (DEPTH, BR_ROWS, D_MODEL), 1.0) * row_scale[None, :, None],
        'w_out': nrm(ks[16], (DEPTH, D_MODEL, D_MODEL), D_MODEL ** -0.5),
        'norm2_g': gain(ks[17], (DEPTH, D_MODEL)),
        'w_gu_dense': nrm(ks[18], (n_dense, D_MODEL, 2 * D_FF_DENSE), D_MODEL ** -0.5),
        'w_down_dense': nrm(ks[19], (n_dense, D_FF_DENSE, D_MODEL), D_FF_DENSE ** -0.5),
        'w_router': nrm(ks[20], (n_moe, D_MODEL, N_EXPERTS), D_MODEL ** -0.5),
        'b_router': nrm(ks[21], (n_moe, N_EXPERTS), 0.01),
        'w_gu_exp': nrm(ks[22], (n_moe, N_EXPERTS, D_MODEL, 2 * D_FF_EXPERT), D_MODEL ** -0.5),
        'w_down_exp': nrm(ks[23], (n_moe, N_EXPERTS, D_FF_EXPERT, D_MODEL), D_FF_EXPERT ** -0.5),
    }


def reference(x, norm1_g, w_in, g_qa, w_qb, g_kva, w_kvb, qk_g_mla, qk_g_sw, qk_g_dil, sinks, rel_bias, w_gate_a, w_gate_b, b_gate, w_branch, w_out, norm2_g, w_gu_dense, w_down_dense, w_router, b_router, w_gu_exp, w_down_exp):
    dist_band = (BLOCK + jnp.arange(BLOCK))[:, None] - jnp.arange(2 * BLOCK)[None, :]
    dist_pos = jnp.maximum(dist_band, 0)
    sw_bias = rel_bias[t5_bucket(dist_pos)][..., :SW_Q_HEADS].transpose(2, 0, 1)
    dil_biases = []
    for g, (w, dil) in enumerate(DIL_PATTERNS):
        lo = SW_Q_HEADS + g * DIL_HEADS
        b = rel_bias[t5_bucket(dist_pos * dil)][..., lo:lo + DIL_HEADS]
        dil_biases.append(b.transpose(2, 0, 1))

    for i in range(DEPTH):
        x = mixer_sublayer(x, norm1_g[i], w_in[i], g_qa[i], w_qb[i], g_kva[i], w_kvb[i], qk_g_mla[i], qk_g_sw[i], qk_g_dil[i], sinks[i], sw_bias, dil_biases, w_gate_a[i], w_gate_b[i], b_gate[i], w_branch[i], w_out[i])
        h = rmsnorm(x, norm2_g[i])
        if i % 2 == 0:
            x = x + swiglu(h, w_gu_dense[i // 2], w_down_dense[i // 2])
        else:
            x = x + moe_swiglu(h, w_router[i // 2], b_router[i // 2], w_gu_exp[i // 2], w_down_exp[i // 2])
    return x
```

```cpp
#include <hip/hip_runtime.h>
#include <stdint.h>
#include <stdio.h>

#define LAS __attribute__((address_space(3)))
#ifndef PROBE_REP
#define PROBE_REP -1
#endif
#define REPS(n) ((PROBE_REP == (n)) ? 2 : 1)
#ifndef PHM
#define PHM 0xFFFFFFFFu
#endif
#define PH(n) ((PHM >> (n)) & 1u)
typedef unsigned short bf16_t;
typedef short bf16x8 __attribute__((ext_vector_type(8)));
typedef short s16x4 __attribute__((ext_vector_type(4)));
typedef float f32x2 __attribute__((ext_vector_type(2)));
typedef float f32x4 __attribute__((ext_vector_type(4)));
typedef float f32x16 __attribute__((ext_vector_type(16)));
typedef unsigned u32x2 __attribute__((ext_vector_type(2)));
typedef unsigned u32x4 __attribute__((ext_vector_type(4)));
typedef __bf16 bf16x2_t __attribute__((ext_vector_type(2)));

constexpr int NTOK = 32768, SEQ = 16384, DM = 1024;
constexpr int PW = 3072;
constexpr int PC_AQ = 0, PC_AK = 256, PC_AV = 512, PC_CQ = 768, PC_CKV = 1024, PC_SWQ = 1280, PC_SWK = 1536, PC_SWV = 1600,
              PC_GLOW = 1664, PC_DQ = 1792, PC_DK = 2176, PC_DV = 2560, PC_KPE = 2944;
constexpr int AOW = 896;
constexpr float LOG2E = 1.4426950408889634f;
constexpr float EPS = 1e-6f;
constexpr int NWG_THREADS = 512;

constexpr size_t MiB = 1u << 20;
constexpr size_t WS_CTL = 0, CTL_BYTES = 1 * MiB;
constexpr size_t WS_MTOK = 1 * MiB;
constexpr size_t WS_MW = 3 * MiB;
constexpr size_t WS_ROPE = 5 * MiB;
constexpr size_t WS_TAB = 7 * MiB;
constexpr size_t WS_WIN = 8 * MiB;
constexpr size_t WS_WQ = 20 * MiB;
constexpr size_t WS_WKV = 20 * MiB + 512 * 1024;
constexpr size_t WS_WGB = 21 * MiB;
constexpr size_t WS_WBR = 23 * MiB;
constexpr size_t WS_WOUT = 27 * MiB;
constexpr size_t WS_WGUD = 31 * MiB;
constexpr size_t WS_WDD = 39 * MiB;
constexpr size_t WS_WGUE = 43 * MiB;
constexpr size_t WS_WDE = 67 * MiB;
constexpr size_t WS_H = 80 * MiB;
constexpr size_t WS_PROJ = 144 * MiB;
constexpr size_t WS_AO = 336 * MiB;
constexpr size_t WS_Y = 392 * MiB;
constexpr size_t WS_END = 456 * MiB;
constexpr int CW_BAR = 4096;
constexpr int CW_MOE = 16384;

constexpr int LDS_STAGE = 0;
constexpr int LDS_VSCR = 0;
constexpr int LDS_DOBUF = 36864;
constexpr int LDS_MLA = 36864;
constexpr int LDS_DLSE = 135168;
constexpr int LDS_BTAB = 141312;
constexpr int LDS_CTL = 151872;
constexpr int LDS_BYTES = 152 * 1024;

__device__ __forceinline__ unsigned pk2(float lo, float hi) { f32x2 v = {lo, hi}; bf16x2_t b = __builtin_convertvector(v, bf16x2_t); return __builtin_bit_cast(unsigned, b); }
__device__ __forceinline__ float bf2f(unsigned short b) { return __uint_as_float(((unsigned)b) << 16); }
__device__ __forceinline__ float bflo(unsigned w) { return __uint_as_float(w << 16); }
__device__ __forceinline__ float bfhi(unsigned w) { return __uint_as_float(w & 0xffff0000u); }
__device__ __forceinline__ float ex2(float x) { return __builtin_amdgcn_exp2f(x); }
__device__ __forceinline__ float lg2(float x) { return __builtin_amdgcn_logf(x); }
__device__ __forceinline__ float rcpf(float x) { return __builtin_amdgcn_rcpf(x); }
template <int CTRL> __device__ __forceinline__ float dppx(float v) { return __uint_as_float((unsigned)__builtin_amdgcn_update_dpp(0, (int)__float_as_uint(v), CTRL, 0xf, 0xf, false)); }
__device__ __forceinline__ float row16_sum(float v) {
    v += dppx<0xB1>(v); v += dppx<0x4E>(v); v += dppx<0x141>(v); v += dppx<0x140>(v); return v;
}
__device__ __forceinline__ float x16_add(float v) { auto r = __builtin_amdgcn_permlane16_swap(__float_as_uint(v), __float_as_uint(v), false, false); return __uint_as_float(r[0]) + __uint_as_float(r[1]); }
__device__ __forceinline__ float x32_add(float v) { auto r = __builtin_amdgcn_permlane32_swap(__float_as_uint(v), __float_as_uint(v), false, false); return __uint_as_float(r[0]) + __uint_as_float(r[1]); }
__device__ __forceinline__ float x32_max(float v) { auto r = __builtin_amdgcn_permlane32_swap(__float_as_uint(v), __float_as_uint(v), false, false); return fmaxf(__uint_as_float(r[0]), __uint_as_float(r[1])); }
__device__ __forceinline__ float x32_other(float v, int hi) { auto r = __builtin_amdgcn_permlane32_swap(__float_as_uint(v), __float_as_uint(v), false, false); return __uint_as_float(hi ? r[0] : r[1]); }
__device__ __forceinline__ f32x4 unpk4(unsigned a, unsigned b) { return (f32x4){__builtin_bit_cast(float, a << 16), __builtin_bit_cast(float, a & 0xffff0000u), __builtin_bit_cast(float, b << 16), __builtin_bit_cast(float, b & 0xffff0000u)}; }
__device__ __forceinline__ float wave_sum(float v) { return x32_add(x16_add(row16_sum(v))); }
__device__ __forceinline__ int sigma32(int i) { return 16 * ((i >> 2) & 1) + (i & 3) + 4 * (i >> 3); }
__device__ __forceinline__ int pi32(int i) { const int h = (i >> 2) & 1, r = (i & 3) + 4 * (i >> 3); return 16 * (r >> 3) + 8 * h + (r & 7); }
__device__ __forceinline__ bf16x8 mk8(u32x4 v) { return __builtin_bit_cast(bf16x8, v); }

#define XB_TMO      128
#define XB_XCNT(j)  (256  + 64 * (j))
#define XB_XSUB(j)  (1280 + 64 * (j))
#define XB_XGEN(j)  (2304 + 64 * (j))
#define XB_TOP      3328
#define XB_TOPGEN   3392
#define XCD_BAR_WORDS 3456
#define XB_SPIN_CAP (1u << 20)
__device__ __forceinline__ unsigned xb_ld(unsigned* p)              { return __hip_atomic_load(p, __ATOMIC_RELAXED, __HIP_MEMORY_SCOPE_AGENT); }
__device__ __forceinline__ unsigned xb_add(unsigned* p, unsigned v) { return __hip_atomic_fetch_add(p, v, __ATOMIC_RELAXED, __HIP_MEMORY_SCOPE_AGENT); }
__device__ __forceinline__ unsigned xb_xcc_id() { return (unsigned)__builtin_amdgcn_s_getreg((3 << 11) | 20) & 0xFu; }
#define XB_SPIN(cond, bar) do { unsigned _sp = 0; while (cond) { __builtin_amdgcn_s_sleep(1); \
    if ((++_sp & 255u) == 0u) { if (xb_ld(&(bar)[XB_TMO])) break; if (_sp > XB_SPIN_CAP) { atomicAdd(&(bar)[XB_TMO], 1u); break; } } } } while (0)
struct XcdBarrier { unsigned* bar; unsigned x; volatile LAS unsigned* st; };
__device__ __forceinline__ XcdBarrier xcd_barrier_post(unsigned* bar, volatile LAS unsigned* st) {
    XcdBarrier b; b.bar = bar; b.x = xb_xcc_id(); b.st = st;
    if (threadIdx.x == 0) (void)xb_add(&bar[XB_XCNT(b.x)], 1u);
    return b;
}
__device__ __forceinline__ void xcd_barrier_complete(unsigned* bar, unsigned x, unsigned& nloc, unsigned& nx) {
    const unsigned G = gridDim.x * gridDim.y * gridDim.z;
    unsigned sum, cnt, mine, sp = 0u;
    for (;;) {
        sum = 0u; cnt = 0u; mine = 0u;
#pragma unroll
        for (unsigned j = 0; j < 16; ++j) { const unsigned c = xb_ld(&bar[XB_XCNT(j)]); sum += c; cnt += (c > 0u) ? 1u : 0u; mine = (j == x) ? c : mine; }
        if (sum == G) break;
        __builtin_amdgcn_s_sleep(1);
        if ((++sp & 255u) == 0u) { if (xb_ld(&bar[XB_TMO])) break; if (sp > XB_SPIN_CAP) { atomicAdd(&bar[XB_TMO], 1u); break; } }
    }
    nloc = mine > 0u ? mine : 1u; nx = cnt > 0u ? cnt : 1u;
}
__device__ __noinline__ void xcd_barrier(const XcdBarrier b) {
    asm volatile("s_waitcnt vmcnt(0)" ::: "memory");
    __syncthreads();
    if (threadIdx.x == 0) {
        unsigned* bar = b.bar;
        __builtin_amdgcn_s_waitcnt(0);
        unsigned nloc = b.st[0], nx = b.st[1];
        if (nloc == 0u) { xcd_barrier_complete(bar, b.x, nloc, nx); b.st[0] = nloc; b.st[1] = nx; }
        const unsigned old = xb_add(&bar[XB_XSUB(b.x)], 1u);
        const unsigned gen = old / nloc;
        if (old + 1u == (gen + 1u) * nloc) {
            __builtin_amdgcn_fence(__ATOMIC_RELEASE, "agent");
            asm volatile("s_waitcnt vmcnt(0)" ::: "memory");
            const unsigned og = xb_add(&bar[XB_TOP], 1u);
            const unsigned tg = og / nx;
            if (og + 1u == (tg + 1u) * nx) xb_add(&bar[XB_TOPGEN], 1u);
            else XB_SPIN(xb_ld(&bar[XB_TOPGEN]) == tg, bar);
            __builtin_amdgcn_fence(__ATOMIC_ACQUIRE, "agent");
            xb_add(&bar[XB_XGEN(b.x)], 1u);
            asm volatile("s_waitcnt vmcnt(0)" ::: "memory");
        } else {
            XB_SPIN(xb_ld(&bar[XB_XGEN(b.x)]) == gen, bar);
            __builtin_amdgcn_fence(__ATOMIC_ACQUIRE, "agent");
            asm volatile("s_waitcnt vmcnt(0)" ::: "memory");
        }
    }
    __syncthreads();
}

struct Params { const float* in[24]; float* out; unsigned char* ws; };
enum { I_X = 0, I_N1G, I_WIN, I_GQA, I_WQB, I_GKVA, I_WKVB, I_GMLA, I_GSW, I_GDIL, I_SINKS, I_RELB, I_WGA, I_WGB, I_BG, I_WBR, I_WOUT, I_N2G,
       I_WGUD, I_WDD, I_WR, I_BR, I_WGUE, I_WDE };

struct Ctx {
    LAS unsigned char* lds;
    int tid, lane, wid, G, vcu, gw, NGW;
};
__device__ __forceinline__ unsigned char* launder_ptr(unsigned char* q) { size_t z = 0; asm volatile("" : "+s"(z)); return q + z; }
__device__ __forceinline__ Ctx launder(const Ctx& c0) {
    Ctx c = c0; int t, w = c0.wid;
    asm volatile("" : "+s"(w));
    asm volatile("v_mbcnt_lo_u32_b32 %0, -1, 0\n\tv_mbcnt_hi_u32_b32 %0, -1, %0" : "=v"(t));
    __builtin_assume(t >= 0 && t < 64); __builtin_assume(w >= 0 && w < 8);
    c.lane = t; c.tid = (w << 6) | t; c.wid = w; c.gw = (int)blockIdx.x * 8 + w;
    return c;
}

__device__ __forceinline__ int inproj_map(int c) {
    if (c < 1280) return c;
    if (c < 1312) return PC_KPE + (c - 1280);
    if (c < 1568) return PC_SWQ + (c - 1312);
    if (c < 1632) return PC_SWK + (c - 1568);
    if (c < 1696) return PC_SWV + (c - 1632);
    return PC_DQ + (c - 1696);
}
struct ItemRegs { f32x4 v[8]; float ks[8]; };
struct ItemInfo { bf16_t* WT; int ldt, dst, k0; float scale; };
__device__ __forceinline__ void item_load(const LAS unsigned* JT, int id, int& j, int lane, ItemRegs& r, ItemInfo& inf) {
    while (id >= (int)JT[(j + 1) * 12 + 11]) ++j;
    const LAS unsigned* e = JT + j * 12;
    const float* W = (const float*)(((unsigned long long)e[1] << 32) | e[0]);
    inf.WT = (bf16_t*)(((unsigned long long)e[3] << 32) | e[2]);
    const float* ks = (const float*)(((unsigned long long)e[5] << 32) | e[4]);
    const int ldw = (int)e[6], N = (int)e[8], mode = (int)(e[10] & 255u), add = (int)(e[10] >> 8);
    inf.ldt = (int)e[9];
    const int it = id - (int)e[11], nblk = N / 32, kb = it / nblk, nb = it % nblk, cc0 = nb * 32;
    float scale = 1.f; int dst;
    if (mode == 0) dst = cc0 + add;
    else if (mode == 3) { dst = cc0 + add; scale = -LOG2E; }
    else if (mode == 1) { dst = inproj_map(cc0); if (cc0 < 256) scale = 0.125f * LOG2E; }
    else { const int half = N / 2; const int isu = cc0 >= half ? 1 : 0; const int cc = cc0 - isu * half; dst = 256 * (cc / 128) + 128 * isu + (cc % 128); }
    inf.dst = dst; inf.k0 = kb * 64; inf.scale = scale;
#pragma unroll
    for (int i = 0; i < 8; ++i) { const int kk = kb * 64 + (lane >> 3) + 8 * i; r.v[i] = *(const f32x4*)(W + (size_t)kk * ldw + cc0 + 4 * (lane & 7)); r.ks[i] = ks ? ks[kk] : 1.f; }
}
__device__ __forceinline__ void item_finish(const ItemRegs& r, const ItemInfo& inf, LAS float* scr, int lane) {
#pragma unroll
    for (int i = 0; i < 8; ++i) { const int kk = (lane >> 3) + 8 * i; const float sc = inf.scale * r.ks[i];
        LAS float* d = scr + kk * 33 + 4 * (lane & 7); d[0] = r.v[i].x * sc; d[1] = r.v[i].y * sc; d[2] = r.v[i].z * sc; d[3] = r.v[i].w * sc; }
    asm volatile("s_waitcnt lgkmcnt(0)" ::: "memory");
    const int c = lane & 7;
#pragma unroll
    for (int j = 0; j < 4; ++j) { const int n = (lane >> 3) + 8 * j; const LAS float* sp = scr + (8 * c) * 33 + n;
        u32x4 o; o.x = pk2(sp[0 * 33], sp[1 * 33]); o.y = pk2(sp[2 * 33], sp[3 * 33]); o.z = pk2(sp[4 * 33], sp[5 * 33]); o.w = pk2(sp[6 * 33], sp[7 * 33]);
        *(u32x4*)(inf.WT + (size_t)(inf.dst + n) * inf.ldt + inf.k0 + 8 * c) = o; }
    asm volatile("s_waitcnt lgkmcnt(0)" ::: "memory");
}
__device__ __forceinline__ int t5_bucket(int d) {
    if (d < 16) return d;
    int b = 16 + (int)(__log2f((float)d * (1.f / 16.f)) * (16.f / 7.f));
    return b > 31 ? 31 : b;
}
__device__ __forceinline__ void prologue(const Params& p, const Ctx& c0) {
    const Ctx c = launder(c0);
    unsigned char* ws = launder_ptr(p.ws);
    LAS float* scr = (LAS float*)(c.lds + c.wid * 16384);
    LAS unsigned* JT = (LAS unsigned*)(c.lds + 131072);
    if (c.tid == 0) {
        int nj = 0, first = 0;
#define JOB(W, ldw, K, N, WT, ldt, mode, add, ks) do { LAS unsigned* e_ = JT + nj * 12; const unsigned long long w_ = (unsigned long long)(W), t_ = (unsigned long long)(WT), k_ = (unsigned long long)(ks); \
        e_[0] = (unsigned)w_; e_[1] = (unsigned)(w_ >> 32); e_[2] = (unsigned)t_; e_[3] = (unsigned)(t_ >> 32); e_[4] = (unsigned)k_; e_[5] = (unsigned)(k_ >> 32); \
        e_[6] = (unsigned)(ldw); e_[7] = (unsigned)(K); e_[8] = (unsigned)(N); e_[9] = (unsigned)(ldt); e_[10] = (unsigned)(mode) | ((unsigned)(add) << 8); e_[11] = (unsigned)first; \
        first += ((K) / 64) * ((N) / 32); ++nj; } while (0)
        for (int l = 0; l < 2; ++l) {
            bf16_t* win = (bf16_t*)(ws + WS_WIN) + (size_t)l * PW * 1024;
            JOB(p.in[I_WIN] + (size_t)l * 1024 * 2848, 2848, 1024, 2848, win, 1024, 1, 0, (const float*)nullptr);
            JOB(p.in[I_WGA] + (size_t)l * 1024 * 128, 128, 1024, 128, win, 1024, 0, PC_GLOW, (const float*)nullptr);
            JOB(p.in[I_WQB] + (size_t)l * 256 * 384, 384, 256, 384, (bf16_t*)(ws + WS_WQ) + (size_t)l * 512 * 256, 256, 0, 0, p.in[I_GQA] + l * 256);
            JOB(p.in[I_WKVB] + (size_t)l * 256 * 512, 512, 256, 512, (bf16_t*)(ws + WS_WKV) + (size_t)l * 512 * 256, 256, 0, 0, p.in[I_GKVA] + l * 256);
            JOB(p.in[I_WGB] + (size_t)l * 128 * 4096, 4096, 128, 4096, (bf16_t*)(ws + WS_WGB) + (size_t)l * 4096 * 128, 128, 3, 0, (const float*)nullptr);
            bf16_t* wbr = (bf16_t*)(ws + WS_WBR) + (size_t)l * 1024 * 1024;
            const float* wb = p.in[I_WBR] + (size_t)l * 896 * 1024;
            JOB(wb, 1024, 256, 1024, wbr, 256, 0, 0, (const float*)nullptr);
            JOB(wb + (size_t)256 * 1024, 1024, 256, 1024, wbr + 1024 * 256, 256, 0, 0, (const float*)nullptr);
            JOB(wb + (size_t)512 * 1024, 1024, 256, 1024, wbr + 2 * 1024 * 256, 256, 0, 0, (const float*)nullptr);
            JOB(wb + (size_t)768 * 1024, 1024, 128, 1024, wbr + 3 * 1024 * 256, 128, 0, 0, (const float*)nullptr);
            JOB(p.in[I_WOUT] + (size_t)l * 1024 * 1024, 1024, 1024, 1024, (bf16_t*)(ws + WS_WOUT) + (size_t)l * 1024 * 1024, 1024, 0, 0, (const float*)nullptr);
        }
        JOB(p.in[I_WGUD], 4096, 1024, 4096, (bf16_t*)(ws + WS_WGUD), 1024, 2, 0, (const float*)nullptr);
        JOB(p.in[I_WDD], 1024, 2048, 1024, (bf16_t*)(ws + WS_WDD), 2048, 0, 0, (const float*)nullptr);
        for (int e = 0; e < 8; ++e) {
            JOB(p.in[I_WGUE] + (size_t)e * 1024 * 1536, 1536, 1024, 1536, (bf16_t*)(ws + WS_WGUE) + (size_t)e * 1536 * 1024, 1024, 2, 0, (const float*)nullptr);
            JOB(p.in[I_WDE] + (size_t)e * 768 * 1024, 1024, 768, 1024, (bf16_t*)(ws + WS_WDE) + (size_t)e * 1024 * 768, 768, 0, 0, (const float*)nullptr);
        }
#undef JOB
        JT[nj * 12 + 11] = (unsigned)first;
        JT[1023] = (unsigned)nj;
    }
    __syncthreads();
    {
        const int nj = (int)JT[1023], total = (int)JT[nj * 12 + 11];
        const int lo = (int)(((long long)c.gw * total) / c.NGW), hi = (int)(((long long)(c.gw + 1) * total) / c.NGW);
        int j = 0; ItemRegs ra, rb; ItemInfo ia, ib;
        if (lo < hi) item_load(JT, lo, j, c.lane, ra, ia);
        for (int id = lo; id < hi; ++id) {
            if (id + 1 < hi) item_load(JT, id + 1, j, c.lane, rb, ib);
            item_finish(ra, ia, scr, c.lane);
            ra = rb; ia = ib;
        }
    }
    __syncthreads();
    const int gt = c.gw * 64 + c.lane, NGT = c.NGW * 64;
    for (int l = 0; l < 2; ++l) {
        u32x4* z = (u32x4*)((bf16_t*)(ws + WS_WIN) + (size_t)l * PW * 1024 + (size_t)2976 * 1024);
        for (int i = gt; i < 96 * 1024 / 8; i += NGT) z[i] = (u32x4){0u, 0u, 0u, 0u};
        u32x4* z2 = (u32x4*)((bf16_t*)(ws + WS_WQ) + (size_t)l * 512 * 256 + (size_t)384 * 256);
        for (int i = gt; i < 128 * 256 / 8; i += NGT) z2[i] = (u32x4){0u, 0u, 0u, 0u};
    }
    {
        f32x2* rt = (f32x2*)(ws + WS_ROPE);
        for (int i = gt; i < SEQ * 16; i += NGT) {
            const int pos = i >> 4, j = i & 15;
            const double c4 = (j & 3) == 0 ? 1.0 : ((j & 3) == 1 ? 0.56234132519034908 : ((j & 3) == 2 ? 0.31622776601683794 : 0.17782794100389228));
            const double d4 = (j >> 2) == 0 ? 1.0 : ((j >> 2) == 1 ? 0.1 : ((j >> 2) == 2 ? 0.01 : 0.001));
            const float inv = (float)(c4 * d4);
            const float ang = (float)pos * inv;
            const double rev = (double)ang * 0.15915494309189535;
            const float fr = (float)(rev - rint(rev));
            rt[i] = (f32x2){__builtin_amdgcn_cosf(fr), __builtin_amdgcn_sinf(fr)};
        }
    }
    {
        float* bt = (float*)(ws + WS_TAB);
        for (int i = gt; i < 20 * 132; i += NGT) {
            const int hd = i / 132, d = i % 132;
            const int dil = hd < 8 ? 1 : (hd < 12 ? 1 : (hd < 16 ? 4 : 16));
            bt[i] = p.in[I_RELB][t5_bucket(d * dil) * 20 + hd] * LOG2E;
        }
        float* bn = bt + 20 * 132 + 256;
        for (int i = gt; i < 2 * 4096; i += NGT) bn[i] = -p.in[I_BG][i] * LOG2E;
        float* gt_ = bt + 20 * 132;
        for (int i = gt; i < 2 * 4 * 32; i += NGT) {
            const int l = i >> 7, t = (i >> 5) & 3, j = i & 31;
            const float sc = 0.17677669529663687f * LOG2E;
            float v;
            if (t == 0) v = p.in[I_GSW][l * 64 + j] * sc; else if (t == 1) v = p.in[I_GSW][l * 64 + 32 + j];
            else if (t == 2) v = p.in[I_GDIL][l * 64 + j] * sc; else v = p.in[I_GDIL][l * 64 + 32 + j];
            gt_[i] = v;
        }
    }
}

template <bool ROUTE>
__device__ __forceinline__ void rmsnorm_phase(const Params& p, const Ctx& c0, const void* xv, int x_f32, const float* g, bf16_t* h, const float* wr, const float* br) {
    const Ctx c = launder(c0);
    unsigned char* const wsl = launder_ptr(p.ws);
    const int lane = c.lane;
    f32x4 gv[4];
#pragma unroll
    for (int j = 0; j < 4; ++j) gv[j] = *(const f32x4*)(g + 4 * lane + 256 * j);
    f32x4 wv[ROUTE ? 32 : 1];
    if (ROUTE) {
#pragma unroll
        for (int j = 0; j < 4; ++j)
#pragma unroll
            for (int cc = 0; cc < 4; ++cc) { const float* w = wr + (size_t)(4 * lane + 256 * j + cc) * 8; wv[(j * 4 + cc) * 2] = *(const f32x4*)w; wv[(j * 4 + cc) * 2 + 1] = *(const f32x4*)(w + 4); }
    }
    int* mtok = (int*)(wsl + WS_MTOK); float* mw = (float*)(wsl + WS_MW); unsigned* ctl = (unsigned*)(wsl + WS_CTL);
    int my_tok = 0, my_e0 = 0, my_e1 = 0; float my_w0 = 0.f, my_w1 = 0.f; int nmine = 0;
    const bool wg_agg = ROUTE && (NTOK % c.NGW) == 0 && (NTOK / c.NGW) <= 64;
    LAS unsigned* rcnt = (LAS unsigned*)c.lds;
#define ROUTE_FLUSH(WG) do { \
        const bool act = lane < nmine; \
        unsigned cntv = 0; int pos0 = 0, pos1 = 0; \
        _Pragma("unroll") for (int k = 0; k < 2; ++k) { \
            const int me = k == 0 ? my_e0 : my_e1; \
            _Pragma("unroll") for (int e = 0; e < 8; ++e) { \
                const unsigned long long mask = __ballot(act && me == e); \
                if (lane == k * 8 + e) cntv = (unsigned)__popcll(mask); \
                if (me == e) { const int r = __popcll(mask & ((1ull << lane) - 1ull)); if (k == 0) pos0 = r; else pos1 = r; } } } \
        unsigned base = 0; \
        if (WG) { \
            if (lane < 16) rcnt[c.wid * 16 + lane] = cntv; \
            __syncthreads(); \
            if (c.wid == 0 && lane < 16) { \
                unsigned tot = 0; \
                _Pragma("unroll") for (int w = 0; w < 8; ++w) tot += rcnt[w * 16 + lane]; \
                unsigned wb = 0; \
                if (tot) wb = __hip_atomic_fetch_add(ctl + CW_MOE + 64 * lane, tot, __ATOMIC_RELAXED, __HIP_MEMORY_SCOPE_AGENT); \
                rcnt[128 + lane] = wb; } \
            __syncthreads(); \
            if (lane < 16) { base = rcnt[128 + lane]; for (int w = 0; w < c.wid; ++w) base += rcnt[w * 16 + lane]; } \
        } else { \
            if (lane < 16 && cntv) base = __hip_atomic_fetch_add(ctl + CW_MOE + 64 * lane, cntv, __ATOMIC_RELAXED, __HIP_MEMORY_SCOPE_AGENT); \
        } \
        const unsigned b0 = (unsigned)__builtin_amdgcn_ds_bpermute(my_e0 * 4, (int)base), b1 = (unsigned)__builtin_amdgcn_ds_bpermute((8 + my_e1) * 4, (int)base); \
        if (act) { \
            mtok[my_e0 * NTOK + b0 + pos0] = my_tok; mw[my_e0 * NTOK + b0 + pos0] = my_w0; \
            mtok[(8 + my_e1) * NTOK + b1 + pos1] = my_tok; mw[(8 + my_e1) * NTOK + b1 + pos1] = my_w1; } \
    } while (0)
    const float* x = (const float*)xv; const bf16_t* xb = (const bf16_t*)xv;
#define RMS_LOAD(dst, row) do { if (x_f32) { _Pragma("unroll") for (int j = 0; j < 4; ++j) dst[j] = ((const f32x4*)(x + (size_t)(row) * DM) + lane)[64 * j]; } \
        else { _Pragma("unroll") for (int j = 0; j < 4; ++j) { const u32x2 w_ = ((const u32x2*)(xb + (size_t)(row) * DM) + lane)[64 * j]; dst[j] = unpk4(w_.x, w_.y); } } } while (0)
    f32x4 nv[4];
    if (c.gw < NTOK) RMS_LOAD(nv, c.gw);
    for (int m = c.gw; m < NTOK; m += c.NGW) {
        f32x4 v[4]; float s = 0.f;
#pragma unroll
        for (int j = 0; j < 4; ++j) v[j] = nv[j];
        if (m + c.NGW < NTOK) RMS_LOAD(nv, m + c.NGW);
#pragma unroll
        for (int j = 0; j < 4; ++j) s += (v[j].x * v[j].x + v[j].y * v[j].y) + (v[j].z * v[j].z + v[j].w * v[j].w);
        const float rs = __builtin_amdgcn_rsqf(wave_sum(s) * (1.f / DM) + EPS);
        unsigned long long* o8 = (unsigned long long*)(h + (size_t)m * DM) + lane;
#pragma unroll
        for (int j = 0; j < 4; ++j) { v[j] = v[j] * rs * gv[j]; o8[64 * j] = (unsigned long long)pk2(v[j].x, v[j].y) | ((unsigned long long)pk2(v[j].z, v[j].w) << 32); }
        if (ROUTE) {
            float lg[8];
#pragma unroll
            for (int e = 0; e < 8; ++e) lg[e] = 0.f;
#pragma unroll
            for (int j = 0; j < 4; ++j)
#pragma unroll
                for (int cc = 0; cc < 4; ++cc) { const float xv = v[j][cc]; const f32x4 a = wv[(j * 4 + cc) * 2], b = wv[(j * 4 + cc) * 2 + 1];
                    lg[0] += xv * a.x; lg[1] += xv * a.y; lg[2] += xv * a.z; lg[3] += xv * a.w; lg[4] += xv * b.x; lg[5] += xv * b.y; lg[6] += xv * b.z; lg[7] += xv * b.w; }
#pragma unroll
            for (int e = 0; e < 8; ++e) lg[e] = wave_sum(lg[e]) + br[e];
            int e0 = 0; float v0 = lg[0];
#pragma unroll
            for (int e = 1; e < 8; ++e) if (lg[e] > v0) { v0 = lg[e]; e0 = e; }
            int e1 = -1; float v1 = -3.0e38f;
#pragma unroll
            for (int e = 0; e < 8; ++e) if (e != e0 && lg[e] > v1) { v1 = lg[e]; e1 = e; }
            const float t = ex2((v1 - v0) * LOG2E);
            const float w0 = 1.f / (1.f + t), w1 = t / (1.f + t);
            if (lane == nmine) { my_tok = m; my_e0 = e0; my_e1 = e1; my_w0 = w0; my_w1 = w1; }
            ++nmine;
            if (nmine == 64 || (!wg_agg && m + c.NGW >= NTOK)) { ROUTE_FLUSH(false); nmine = 0; }
        }
    }
    if (ROUTE && wg_agg) { ROUTE_FLUSH(true); }
#undef ROUTE_FLUSH
}

constexpr int SLOT_BYTES = 24576, SLOT_BOFF = 8192, NSLOT = 6;
struct Unit { int pm, pn, e, sa, sb; };
#define DMA16(m0v, voff, rsrc, soff) asm volatile("s_mov_b32 m0, %0\n\ts_nop 0\n\tbuffer_load_dwordx4 %1, %2, %3 offen lds" :: "s"(m0v), "v"(voff), "s"(rsrc), "s"(soff) : "m0", "memory")

template <int BM>
struct SubFrags { bf16x8 xf[2][BM / 64], wf[2][2]; };
template <int BM>
__device__ __forceinline__ void ld_frags(const LAS unsigned char* sl, SubFrags<BM>& F, int ks, int wr, int wc, int r32, int hi) {
    constexpr int MB = BM / 64;
    const int s32 = sigma32(r32);
    const unsigned xrow = (unsigned)(wr * (BM / 2) + r32) * 64u, kx = (r32 >> 2) & 3;
    const unsigned wrow = SLOT_BOFF + (unsigned)(wc * 64 + s32) * 64u, kw = (s32 >> 2) & 3;
#pragma unroll
    for (int mb = 0; mb < MB; ++mb) F.xf[ks][mb] = *(const LAS bf16x8*)(sl + xrow + mb * 2048 + (((2 * ks + hi) ^ kx) << 4));
#pragma unroll
    for (int nb = 0; nb < 2; ++nb) F.wf[ks][nb] = *(const LAS bf16x8*)(sl + wrow + nb * 2048 + (((2 * ks + hi) ^ kw) << 4));
}
template <int BM>
__device__ __forceinline__ void mma_sub_pipe(const LAS unsigned char* nxt, SubFrags<BM>& F, f32x16 (&acc)[BM / 64][2], int wr, int wc, int r32, int hi) {
    constexpr int MB = BM / 64;
#pragma unroll
    for (int ks = 0; ks < 2; ++ks) {
        __builtin_amdgcn_s_setprio(1);
#pragma unroll
        for (int mb = 0; mb < MB; ++mb)
#pragma unroll
            for (int nb = 0; nb < 2; ++nb) acc[mb][nb] = __builtin_amdgcn_mfma_f32_32x32x16_bf16(F.wf[ks][nb], F.xf[ks][mb], acc[mb][nb], 0, 0, 0);
        __builtin_amdgcn_s_setprio(0);
        __builtin_amdgcn_sched_barrier(0);
        ld_frags<BM>(nxt, F, ks, wr, wc, r32, hi);
        __builtin_amdgcn_sched_barrier(0);
    }
}

namespace pg8 {
constexpr int HALF = 128, HTB = HALF * 64 * 2;
__device__ __forceinline__ int lds_byte(int r, int c) { const int st = (r >> 4) * 2 + (c >> 5), rr = r & 15, cc = c & 31, ob = rr * 64 + cc * 2; return st * 1024 + (ob ^ (((ob >> 9) & 1) << 5)); }
__device__ __forceinline__ void stage_rc(int b, int& R, int& C) { const int st = b / 1024, sb = b % 1024, swz = sb ^ (((sb >> 9) & 1) << 5); R = (st >> 1) * 16 + swz / 64; C = (st & 1) * 32 + (swz % 64) / 2; }
__device__ __forceinline__ int perm32(int rho) { const int n = rho >> 4, i = rho & 15; return 8 * (i >> 2) + 4 * n + (i & 3); }

__device__ __forceinline__ const char* uni_ptr(const char* q) {
    const unsigned long long v = (unsigned long long)q;
    const unsigned lo = (unsigned)__builtin_amdgcn_readfirstlane((int)(unsigned)v), hi = (unsigned)__builtin_amdgcn_readfirstlane((int)(unsigned)(v >> 32));
    return (const char*)(((unsigned long long)hi << 32) | lo);
}
template <class Epi, class Sched, bool ALIGN_EPI, int SUB = 0>
__device__ __forceinline__ void gemm_phase(const Ctx& c0, const char* Abase, int K, const Sched& S, const Epi& E) {
    const Ctx c = launder(c0);
    LAS unsigned char* lds = c.lds + LDS_STAGE;
    const int tid = c.tid, wid = c.wid, lane = c.lane, wr = wid >> 2, wc = wid & 3, fr = lane & 15, fq = lane >> 4;
    int nt = K / 64; asm volatile("" : "+s"(nt));
    int R[2], C[2]; unsigned voffB[2];
#pragma unroll
    for (int i = 0; i < 2; ++i) { stage_rc(tid * 16 + i * 8192, R[i], C[i]); const int Rb = (R[i] & ~31) + perm32(R[i] & 31); voffB[i] = (unsigned)(Rb * S.ldb2 + C[i] * 2); }
    const size_t kstep = 128;
    const size_t hstepB = (size_t)HALF * S.ldb2;
    const unsigned ldsw = (unsigned)wid * 1024u;
    const int aoff = lds_byte(wr * 64 + fr, fq * 8), boff = lds_byte(wc * 32 + fr, fq * 8);
#define PG8_SA(b, h) (((b) * 2 + (h)) * HTB)
#define PG8_SB(b, h) ((4 + (b) * 2 + (h)) * HTB)
#define PG8_STAGE(bufoff, gbase, voff) do { const char* gb_ = (const char*)(gbase); asm volatile("" : "+s"(gb_));     \
        _Pragma("unroll") for (int _i = 0; _i < 2; ++_i) { unsigned vo_ = (voff)[_i]; asm volatile("" : "+v"(vo_)); \
        __builtin_amdgcn_global_load_lds((const unsigned*)(gb_ + vo_), (LAS unsigned*)(lds + (bufoff) + ldsw + _i * 8192), 16, 0, 0); } } while (0)
#define PG8_LDA(dst, b, h) do { _Pragma("unroll") for (int m = 0; m < 4; ++m) _Pragma("unroll") for (int k = 0; k < 2; ++k) dst[m][k] = *(const LAS bf16x8*)(lds + PG8_SA(b, h) + aoff + m * 2048 + k * 1024); } while (0)
#define PG8_LDB(dst, b, h) do { _Pragma("unroll") for (int n = 0; n < 2; ++n) _Pragma("unroll") for (int k = 0; k < 2; ++k) dst[n][k] = *(const LAS bf16x8*)(lds + PG8_SB(b, h) + boff + n * 2048 + k * 1024); } while (0)
#define PG8_MMA(ai, bj, At, Bt) do { __builtin_amdgcn_s_setprio(1); _Pragma("unroll") for (int m = 0; m < 4; ++m) _Pragma("unroll") for (int n = 0; n < 2; ++n) _Pragma("unroll") for (int k = 0; k < 2; ++k) \
        acc[ai][bj][m][n] = __builtin_amdgcn_mfma_f32_16x16x32_bf16(Bt[n][k], At[m][k], acc[ai][bj][m][n], 0, 0, 0); __builtin_amdgcn_s_setprio(0); } while (0)
#define PG8_WAIT_V(n) asm volatile("s_waitcnt vmcnt(" #n ")" ::: "memory")
#define PG8_WAIT_L(n) asm volatile("s_waitcnt lgkmcnt(" #n ")" ::: "memory")
#define PG8_BAR __builtin_amdgcn_s_barrier()
#define PG8_SCHED __builtin_amdgcn_sched_barrier(0)
    constexpr bool AFF = Sched::AFFINE;
    unsigned voffA[2] = {0u, 0u}; size_t hstepA = 0;
    if constexpr (AFF) {
#pragma unroll
        for (int i = 0; i < 2; ++i) voffA[i] = (unsigned)(R[i] * S.lda2 + C[i] * 2);
        hstepA = (size_t)HALF * S.lda2;
    }
#define PG8_STA(bufoff, abase, h, vv) do { if constexpr (AFF) PG8_STAGE(bufoff, (abase) + (h) * hstepA, voffA); else PG8_STAGE(bufoff, abase, (vv)[h]); } while (0)
    Unit cur, nxt; int ui = 0;
    if (!S.next(0, cur)) return;
    f32x4 acc[2][2][4][2];
    if constexpr (SUB == 0) E.init(acc, cur, wr, wc, fr, fq);
    else E.template init_sub<SUB>(acc, cur, wr, wc, fr, fq);
    bf16x8 At[4][2], B0[2][2], B1[2][2];
    unsigned vA[2][2] = {{0u, 0u}, {0u, 0u}}, vAn[2][2] = {{0u, 0u}, {0u, 0u}};
    const char* uA = Abase;
    if constexpr (AFF) uA = Abase + S.a_unit_off(cur) + (SUB ? (size_t)cur.sa * hstepA : (size_t)0); else S.a_offs(cur, R, C, vA);
    const char* cB = S.b_ptr(cur) + (SUB == 2 ? (size_t)cur.sb * hstepB : (size_t)0);
    PG8_STAGE(PG8_SB(0, 0), cB, voffB); PG8_STAGE(PG8_SB(0, 1), cB + hstepB, voffB); PG8_STA(PG8_SA(0, 0), uA, 0, vA); PG8_STA(PG8_SA(0, 1), uA, 1, vA);
    if (wr == 1) PG8_BAR;
    PG8_WAIT_V(2); PG8_BAR;
    PG8_STAGE(PG8_SB(1, 0), cB + kstep, voffB); PG8_STA(PG8_SA(1, 0), uA + kstep, 0, vA); PG8_STAGE(PG8_SB(1, 1), cB + hstepB + kstep, voffB);
    PG8_WAIT_V(6); PG8_BAR;
#define PG8_WAIT_N(n) asm volatile("s_waitcnt vmcnt(%0)" :: "n"(n) : "memory")
#define PG8_WAIT_R() do { if (rlx) PG8_WAIT_N(NS + 8); else PG8_WAIT_N(8); } while (0)
    constexpr int NS = SUB ? 0 : Epi::NSTORE;
    for (;;) {
        const bool has_next = S.next(ui + 1, nxt);
        const char* nuA = uA;
        if constexpr (AFF) { if (has_next) nuA = Abase + S.a_unit_off(nxt) + (SUB ? (size_t)nxt.sa * hstepA : (size_t)0); }
        else {
            if (has_next) { int td = tid; asm volatile("" : "+v"(td)); int R2[2], C2[2]; stage_rc(td * 16, R2[0], C2[0]); stage_rc(td * 16 + 8192, R2[1], C2[1]); S.a_offs(nxt, R2, C2, vAn); }
            else {
#pragma unroll
                for (int h = 0; h < 2; ++h) { vAn[h][0] = vA[h][0]; vAn[h][1] = vA[h][1]; }
            }
        }
        const char* nB = has_next ? S.b_ptr(nxt) + (SUB == 2 ? (size_t)nxt.sb * hstepB : (size_t)0) : cB;
        for (int t = 0; t < nt; t += 2) {
            const bool last = (t == nt - 2);
            const bool rlx = NS > 0 && t == 0 && ui > 0;
            const char* a1 = uA + (size_t)(t + 1) * kstep;
            const char* a2 = last ? nuA : uA + (size_t)(t + 2) * kstep; const char* b2 = last ? nB : cB + (size_t)(t + 2) * kstep;
            const char* a3 = a2 + kstep; const char* b3 = b2 + kstep;
            unsigned va2[2][2] = {{0u, 0u}, {0u, 0u}};
            if constexpr (!AFF) {
#pragma unroll
                for (int h = 0; h < 2; ++h) { va2[h][0] = last ? vAn[h][0] : vA[h][0]; va2[h][1] = last ? vAn[h][1] : vA[h][1]; }
            }
            PG8_LDB(B0, 0, 0); if constexpr (SUB < 2) PG8_LDB(B1, 0, 1); PG8_SCHED; PG8_LDA(At, 0, 0); if (NS == 0 || t > 0 || ui == 0) PG8_STA(PG8_SA(1, 1), a1, 1, vA);
            PG8_WAIT_R(); PG8_WAIT_L(0); PG8_BAR; PG8_MMA(0, 0, At, B0); if constexpr (SUB < 2) PG8_MMA(0, 1, At, B1); PG8_BAR; PG8_SCHED;
            if constexpr (SUB == 0) PG8_LDA(At, 0, 1); PG8_STAGE(PG8_SB(0, 0), b2, voffB); PG8_STAGE(PG8_SB(0, 1), b2 + hstepB, voffB); PG8_STA(PG8_SA(0, 0), a2, 0, va2);
            PG8_WAIT_R(); PG8_WAIT_L(0); PG8_BAR; if constexpr (SUB == 0) { PG8_MMA(1, 0, At, B0); PG8_MMA(1, 1, At, B1); } PG8_BAR; PG8_SCHED;
            PG8_LDB(B0, 1, 0); if constexpr (SUB < 2) PG8_LDB(B1, 1, 1); PG8_SCHED; PG8_LDA(At, 1, 0); PG8_STA(PG8_SA(0, 1), a2, 1, va2);
            PG8_WAIT_R(); PG8_WAIT_L(0); PG8_BAR; PG8_MMA(0, 0, At, B0); if constexpr (SUB < 2) PG8_MMA(0, 1, At, B1); PG8_BAR; PG8_SCHED;
            if constexpr (SUB == 0) PG8_LDA(At, 1, 1); PG8_STAGE(PG8_SB(1, 0), b3, voffB); PG8_STAGE(PG8_SB(1, 1), b3 + hstepB, voffB); PG8_STA(PG8_SA(1, 0), a3, 0, va2);
            PG8_WAIT_V(8); PG8_WAIT_L(0); PG8_BAR; if constexpr (SUB == 0) { PG8_MMA(1, 0, At, B0); PG8_MMA(1, 1, At, B1); } PG8_BAR; PG8_SCHED;
        }
        if constexpr (ALIGN_EPI) { if (wr == 0) PG8_BAR; }
        if (NS > 0) PG8_STA(PG8_SA(1, 1), nuA + kstep, 1, vAn);
        int ln = tid; asm volatile("" : "+v"(ln)); ln &= 63;
        if constexpr (SUB == 0) E(acc, cur, wr, wc, ln & 15, ln >> 4); else E.template run_sub<SUB>(acc, cur, wr, wc, ln & 15, ln >> 4);
        if (!has_next) break;
        if constexpr (SUB == 0) E.init(acc, nxt, wr, wc, ln & 15, ln >> 4); else E.template init_sub<SUB>(acc, nxt, wr, wc, ln & 15, ln >> 4);
        cur = nxt; cB = nB; uA = nuA; ++ui;
        if constexpr (!AFF) {
#pragma unroll
            for (int h = 0; h < 2; ++h) { vA[h][0] = vAn[h][0]; vA[h][1] = vAn[h][1]; }
        }
        if constexpr (ALIGN_EPI) { if (wr == 1) PG8_BAR; }
    }
    PG8_WAIT_V(0);
    if constexpr (!ALIGN_EPI) { if (wr == 0) PG8_BAR; }
    PG8_BAR;
#undef PG8_SA
#undef PG8_SB
#undef PG8_STAGE
#undef PG8_STA
#undef PG8_LDA
#undef PG8_LDB
#undef PG8_MMA
#undef PG8_WAIT_V
#undef PG8_WAIT_L
#undef PG8_BAR
#undef PG8_SCHED
#undef PG8_WAIT_R
#undef PG8_WAIT_N
}

__device__ __forceinline__ u32x4 pack8(const f32x4& a, const f32x4& b) { u32x4 w; w.x = pk2(a[0], a[1]); w.y = pk2(a[2], a[3]); w.z = pk2(b[0], b[1]); w.w = pk2(b[2], b[3]); return w; }

struct SchedPlain {
    static constexpr bool AFFINE = true;
    const char* Bt; int lda2, ldb2; int nM, nN, G, c; int swp;
    __device__ __forceinline__ size_t a_unit_off(const Unit& u) const { return (size_t)u.pm * 256 * lda2; }
    __device__ __forceinline__ bool next(int i, Unit& u) const {
        const int L = i * G + c; if (L >= nM * nN) return false;
        const int nig = 8 * nN, gid = L / nig, fm = gid * 8, wi = L % nig; int gsz = nM - fm; gsz = gsz < 8 ? gsz : 8;
        u.pm = fm + wi % gsz; int pn = wi / gsz; if (swp) pn = pn == 9 ? 10 : (pn == 10 ? 9 : pn); u.pn = pn; u.e = 0; u.sa = 0; u.sb = 0; return true;
    }
    __device__ __forceinline__ void a_offs(const Unit& u, const int (&R)[2], const int (&C)[2], unsigned (&v)[2][2]) const {
#pragma unroll
        for (int h = 0; h < 2; ++h)
#pragma unroll
            for (int i = 0; i < 2; ++i) v[h][i] = (unsigned)(u.pm * 256 + h * 128 + R[i]) * (unsigned)lda2 + (unsigned)(C[i] * 2);
    }
    __device__ __forceinline__ const char* b_ptr(const Unit& u) const { return Bt + (size_t)u.pn * 256 * ldb2; }
};

struct EpiInProj {
    static constexpr int NSTORE = 16;
    bf16_t* O; const float* gtab;
    __device__ __forceinline__ void init(f32x4 (&acc)[2][2][4][2], const Unit&, int, int, int, int) const {
#pragma unroll
        for (int a = 0; a < 2; ++a)
#pragma unroll
            for (int b = 0; b < 2; ++b)
#pragma unroll
                for (int m = 0; m < 4; ++m)
#pragma unroll
                    for (int n = 0; n < 2; ++n) acc[a][b][m][n] = (f32x4){0.f, 0.f, 0.f, 0.f};
    }
    __device__ __forceinline__ void operator()(const f32x4 (&acc)[2][2][4][2], const Unit& u, int wr, int wc, int fr, int fq) const {
#pragma unroll
        for (int bj = 0; bj < 2; ++bj) {
            const int col = u.pn * 256 + bj * 128 + wc * 32, grp = col >> 5;
            int t = -1;
            if (grp >= 40 && grp < 48) t = 0; else if (grp >= 48 && grp < 50) t = 1; else if (grp >= 56 && grp < 68) t = 2; else if (grp >= 68 && grp < 80) t = 3;
            int sh = 0;
            if (grp >= 56 && grp < 92) { const int gg = ((grp - 56) % 12) >> 2; sh = 2 * gg; }
            const int smask = (1 << sh) - 1, sstr = SEQ >> sh;
            bf16_t* const Ob = O + col + 8 * fq;
            const int row0 = u.pm * 256 + wr * 64 + fr;
            if (t >= 0) {
                const f32x4 g0 = *(const f32x4*)(gtab + t * 32 + 8 * fq), g1 = *(const f32x4*)(gtab + t * 32 + 8 * fq + 4);
#pragma unroll
                for (int ai = 0; ai < 2; ++ai)
#pragma unroll
                    for (int m = 0; m < 4; ++m) {
                        f32x4 v0 = acc[ai][bj][m][0], v1 = acc[ai][bj][m][1];
                        float s = (v0[0] * v0[0] + v0[1] * v0[1]) + (v0[2] * v0[2] + v0[3] * v0[3]) + (v1[0] * v1[0] + v1[1] * v1[1]) + (v1[2] * v1[2] + v1[3] * v1[3]);
                        s = x32_add(x16_add(s));
                        const float rs = __builtin_amdgcn_rsqf(s * (1.f / 32.f) + EPS);
                        v0 = v0 * rs * g0; v1 = v1 * rs * g1;
                        const int row = row0 + ai * 128 + m * 16, sq = row & (SEQ - 1);
                        *(u32x4*)(Ob + (size_t)((row & ~(SEQ - 1)) + (sq & smask) * sstr + (sq >> sh)) * PW) = pack8(v0, v1);
                    }
            } else {
#pragma unroll
                for (int ai = 0; ai < 2; ++ai)
#pragma unroll
                    for (int m = 0; m < 4; ++m) {
                        const int row = row0 + ai * 128 + m * 16, sq = row & (SEQ - 1);
                        *(u32x4*)(Ob + (size_t)((row & ~(SEQ - 1)) + (sq & smask) * sstr + (sq >> sh)) * PW) = pack8(acc[ai][bj][m][0], acc[ai][bj][m][1]);
                    }
            }
        }
    }
};
struct EpiBf16 {
    static constexpr int NSTORE = 16;
    bf16_t* O; int ldo; int coff;
    __device__ __forceinline__ void init(f32x4 (&acc)[2][2][4][2], const Unit&, int, int, int, int) const {
#pragma unroll
        for (int a = 0; a < 2; ++a)
#pragma unroll
            for (int b = 0; b < 2; ++b)
#pragma unroll
                for (int m = 0; m < 4; ++m)
#pragma unroll
                    for (int n = 0; n < 2; ++n) acc[a][b][m][n] = (f32x4){0.f, 0.f, 0.f, 0.f};
    }
    __device__ __forceinline__ void operator()(const f32x4 (&acc)[2][2][4][2], const Unit& u, int wr, int wc, int fr, int fq) const {
#pragma unroll
        for (int ai = 0; ai < 2; ++ai)
#pragma unroll
            for (int m = 0; m < 4; ++m) {
                const int row = u.pm * 256 + ai * 128 + wr * 64 + m * 16 + fr;
#pragma unroll
                for (int bj = 0; bj < 2; ++bj) *(u32x4*)(O + (size_t)row * ldo + coff + u.pn * 256 + bj * 128 + wc * 32 + 8 * fq) = pack8(acc[ai][bj][m][0], acc[ai][bj][m][1]);
            }
    }
};
struct EpiResid {
    static constexpr int NSTORE = 16;
    const void* res; int res_f32; bf16_t* out;
    __device__ __forceinline__ void init(f32x4 (&acc)[2][2][4][2], const Unit& u, int wr, int wc, int fr, int fq) const {
        if (res_f32) {
            const float* rf = (const float*)res;
#pragma unroll
            for (int ai = 0; ai < 2; ++ai)
#pragma unroll
                for (int m = 0; m < 4; ++m) {
                    const int row = u.pm * 256 + ai * 128 + wr * 64 + m * 16 + fr;
#pragma unroll
                    for (int bj = 0; bj < 2; ++bj) {
                        const size_t o = (size_t)row * DM + u.pn * 256 + bj * 128 + wc * 32 + 8 * fq;
                        acc[ai][bj][m][0] = *(const f32x4*)(rf + o); acc[ai][bj][m][1] = *(const f32x4*)(rf + o + 4);
                    }
                }
        } else {
            const bf16_t* rb = (const bf16_t*)res;
#pragma unroll
            for (int ai = 0; ai < 2; ++ai)
#pragma unroll
                for (int m = 0; m < 4; ++m) {
                    const int row = u.pm * 256 + ai * 128 + wr * 64 + m * 16 + fr;
#pragma unroll
                    for (int bj = 0; bj < 2; ++bj) {
                        const u32x4 w = *(const u32x4*)(rb + (size_t)row * DM + u.pn * 256 + bj * 128 + wc * 32 + 8 * fq);
                        acc[ai][bj][m][0] = unpk4(w.x, w.y); acc[ai][bj][m][1] = unpk4(w.z, w.w);
                    }
                }
        }
    }
    __device__ __forceinline__ void operator()(const f32x4 (&acc)[2][2][4][2], const Unit& u, int wr, int wc, int fr, int fq) const {
#pragma unroll
        for (int ai = 0; ai < 2; ++ai)
#pragma unroll
            for (int m = 0; m < 4; ++m) {
                const int row = u.pm * 256 + ai * 128 + wr * 64 + m * 16 + fr;
#pragma unroll
                for (int bj = 0; bj < 2; ++bj)
                    *(u32x4*)(out + (size_t)row * DM + u.pn * 256 + bj * 128 + wc * 32 + 8 * fq) = pack8(acc[ai][bj][m][0], acc[ai][bj][m][1]);
            }
    }
};
struct EpiSwiglu {
    static constexpr int NSTORE = 8;
    bf16_t* O; int ldo;
    __device__ __forceinline__ void init(f32x4 (&acc)[2][2][4][2], const Unit&, int, int, int, int) const {
#pragma unroll
        for (int a = 0; a < 2; ++a)
#pragma unroll
            for (int b = 0; b < 2; ++b)
#pragma unroll
                for (int m = 0; m < 4; ++m)
#pragma unroll
                    for (int n = 0; n < 2; ++n) acc[a][b][m][n] = (f32x4){0.f, 0.f, 0.f, 0.f};
    }
    __device__ __forceinline__ void operator()(const f32x4 (&acc)[2][2][4][2], const Unit& u, int wr, int wc, int fr, int fq) const {
#pragma unroll
        for (int ai = 0; ai < 2; ++ai)
#pragma unroll
            for (int m = 0; m < 4; ++m) {
                f32x4 v[2];
#pragma unroll
                for (int n = 0; n < 2; ++n)
#pragma unroll
                    for (int q = 0; q < 4; ++q) { const float g = acc[ai][0][m][n][q], uu = acc[ai][1][m][n][q]; v[n][q] = g * uu * rcpf(1.f + ex2(-g * LOG2E)); }
                const int row = u.pm * 256 + ai * 128 + wr * 64 + m * 16 + fr;
                *(u32x4*)(O + (size_t)row * ldo + u.pn * 128 + wc * 32 + 8 * fq) = pack8(v[0], v[1]);
            }
    }
};

struct MoeInfo {
    int cnt[16], ts[17];
    __device__ __forceinline__ void load(const unsigned* ctl) {
        int s = 0;
#pragma unroll
        for (int g = 0; g < 16; ++g) { cnt[g] = (int)__builtin_amdgcn_readfirstlane(ctl[CW_MOE + 64 * g]); ts[g] = s; s += (cnt[g] + 255) >> 8; }
        ts[16] = s;
    }
    __device__ __forceinline__ void find(int rt, int& g, int& t0, int& n) const {
        g = 0; t0 = 0; n = cnt[0];
#pragma unroll
        for (int q = 1; q < 16; ++q) if (rt >= ts[q]) { g = q; t0 = ts[q]; n = cnt[q]; }
    }
};
struct SchedMoeUp {
    static constexpr bool AFFINE = false; static constexpr int lda2 = 0;
    MoeInfo mi; const char* W; const int* mtok; int ldb2; int G, c; int u0, nu, sh;
    __device__ __forceinline__ size_t a_unit_off(const Unit&) const { return 0; }
    __device__ __forceinline__ bool next(int i, Unit& u) const {
        const int nM = mi.ts[16], nN = 6; const int q = i * G + c; if (q >= (nu << sh)) return false;
        const int L = u0 + (q >> sh);
        const int nig = 8 * nN, gid = L / nig, fm = gid * 8, wi = L % nig; int gsz = nM - fm; gsz = gsz < 8 ? gsz : 8;
        u.pm = fm + wi % gsz; u.pn = wi / gsz; int g, t0, n; mi.find(u.pm, g, t0, n); u.e = g; u.sa = q & ((1 << sh) - 1); u.sb = 0; return true;
    }
    __device__ __forceinline__ void a_offs(const Unit& u, const int (&R)[2], const int (&C)[2], unsigned (&v)[2][2]) const {
        int g, t0, n; mi.find(u.pm, g, t0, n);
#pragma unroll
        for (int h = 0; h < 2; ++h)
#pragma unroll
            for (int i = 0; i < 2; ++i) { const int pos = (u.pm - t0) * 256 + (u.sa + h) * 128 + R[i]; const int tok = pos < n ? mtok[g * NTOK + pos] : 0; v[h][i] = (unsigned)tok * 2048u + (unsigned)(C[i] * 2); }
    }
    __device__ __forceinline__ const char* b_ptr(const Unit& u) const { return W + (size_t)(u.e & 7) * (1536 * 1024 * 2) + (size_t)u.pn * 256 * 2048; }
};
struct SchedMoeDown {
    static constexpr bool AFFINE = true; static constexpr int lda2 = 1536;
    MoeInfo mi; const char* W; int ldb2; int r0, nM, G, c; int u0, nu, sh;
    __device__ __forceinline__ size_t a_unit_off(const Unit& u) const { return (size_t)u.pm * 256 * 1536; }
    __device__ __forceinline__ bool next(int i, Unit& u) const {
        const int nN = 4; const int q = i * G + c; if (q >= (nu << sh)) return false;
        const int L = u0 + (q >> sh), sub = q & ((1 << sh) - 1);
        const int nig = 8 * nN, gid = L / nig, fm = gid * 8, wi = L % nig; int gsz = nM - fm; gsz = gsz < 8 ? gsz : 8;
        u.pm = r0 + fm + wi % gsz; u.pn = wi / gsz; int g, t0, n; mi.find(u.pm, g, t0, n); u.e = g;
        u.sa = sh == 2 ? (sub >> 1) : sub; u.sb = sh == 2 ? (sub & 1) : 0; return true;
    }
    __device__ __forceinline__ void a_offs(const Unit& u, const int (&R)[2], const int (&C)[2], unsigned (&v)[2][2]) const {
#pragma unroll
        for (int h = 0; h < 2; ++h)
#pragma unroll
            for (int i = 0; i < 2; ++i) v[h][i] = (unsigned)(u.pm * 256 + h * 128 + R[i]) * 1536u + (unsigned)(C[i] * 2);
    }
    __device__ __forceinline__ const char* b_ptr(const Unit& u) const { return W + (size_t)(u.e & 7) * (1024 * 768 * 2) + (size_t)u.pn * 256 * 1536; }
};
struct EpiSwigluMoe {
    static constexpr int NSTORE = 8;
    MoeInfo mi; bf16_t* O; const float* mw;
    template <int SUB>
    __device__ __forceinline__ void init_sub(f32x4 (&acc)[2][2][4][2], const Unit&, int, int, int, int) const {
#pragma unroll
        for (int a = 0; a < (SUB ? 1 : 2); ++a)
#pragma unroll
            for (int b = 0; b < 2; ++b)
#pragma unroll
                for (int m = 0; m < 4; ++m)
#pragma unroll
                    for (int n = 0; n < 2; ++n) acc[a][b][m][n] = (f32x4){0.f, 0.f, 0.f, 0.f};
    }
    template <int SUB>
    __device__ __forceinline__ void run_sub(const f32x4 (&acc)[2][2][4][2], const Unit& u, int wr, int wc, int fr, int fq) const {
        constexpr int NA = SUB ? 1 : 2;
        int g, t0, n; mi.find(u.pm, g, t0, n);
        float wv[NA][4];
#pragma unroll
        for (int ai = 0; ai < NA; ++ai)
#pragma unroll
            for (int m = 0; m < 4; ++m) { const int pos = (u.pm - t0) * 256 + (u.sa + ai) * 128 + wr * 64 + m * 16 + fr; wv[ai][m] = pos < n ? mw[g * NTOK + pos] : 0.f; }
#pragma unroll
        for (int ai = 0; ai < NA; ++ai)
#pragma unroll
            for (int m = 0; m < 4; ++m) {
                f32x4 v[2];
#pragma unroll
                for (int nn = 0; nn < 2; ++nn)
#pragma unroll
                    for (int q = 0; q < 4; ++q) { const float gg = acc[ai][0][m][nn][q], uu = acc[ai][1][m][nn][q]; v[nn][q] = wv[ai][m] * gg * uu * rcpf(1.f + ex2(-gg * LOG2E)); }
                const int row = u.pm * 256 + (u.sa + ai) * 128 + wr * 64 + m * 16 + fr;
                *(u32x4*)(O + (size_t)row * 768 + u.pn * 128 + wc * 32 + 8 * fq) = pack8(v[0], v[1]);
            }
    }
    __device__ __forceinline__ void init(f32x4 (&acc)[2][2][4][2], const Unit& u, int wr, int wc, int fr, int fq) const { init_sub<0>(acc, u, wr, wc, fr, fq); }
    __device__ __forceinline__ void operator()(const f32x4 (&acc)[2][2][4][2], const Unit& u, int wr, int wc, int fr, int fq) const { run_sub<0>(acc, u, wr, wc, fr, fq); }
};
struct EpiMoeDown {
    static constexpr int NSTORE = 0;
    MoeInfo mi; const bf16_t* src; void* dst; int dst_f32; const int* mtok;
    template <int SUB>
    __device__ __forceinline__ void init_sub(f32x4 (&acc)[2][2][4][2], const Unit& u, int wr, int wc, int fr, int fq) const {
        constexpr int NA = SUB ? 1 : 2, NB = SUB == 2 ? 1 : 2;
        int g, t0, n; mi.find(u.pm, g, t0, n);
#pragma unroll
        for (int ai = 0; ai < NA; ++ai)
#pragma unroll
            for (int m = 0; m < 4; ++m) {
                const int pos = (u.pm - t0) * 256 + (u.sa + ai) * 128 + wr * 64 + m * 16 + fr;
                const int tok = pos < n ? mtok[g * NTOK + pos] : -1;
#pragma unroll
                for (int bj = 0; bj < NB; ++bj) {
                    if (tok >= 0) { const u32x4 w = *(const u32x4*)(src + (size_t)tok * DM + u.pn * 256 + (u.sb + bj) * 128 + wc * 32 + 8 * fq); acc[ai][bj][m][0] = unpk4(w.x, w.y); acc[ai][bj][m][1] = unpk4(w.z, w.w); }
                    else { acc[ai][bj][m][0] = (f32x4){0.f, 0.f, 0.f, 0.f}; acc[ai][bj][m][1] = (f32x4){0.f, 0.f, 0.f, 0.f}; }
                }
            }
    }
    template <int SUB>
    __device__ __forceinline__ void run_sub(const f32x4 (&acc)[2][2][4][2], const Unit& u, int wr, int wc, int fr, int fq) const {
        constexpr int NA = SUB ? 1 : 2, NB = SUB == 2 ? 1 : 2;
        int g, t0, n; mi.find(u.pm, g, t0, n);
        int tk[NA][4];
#pragma unroll
        for (int ai = 0; ai < NA; ++ai)
#pragma unroll
            for (int m = 0; m < 4; ++m) { const int pos = (u.pm - t0) * 256 + (u.sa + ai) * 128 + wr * 64 + m * 16 + fr; tk[ai][m] = pos < n ? mtok[g * NTOK + pos] : -1; }
        if (dst_f32) {
            float* out = (float*)dst;
#pragma unroll
            for (int ai = 0; ai < NA; ++ai)
#pragma unroll
                for (int m = 0; m < 4; ++m) {
                    if (tk[ai][m] >= 0) {
#pragma unroll
                        for (int bj = 0; bj < NB; ++bj) {
                            const size_t o = (size_t)tk[ai][m] * DM + u.pn * 256 + (u.sb + bj) * 128 + wc * 32 + 8 * fq;
                            *(f32x4*)(out + o) = acc[ai][bj][m][0]; *(f32x4*)(out + o + 4) = acc[ai][bj][m][1];
                        }
                    }
                }
        } else {
            bf16_t* out = (bf16_t*)dst;
#pragma unroll
            for (int ai = 0; ai < NA; ++ai)
#pragma unroll
                for (int m = 0; m < 4; ++m) {
                    if (tk[ai][m] >= 0) {
#pragma unroll
                        for (int bj = 0; bj < NB; ++bj)
                            *(u32x4*)(out + (size_t)tk[ai][m] * DM + u.pn * 256 + (u.sb + bj) * 128 + wc * 32 + 8 * fq) = pack8(acc[ai][bj][m][0], acc[ai][bj][m][1]);
                    }
                }
        }
    }
    __device__ __forceinline__ void init(f32x4 (&acc)[2][2][4][2], const Unit& u, int wr, int wc, int fr, int fq) const { init_sub<0>(acc, u, wr, wc, fr, fq); }
    __device__ __forceinline__ void operator()(const f32x4 (&acc)[2][2][4][2], const Unit& u, int wr, int wc, int fr, int fq) const { run_sub<0>(acc, u, wr, wc, fr, fq); }
};
}

__device__ __forceinline__ void st16_bf16(bf16_t* p, const f32x16& v) {
    u32x4 a, b;
    a.x = pk2(v[0], v[1]); a.y = pk2(v[2], v[3]); a.z = pk2(v[4], v[5]); a.w = pk2(v[6], v[7]);
    b.x = pk2(v[8], v[9]); b.y = pk2(v[10], v[11]); b.z = pk2(v[12], v[13]); b.w = pk2(v[14], v[15]);
    *(u32x4*)p = a; *(u32x4*)(p + 8) = b;
}
__device__ __forceinline__ void merge_phase(const Params& p, const Ctx& c0, int l) {
    const Ctx c = launder(c0);
    unsigned char* const wsl = launder_ptr(p.ws);
    LAS unsigned char* lds = c.lds + LDS_STAGE;
    const int tid = c.tid, lane = c.lane, wid = c.wid, wr = wid >> 2, wc = wid & 3, fr = lane & 15, fq = lane >> 4;
    const float* bneg = (const float*)(wsl + WS_TAB) + 20 * 132 + 256 + l * 4096; bf16_t* Y = (bf16_t*)(wsl + WS_Y);
    constexpr int HTB = 16384, KTB = 3 * HTB;
    const int NU = 256 * 4;
    int R[2], C[2];
    unsigned vAg[2], vAb[2], vB1[2], vB2[2];
#pragma unroll
    for (int i = 0; i < 2; ++i) { pg8::stage_rc(tid * 16 + i * 8192, R[i], C[i]); const int Rb = (R[i] & ~31) + pg8::perm32(R[i] & 31);
        vAg[i] = (unsigned)(R[i] * (PW * 2) + C[i] * 2); vAb[i] = (unsigned)(R[i] * (AOW * 2) + C[i] * 2); vB1[i] = (unsigned)(Rb * 256 + C[i] * 2); vB2[i] = (unsigned)(Rb * 512 + C[i] * 2); }
    const char* pPG = (const char*)(wsl + WS_PROJ) + PC_GLOW * 2; const char* pAO = (const char*)(wsl + WS_AO);
    const char* pGB = (const char*)(wsl + WS_WGB) + (size_t)l * 4096 * 128 * 2; const char* pBR = (const char*)(wsl + WS_WBR) + (size_t)l * 1024 * 1024 * 2;
    const unsigned ldsw = (unsigned)wid * 1024u;
    const int aoff = pg8::lds_byte(wr * 64 + fr, fq * 8), boff = pg8::lds_byte(wc * 32 + fr, fq * 8);
#define UNIT_OF(i, pm, pn, ok) do { const int L_ = (i) * c.G + (int)blockIdx.x; ok = L_ < NU; if (ok) { const int gid_ = L_ / 32, wi_ = L_ % 32; pm = gid_ * 8 + wi_ % 8; pn = wi_ / 8; } } while (0)
    int pml = 0, pnl = 0, jl = 0, iul = 0, bl = 0; bool okl = false;
    UNIT_OF(0, pml, pnl, okl);
    if (!okl) return;
#define L_STAGE() do { const int i_ = jl < 18 ? jl / 6 : 3, jj_ = jl - 6 * i_, nkb_ = i_ < 3 ? 4 : 2; const bool isg_ = jj_ >= nkb_; const int kc_ = isg_ ? jj_ - nkb_ : jj_; \
        const size_t lda2_ = isg_ ? PW * 2 : AOW * 2, ldb2_ = isg_ ? 256 : (i_ < 3 ? 512 : 256); \
        const char* ua_ = (isg_ ? pPG : pAO + i_ * 512) + kc_ * 128 + (size_t)pml * 128 * lda2_; \
        const char* ub_ = (isg_ ? pGB + (size_t)i_ * (1024 * 128 * 2) : pBR + (size_t)i_ * (1024 * 256 * 2)) + kc_ * 128 + (size_t)pnl * 256 * ldb2_; \
        LAS unsigned char* d_ = lds + bl * KTB + ldsw; \
        _Pragma("unroll") for (int q_ = 0; q_ < 2; ++q_) { \
            __builtin_amdgcn_global_load_lds((const unsigned*)(ua_ + (isg_ ? vAg[q_] : vAb[q_])), (LAS unsigned*)(d_ + q_ * 8192), 16, 0, 0); \
            __builtin_amdgcn_global_load_lds((const unsigned*)(ub_ + (ldb2_ == 256 ? vB1[q_] : vB2[q_])), (LAS unsigned*)(d_ + HTB + q_ * 8192), 16, 0, 0); \
            __builtin_amdgcn_global_load_lds((const unsigned*)(ub_ + 128 * ldb2_ + (ldb2_ == 256 ? vB1[q_] : vB2[q_])), (LAS unsigned*)(d_ + 2 * HTB + q_ * 8192), 16, 0, 0); } \
        bl = bl == 2 ? 0 : bl + 1; \
        if (jl + 1 < 22) ++jl; else { int pm2_ = 0, pn2_ = 0; bool ok2_; UNIT_OF(iul + 1, pm2_, pn2_, ok2_); if (ok2_) { ++iul; jl = 0; pml = pm2_; pnl = pn2_; } } } while (0)
#define L_WAITV(n) asm volatile("s_waitcnt vmcnt(" #n ")" ::: "memory")
#define L_BAR __builtin_amdgcn_s_barrier()
    bf16x8 At[4][2], B0[2][2], B1[2][2];
    f32x4 acc[2][4][2];
#define L_STEP() do { const LAS unsigned char* b_ = lds + bc * KTB; \
        _Pragma("unroll") for (int n = 0; n < 2; ++n) _Pragma("unroll") for (int k = 0; k < 2; ++k) { B0[n][k] = *(const LAS bf16x8*)(b_ + HTB + boff + n * 2048 + k * 1024); B1[n][k] = *(const LAS bf16x8*)(b_ + 2 * HTB + boff + n * 2048 + k * 1024); } \
        __builtin_amdgcn_sched_barrier(0); \
        _Pragma("unroll") for (int m = 0; m < 4; ++m) _Pragma("unroll") for (int k = 0; k < 2; ++k) At[m][k] = *(const LAS bf16x8*)(b_ + aoff + m * 2048 + k * 1024); \
        L_STAGE(); \
        L_WAITV(6); asm volatile("s_waitcnt lgkmcnt(0)" ::: "memory"); L_BAR; \
        __builtin_amdgcn_s_setprio(1); \
        _Pragma("unroll") for (int m = 0; m < 4; ++m) _Pragma("unroll") for (int n = 0; n < 2; ++n) _Pragma("unroll") for (int k = 0; k < 2; ++k) { \
            acc[0][m][n] = __builtin_amdgcn_mfma_f32_16x16x32_bf16(B0[n][k], At[m][k], acc[0][m][n], 0, 0, 0); \
            acc[1][m][n] = __builtin_amdgcn_mfma_f32_16x16x32_bf16(B1[n][k], At[m][k], acc[1][m][n], 0, 0, 0); } \
        __builtin_amdgcn_s_setprio(0); \
        L_BAR; __builtin_amdgcn_sched_barrier(0); \
        bc = bc == 2 ? 0 : bc + 1; } while (0)
    L_STAGE(); L_STAGE();
    L_WAITV(6); L_BAR;
    if (wr == 1) L_BAR;
    int bc = 0, pm = pml, pn = pnl; bool ok = true;
    pm = 0; pn = 0; UNIT_OF(0, pm, pn, ok);
#pragma unroll 1
    for (int iu = 0; ok; ++iu) {
        unsigned yy[2][4][2][2];
#pragma unroll
        for (int a = 0; a < 2; ++a)
#pragma unroll
            for (int m = 0; m < 4; ++m) { yy[a][m][0][0] = 0u; yy[a][m][0][1] = 0u; yy[a][m][1][0] = 0u; yy[a][m][1][1] = 0u; }
#pragma unroll 1
        for (int i = 0; i < 4; ++i) {
            const int nkb = i < 3 ? 4 : 2;
#pragma unroll
            for (int a = 0; a < 2; ++a)
#pragma unroll
                for (int m = 0; m < 4; ++m) { acc[a][m][0] = (f32x4){0.f, 0.f, 0.f, 0.f}; acc[a][m][1] = (f32x4){0.f, 0.f, 0.f, 0.f}; }
#pragma unroll 1
            for (int kc = 0; kc < nkb; ++kc) L_STEP();
            unsigned tpk[2][4][2][2];
            __builtin_amdgcn_sched_barrier(0);
#pragma unroll
            for (int bj = 0; bj < 2; ++bj) {
                int fqb = fq; asm volatile("" : "+v"(fqb));
                const float* bp = bneg + i * 1024 + pn * 256 + bj * 128 + wc * 32 + 8 * fqb;
                const f32x4 b0 = *(const f32x4*)bp, b1 = *(const f32x4*)(bp + 4);
#pragma unroll
                for (int m = 0; m < 4; ++m) {
#pragma unroll
                    for (int n = 0; n < 2; ++n) { tpk[bj][m][n][0] = pk2(acc[bj][m][n][0], acc[bj][m][n][1]); tpk[bj][m][n][1] = pk2(acc[bj][m][n][2], acc[bj][m][n][3]); }
                    acc[bj][m][0] = b0; acc[bj][m][1] = b1;
                }
            }
            __builtin_amdgcn_sched_barrier(0);
#pragma unroll 1
            for (int kc = 0; kc < 2; ++kc) L_STEP();
#pragma unroll
            for (int bj = 0; bj < 2; ++bj)
#pragma unroll
                for (int m = 0; m < 4; ++m)
#pragma unroll
                    for (int n = 0; n < 2; ++n) {
                        const float y0 = bflo(yy[bj][m][n][0]) + bflo(tpk[bj][m][n][0]) * rcpf(1.f + ex2(acc[bj][m][n][0]));
                        const float y1 = bfhi(yy[bj][m][n][0]) + bfhi(tpk[bj][m][n][0]) * rcpf(1.f + ex2(acc[bj][m][n][1]));
                        const float y2 = bflo(yy[bj][m][n][1]) + bflo(tpk[bj][m][n][1]) * rcpf(1.f + ex2(acc[bj][m][n][2]));
                        const float y3 = bfhi(yy[bj][m][n][1]) + bfhi(tpk[bj][m][n][1]) * rcpf(1.f + ex2(acc[bj][m][n][3]));
                        yy[bj][m][n][0] = pk2(y0, y1); yy[bj][m][n][1] = pk2(y2, y3);
                    }
        }
#pragma unroll
        for (int m = 0; m < 4; ++m) {
            int lb = lane; asm volatile("" : "+v"(lb));
            const int row = pm * 128 + wr * 64 + m * 16 + (lb & 15);
#pragma unroll
            for (int bj = 0; bj < 2; ++bj)
                *(u32x4*)(Y + (size_t)row * DM + pn * 256 + bj * 128 + wc * 32 + 8 * (lb >> 4)) = (u32x4){yy[bj][m][0][0], yy[bj][m][0][1], yy[bj][m][1][0], yy[bj][m][1][1]};
        }
        UNIT_OF(iu + 1, pm, pn, ok);
    }
    if (wr == 0) L_BAR;
    L_WAITV(0); L_BAR;
#undef UNIT_OF
#undef L_STAGE
#undef L_WAITV
#undef L_BAR
#undef L_STEP
}

__device__ __forceinline__ void mla_finalize(const Params& p, const Ctx& c0, int l) {
    const Ctx c = launder(c0);
    unsigned char* const wsl = launder_ptr(p.ws);
    const bf16_t* PROJ = (const bf16_t*)(wsl + WS_PROJ); const bf16_t* RAW = (const bf16_t*)(wsl + WS_H);
    bf16_t* QM = (bf16_t*)(wsl + WS_Y); bf16_t* KM = QM + (size_t)NTOK * 384; bf16_t* VM = KM + (size_t)NTOK * 384;
    const f32x2* rope = (const f32x2*)(wsl + WS_ROPE);
    const float* gq = p.in[I_GMLA] + l * 192; const float* gk = gq + 96;
    const int lane = c.lane, hd = lane >> 4, sub = lane & 15;
    const float SC = 0.10206207261596575f * LOG2E;
    f32x4 gqn = *(const f32x4*)(gq + 4 * sub), gkn = *(const f32x4*)(gk + 4 * sub);
    const float gq1 = gq[64 + sub], gq2 = gq[80 + sub], gk1 = gk[64 + sub], gk2 = gk[80 + sub];
    u32x2 n_cq, n_ck, n_qn, n_kn, n_vn; unsigned short n_x1, n_x2, n_p1, n_p2; f32x2 n_cs;
#define FIN_LOAD(m_) do { const bf16_t* pr_ = PROJ + (size_t)(m_) * PW; const bf16_t* rw_ = RAW + (size_t)(m_) * 1024; \
        n_cq = *(const u32x2*)(pr_ + PC_CQ + 4 * lane); n_ck = *(const u32x2*)(pr_ + PC_CKV + 4 * lane); n_cs = rope[(size_t)((m_) & (SEQ - 1)) * 16 + sub]; \
        n_qn = *(const u32x2*)(rw_ + hd * 96 + 4 * sub); n_x1 = rw_[hd * 96 + 64 + sub]; n_x2 = rw_[hd * 96 + 80 + sub]; \
        n_kn = *(const u32x2*)(rw_ + 512 + hd * 128 + 4 * sub); n_vn = *(const u32x2*)(rw_ + 512 + hd * 128 + 64 + 4 * sub); n_p1 = pr_[PC_KPE + sub]; n_p2 = pr_[PC_KPE + 16 + sub]; } while (0)
    if (c.gw < NTOK) FIN_LOAD(c.gw);
    for (int m = c.gw; m < NTOK; m += c.NGW) {
        const u32x2 cq = n_cq, ck = n_ck, qn = n_qn, kn = n_kn, vn = n_vn; const f32x2 cs = n_cs;
        const float x1r = bf2f(n_x1), x2r = bf2f(n_x2), p1 = bf2f(n_p1), p2 = bf2f(n_p2);
        if (m + c.NGW < NTOK) FIN_LOAD(m + c.NGW);
        float sq = bflo(cq.x) * bflo(cq.x) + bfhi(cq.x) * bfhi(cq.x) + bflo(cq.y) * bflo(cq.y) + bfhi(cq.y) * bfhi(cq.y);
        float sk = bflo(ck.x) * bflo(ck.x) + bfhi(ck.x) * bfhi(ck.x) + bflo(ck.y) * bflo(ck.y) + bfhi(ck.y) * bfhi(ck.y);
        const float rsq = __builtin_amdgcn_rsqf(wave_sum(sq) * (1.f / 256.f) + EPS), rsk = __builtin_amdgcn_rsqf(wave_sum(sk) * (1.f / 256.f) + EPS);
        float q0 = bflo(qn.x) * rsq, q1 = bfhi(qn.x) * rsq, q2 = bflo(qn.y) * rsq, q3 = bfhi(qn.y) * rsq;
        const float x1 = x1r * rsq, x2 = x2r * rsq;
        const float y1 = x1 * cs.x - x2 * cs.y, y2 = x2 * cs.x + x1 * cs.y;
        float ss = q0 * q0 + q1 * q1 + q2 * q2 + q3 * q3 + y1 * y1 + y2 * y2;
        ss = row16_sum(ss);
        float rr = __builtin_amdgcn_rsqf(ss * (1.f / 96.f) + EPS) * SC;
        bf16_t* qo = QM + (size_t)m * 384 + hd * 96;
        *(u32x2*)(qo + 4 * sub) = (u32x2){pk2(q0 * rr * gqn.x, q1 * rr * gqn.y), pk2(q2 * rr * gqn.z, q3 * rr * gqn.w)};
        qo[64 + sub] = (bf16_t)(pk2(y1 * rr * gq1, 0.f) & 0xffffu); qo[80 + sub] = (bf16_t)(pk2(y2 * rr * gq2, 0.f) & 0xffffu);
        float k0 = bflo(kn.x) * rsk, k1 = bfhi(kn.x) * rsk, k2 = bflo(kn.y) * rsk, k3 = bfhi(kn.y) * rsk;
        const float z1 = p1 * cs.x - p2 * cs.y, z2 = p2 * cs.x + p1 * cs.y;
        float sk2 = k0 * k0 + k1 * k1 + k2 * k2 + k3 * k3 + z1 * z1 + z2 * z2;
        sk2 = row16_sum(sk2);
        const float rk = __builtin_amdgcn_rsqf(sk2 * (1.f / 96.f) + EPS);
        const int bb = m >> 14, pos = m & (SEQ - 1), T = pos >> 6, kk = pos & 63;
        bf16_t* kt = KM + ((size_t)((bb * 4 + hd) * 256 + T)) * (12 * 64 * 8) + kk * 8;
        *(u32x2*)(kt + (sub >> 1) * 512 + 4 * (sub & 1)) = (u32x2){pk2(k0 * rk * gkn.x, k1 * rk * gkn.y), pk2(k2 * rk * gkn.z, k3 * rk * gkn.w)};
        kt[(8 + (sub >> 3)) * 512 + (sub & 7)] = (bf16_t)(pk2(z1 * rk * gk1, 0.f) & 0xffffu); kt[(10 + (sub >> 3)) * 512 + (sub & 7)] = (bf16_t)(pk2(z2 * rk * gk2, 0.f) & 0xffffu);
        bf16_t* vt_ = VM + ((size_t)((bb * 4 + hd) * 256 + T)) * (8 * 16 * 32) + ((sub >> 3) * 4 + (kk >> 4)) * 512 + (kk & 15) * 32 + (4 * sub & 31);
        *(u32x2*)vt_ = (u32x2){pk2(bflo(vn.x) * rsk, bfhi(vn.x) * rsk), pk2(bflo(vn.y) * rsk, bfhi(vn.y) * rsk)};
    }
#undef FIN_LOAD
}

__device__ __forceinline__ s16x4 tr16(const LAS unsigned char* p) { return __builtin_bit_cast(s16x4, __builtin_amdgcn_ds_read_tr16_b64_v4i16((LAS s16x4*)p)); }
__device__ __forceinline__ bf16x8 vfrag(const LAS unsigned char* vt, int VP, int s, int db, int lane) {
    const int hi = lane >> 5, q4 = (lane & 15) >> 2, pp = lane & 3, g1 = (lane >> 4) & 1;
    const LAS unsigned char* a = vt + (16 * s + 8 * hi + q4) * VP + (32 * db + 16 * g1 + 4 * pp) * 2;
    const s16x4 lo = tr16(a), hh = tr16(a + 4 * VP);
    return (bf16x8){lo[0], lo[1], lo[2], lo[3], hh[0], hh[1], hh[2], hh[3]};
}
__device__ __forceinline__ bf16x8 pfrag(const f32x16& pv, int s) {
    u32x4 w; w.x = pk2(pv[8 * s], pv[8 * s + 1]); w.y = pk2(pv[8 * s + 2], pv[8 * s + 3]); w.z = pk2(pv[8 * s + 4], pv[8 * s + 5]); w.w = pk2(pv[8 * s + 6], pv[8 * s + 7]);
    return mk8(w);
}
__device__ __forceinline__ float dot2_ones(unsigned pk, float c) { return __builtin_amdgcn_fdot2_f32_bf16(__builtin_bit_cast(bf16x2_t, pk), __builtin_bit_cast(bf16x2_t, 0x3F803F80u), c, false); }
__device__ __forceinline__ int keyof(int r, int hi) { return 16 * (r >> 3) + 8 * hi + (r & 7); }
__device__ __forceinline__ void store_ot(bf16_t* rowp, const f32x16& o, float sc, int hi) {
#pragma unroll
    for (int g = 0; g < 4; ++g) *(u32x2*)(rowp + 8 * g + 4 * hi) = (u32x2){pk2(o[4 * g] * sc, o[4 * g + 1] * sc), pk2(o[4 * g + 2] * sc, o[4 * g + 3] * sc)};
}

__device__ __forceinline__ void sb_unit(const Params& p, const Ctx& c0, int b, int h, int qt) {
    const Ctx c = launder(c0);
    unsigned char* const wsl = launder_ptr(p.ws);
    const bf16_t* PROJ = (const bf16_t*)(wsl + WS_PROJ); bf16_t* AO = (bf16_t*)(wsl + WS_AO);
    LAS unsigned char* vt = c.lds + LDS_VSCR + c.wid * 4608;
    const int lane = c.lane, r32 = lane & 31, hi = lane >> 5;
    const size_t tb = (size_t)b * SEQ;
    const bf16_t* qp = PROJ + (tb + qt * 32 + r32) * PW + PC_AQ + h * 64 + 8 * hi;
    bf16x8 qr[4];
#pragma unroll
    for (int d0 = 0; d0 < 4; ++d0) qr[d0] = *(const bf16x8*)(qp + 16 * d0);
    f32x16 o0 = (f32x16){}, o1 = (f32x16){};
    float R = 0.f;
    const int prow = pi32(r32);
    bf16x8 kf[4], nkf[4]; u32x4 vr[4], nvr[4];
#define SB_LOAD(KF, VR, kt_) do { const bf16_t* kp_ = PROJ + (tb + (kt_) * 32 + prow) * PW + PC_AK + h * 64 + 8 * hi; \
        _Pragma("unroll") for (int d0 = 0; d0 < 4; ++d0) KF[d0] = *(const bf16x8*)(kp_ + 16 * d0); \
        _Pragma("unroll") for (int i = 0; i < 4; ++i) { const int id = lane + 64 * i; VR[i] = *(const u32x4*)(PROJ + (tb + (kt_) * 32 + (id >> 3)) * PW + PC_AV + h * 64 + (id & 7) * 8); } } while (0)
    SB_LOAD(kf, vr, qt);
    for (int kt = qt; kt >= 0; --kt) {
        if (kt > 0) SB_LOAD(nkf, nvr, kt - 1);
        f32x16 z = (f32x16){};
#pragma unroll
        for (int d0 = 0; d0 < 4; ++d0) z = __builtin_amdgcn_mfma_f32_32x32x16_bf16(kf[d0], qr[d0], z, 0, 0, 0);
#pragma unroll
        for (int i = 0; i < 4; ++i) { const int id = lane + 64 * i; *(LAS u32x4*)(vt + (id >> 3) * 144 + (id & 7) * 16) = vr[i]; }
        f32x16 L; const bool diag = kt == qt;
#pragma unroll
        for (int r = 0; r < 16; ++r) {
            const float zz = z[r];
            float lv = -(fmaxf(zz, 0.f) + lg2(1.f + ex2(-fabsf(zz))));
            if (diag && keyof(r, hi) >= r32) lv = 0.f;
            L[r] = lv;
        }
        float ta = 0.f, tb2 = 0.f;
#pragma unroll
        for (int r = 0; r < 8; ++r) { ta += L[r]; tb2 += L[8 + r]; }
        const float pa = x32_other(ta, hi), pb = x32_other(tb2, hi);
        const float afterA = hi ? (pb + tb2) : (pa + tb2 + pb);
        const float afterB = hi ? 0.f : pb;
        f32x16 a;
        {
            float run = R + afterA;
#pragma unroll
            for (int r = 7; r >= 0; --r) { a[r] = ex2(z[r] + L[r] + run); run += L[r]; }
            run = R + afterB;
#pragma unroll
            for (int r = 15; r >= 8; --r) { a[r] = ex2(z[r] + L[r] + run); run += L[r]; }
        }
        if (diag) {
#pragma unroll
            for (int r = 0; r < 16; ++r) if (keyof(r, hi) >= r32) a[r] = 0.f;
        }
        R += (ta + pa) + (tb2 + pb);
#pragma unroll
        for (int s = 0; s < 2; ++s) {
            const bf16x8 pf = pfrag(a, s);
            o0 = __builtin_amdgcn_mfma_f32_32x32x16_bf16(vfrag(vt, 144, s, 0, lane), pf, o0, 0, 0, 0);
            o1 = __builtin_amdgcn_mfma_f32_32x32x16_bf16(vfrag(vt, 144, s, 1, lane), pf, o1, 0, 0, 0);
        }
        if (__all(R < -160.f)) break;
#pragma unroll
        for (int i = 0; i < 4; ++i) { kf[i] = nkf[i]; vr[i] = nvr[i]; }
    }
#undef SB_LOAD
    bf16_t* op = AO + (tb + qt * 32 + r32) * AOW + h * 64;
    store_ot(op, o0, 1.f, hi); store_ot(op + 32, o1, 1.f, hi);
}

__device__ __forceinline__ void local_attn(const bf16_t* PROJ, LAS unsigned char* vt, const LAS float* btab, int qcol, int kcol, int vcol,
                                           size_t tb, int dil, int rr, int m0, int W, int lane, f32x16& o, float& m, float& lsum) {
    const int r32 = lane & 31, hi = lane >> 5, prow = pi32(r32);
    const bf16_t* qp = PROJ + (tb + (size_t)(m0 + r32) * dil + rr) * PW + qcol + 8 * hi;
    const bf16x8 q0 = *(const bf16x8*)qp, q1 = *(const bf16x8*)(qp + 16);
    bf16x8 kf[5][2]; u32x4 vr[5][2];
#pragma unroll
    for (int ti = 0; ti < 5; ++ti) {
        const int k0 = m0 - 128 + 32 * ti;
        if (k0 >= 0) {
            const bf16_t* kp = PROJ + (tb + (size_t)(k0 + prow) * dil + rr) * PW + kcol + 8 * hi;
            kf[ti][0] = *(const bf16x8*)kp; kf[ti][1] = *(const bf16x8*)(kp + 16);
#pragma unroll
            for (int i = 0; i < 2; ++i) { const int id = lane + 64 * i; vr[ti][i] = *(const u32x4*)(PROJ + (tb + (size_t)(k0 + (id >> 2)) * dil + rr) * PW + vcol + (id & 3) * 8); }
        } else { kf[ti][0] = kf[ti][1] = (bf16x8){}; vr[ti][0] = vr[ti][1] = (u32x4){0u, 0u, 0u, 0u}; }
    }
    o = (f32x16){}; m = -1e30f; lsum = 0.f;
#pragma unroll
    for (int ti = 0; ti < 5; ++ti) {
        const int dl = 128 - 32 * ti, k0 = m0 - dl;
        if (k0 < 0) continue;
        f32x16 s = (f32x16){};
        s = __builtin_amdgcn_mfma_f32_32x32x16_bf16(kf[ti][0], q0, s, 0, 0, 0);
        s = __builtin_amdgcn_mfma_f32_32x32x16_bf16(kf[ti][1], q1, s, 0, 0, 0);
#pragma unroll
        for (int i = 0; i < 2; ++i) { const int id = lane + 64 * i; *(LAS u32x4*)(vt + (id >> 2) * 80 + (id & 3) * 16) = vr[ti][i]; }
        float mx = -INFINITY;
#pragma unroll
        for (int r = 0; r < 16; ++r) {
            const int dist = dl + r32 - keyof(r, hi);
            const int di = dist < 0 ? 0 : (dist > 131 ? 131 : dist);
            float v = s[r] + btab[di];
            if (dl == 0) { if (dist < 0) v = -INFINITY; }
            if (dl == 128) { if (dist > W) v = -INFINITY; }
            s[r] = v; mx = fmaxf(mx, v);
        }
        mx = x32_max(mx);
        const float mn = fmaxf(m, mx), f = ex2(m - mn);
        m = mn;
        float ps = 0.f;
#pragma unroll
        for (int r = 0; r < 16; ++r) { s[r] = ex2(s[r] - mn); ps += s[r]; }
        lsum = lsum * f + ps;
#pragma unroll
        for (int r = 0; r < 16; ++r) o[r] *= f;
#pragma unroll
        for (int st = 0; st < 2; ++st) o = __builtin_amdgcn_mfma_f32_32x32x16_bf16(vfrag(vt, 80, st, 0, lane), pfrag(s, st), o, 0, 0, 0);
    }
}

__device__ __forceinline__ void sw_unit(const Params& p, const Ctx& c0, int l, int b, int hq, int qt) {
    const Ctx c = launder(c0);
    unsigned char* const wsl = launder_ptr(p.ws);
    const bf16_t* PROJ = (const bf16_t*)(wsl + WS_PROJ); bf16_t* AO = (bf16_t*)(wsl + WS_AO);
    LAS unsigned char* vt = c.lds + LDS_VSCR + c.wid * 4608;
    const LAS float* btab = (const LAS float*)(c.lds + LDS_BTAB) + hq * 132;
    const int lane = c.lane, r32 = lane & 31, hi = lane >> 5, kv = hq >> 2;
    f32x16 o; float m, ls;
    local_attn(PROJ, vt, btab, PC_SWQ + hq * 32, PC_SWK + kv * 32, PC_SWV + kv * 32, (size_t)b * SEQ, 1, 0, qt * 32, 127, lane, o, m, ls);
    ls = x32_add(ls);
    const float sk = p.in[I_SINKS][l * 8 + hq] * LOG2E;
    const float mf = fmaxf(m, sk), f = ex2(m - mf);
    const float den = ls * f + ex2(sk - mf);
    store_ot(AO + ((size_t)b * SEQ + qt * 32 + r32) * AOW + 512 + hq * 32, o, f * rcpf(den), hi);
}

__device__ __forceinline__ void dil_unit(const Params& p, const Ctx& c0, int b, int tblk, int h) {
    const Ctx c = launder(c0);
    unsigned char* const wsl = launder_ptr(p.ws);
    const bf16_t* PROJ = (const bf16_t*)(wsl + WS_PROJ); bf16_t* AO = (bf16_t*)(wsl + WS_AO);
    LAS unsigned char* vt = c.lds + LDS_VSCR + c.wid * 4608;
    LAS bf16_t* obuf = (LAS bf16_t*)(c.lds + LDS_DOBUF); LAS float* lse = (LAS float*)(c.lds + LDS_DLSE);
    const int lane = c.lane, r32 = lane & 31, hi = lane >> 5;
    const int T0 = tblk * 512;
#pragma unroll 1
    for (int g = 0; g < 3; ++g) {
        const int dil = g == 0 ? 1 : (g == 1 ? 4 : 16), sh = g == 0 ? 0 : (g == 1 ? 2 : 4);
        const LAS float* btab = (const LAS float*)(c.lds + LDS_BTAB) + (8 + 4 * g + h) * 132;
#pragma unroll 1
        for (int jj = 0; jj < 2; ++jj) {
            const int j = 2 * c.wid + jj;
            const int ntr = 16 >> sh;
            const int rr = j / ntr, sub = j % ntr;
            const int m0 = (T0 >> sh) + 32 * sub;
            f32x16 o; float m, ls;
            local_attn(PROJ, vt, btab, PC_DQ + g * 128 + h * 32, PC_DK + g * 128 + h * 32, PC_DV + g * 128 + h * 32, (size_t)b * SEQ + (size_t)rr * (SEQ >> sh), 1, 0, m0, 128, lane, o, m, ls);
            ls = x32_add(ls);
            const float inv = rcpf(ls);
            const int tl = ((m0 + r32) << sh) + rr - T0;
            LAS bf16_t* ob = obuf + (tl * 3 + g) * 32;
#pragma unroll
            for (int q = 0; q < 4; ++q) *(LAS u32x2*)(ob + 8 * q + 4 * hi) = (u32x2){pk2(o[4 * q] * inv, o[4 * q + 1] * inv), pk2(o[4 * q + 2] * inv, o[4 * q + 3] * inv)};
            if (hi == 0) lse[tl * 3 + g] = m + lg2(ls);
        }
    }
    __syncthreads();
    {
        const int tl = c.tid;
        const float l0 = lse[tl * 3], l1 = lse[tl * 3 + 1], l2 = lse[tl * 3 + 2];
        const float mx = fmaxf(l0, fmaxf(l1, l2));
        float w0 = ex2(l0 - mx), w1 = ex2(l1 - mx), w2 = ex2(l2 - mx); const float iv = rcpf(w0 + w1 + w2); w0 *= iv; w1 *= iv; w2 *= iv;
        const LAS u32x4* ob = (const LAS u32x4*)(obuf + tl * 96);
        u32x4* dst = (u32x4*)(AO + ((size_t)b * SEQ + T0 + tl) * AOW + 768 + h * 32);
#pragma unroll
        for (int q = 0; q < 4; ++q) {
            const u32x4 a = ob[q], bq = ob[4 + q], cq = ob[8 + q];
            u32x4 r;
            r.x = pk2(w0 * bflo(a.x) + w1 * bflo(bq.x) + w2 * bflo(cq.x), w0 * bfhi(a.x) + w1 * bfhi(bq.x) + w2 * bfhi(cq.x));
            r.y = pk2(w0 * bflo(a.y) + w1 * bflo(bq.y) + w2 * bflo(cq.y), w0 * bfhi(a.y) + w1 * bfhi(bq.y) + w2 * bfhi(cq.y));
            r.z = pk2(w0 * bflo(a.z) + w1 * bflo(bq.z) + w2 * bflo(cq.z), w0 * bfhi(a.z) + w1 * bfhi(bq.z) + w2 * bfhi(cq.z));
            r.w = pk2(w0 * bflo(a.w) + w1 * bflo(bq.w) + w2 * bflo(cq.w), w0 * bfhi(a.w) + w1 * bfhi(bq.w) + w2 * bfhi(cq.w));
            dst[q] = r;
        }
    }
    __syncthreads();
}

#ifndef MLA_BIG
#define MLA_BIG 1.0995116e12f
#endif
constexpr int MK_SLOT = 12288, MV_SLOT = 8192, MLA_VOFF = 5 * MK_SLOT;
__device__ __forceinline__ void mla_qk(const LAS unsigned char* ks, const bf16x8 (&qr)[6], const f32x16& negm, int prow, int hi, f32x16& s0, f32x16& s1) {
    bf16x8 kf[12];
    const LAS unsigned char* kp = ks + hi * 1024 + prow * 16;
#pragma unroll
    for (int d0 = 0; d0 < 6; ++d0) { kf[2 * d0] = *(const LAS bf16x8*)(kp + d0 * 2048); kf[2 * d0 + 1] = *(const LAS bf16x8*)(kp + d0 * 2048 + 512); }
    __builtin_amdgcn_sched_barrier(0);
    s0 = __builtin_amdgcn_mfma_f32_32x32x16_bf16(kf[0], qr[0], negm, 0, 0, 0);
    s1 = __builtin_amdgcn_mfma_f32_32x32x16_bf16(kf[1], qr[0], negm, 0, 0, 0);
#pragma unroll
    for (int d0 = 1; d0 < 6; ++d0) {
        s0 = __builtin_amdgcn_mfma_f32_32x32x16_bf16(kf[2 * d0], qr[d0], s0, 0, 0, 0);
        s1 = __builtin_amdgcn_mfma_f32_32x32x16_bf16(kf[2 * d0 + 1], qr[d0], s1, 0, 0, 0);
    }
    __builtin_amdgcn_sched_barrier(0);
}
__device__ __forceinline__ bf16x8 mla_vfrag(const LAS unsigned char* vs, int s, int db, int lane) {
    const int hi = lane >> 5, q4 = (lane & 15) >> 2, pp = lane & 3, g1 = (lane >> 4) & 1;
    const LAS unsigned char* a = vs + (db * 4 + s) * 1024 + (8 * hi + q4) * 64 + (16 * g1 + 4 * pp) * 2;
    const s16x4 lo = tr16(a), hh = tr16(a + 256);
    return (bf16x8){lo[0], lo[1], lo[2], lo[3], hh[0], hh[1], hh[2], hh[3]};
}
__device__ __forceinline__ float max3f(float a, float b, float c) { return fmaxf(fmaxf(a, b), c); }
__device__ __forceinline__ float rowmax32(const f32x16& a, const f32x16& b) {
    float x = max3f(a[0], a[1], a[2]), y = max3f(b[0], b[1], b[2]);
    x = max3f(x, a[3], a[4]); y = max3f(y, b[3], b[4]); x = max3f(x, a[5], a[6]); y = max3f(y, b[5], b[6]);
    x = max3f(x, a[7], a[8]); y = max3f(y, b[7], b[8]); x = max3f(x, a[9], a[10]); y = max3f(y, b[9], b[10]);
    x = max3f(x, a[11], a[12]); y = max3f(y, b[11], b[12]); x = max3f(x, a[13], a[14]); y = max3f(y, b[13], b[14]);
    return max3f(x, y, fmaxf(a[15], b[15]));
}
__device__ __forceinline__ void mla_unit(const Params& p, const Ctx& c0, int b, int h, int qb) {
    const Ctx c = launder(c0);
    unsigned char* const wsl = launder_ptr(p.ws);
    const bf16_t* QM = (const bf16_t*)(wsl + WS_Y);
    bf16_t* AO = (bf16_t*)(wsl + WS_AO);
    LAS unsigned char* buf = c.lds + LDS_MLA;
    const int lane = c.lane, wid = c.wid, r32 = lane & 31, hi = lane >> 5, prow = pi32(r32);
    const size_t tb = (size_t)b * SEQ; const int q0 = qb * 256, qw0 = q0 + wid * 32;
    const bf16_t* qp = QM + (tb + qw0 + r32) * 384 + h * 96 + 8 * hi;
    bf16x8 qr[6];
#pragma unroll
    for (int d0 = 0; d0 < 6; ++d0) qr[d0] = *(const bf16x8*)(qp + 16 * d0);
    const int NT = (q0 + 256) / 64;
    const __amdgpu_buffer_rsrc_t rs = __builtin_amdgcn_make_buffer_rsrc((void*)wsl, (short)0, 0x7fffffff, 0x00020000);
    const unsigned ldsb = (unsigned)(__SIZE_TYPE__)buf;
    const unsigned kvo = (unsigned)lane * 16u;
    const unsigned kso = (unsigned)(WS_Y + (size_t)NTOK * 384 * 2) + (unsigned)(((size_t)(b * 4 + h) * 256) * (12 * 1024)), vso = (unsigned)(WS_Y + (size_t)NTOK * 768 * 2) + (unsigned)(((size_t)(b * 4 + h) * 256) * (8 * 1024));
#define MLA_DMA_K(t) do { if (wid < 4) { const unsigned m0_ = ldsb + (unsigned)((t) % 5) * MK_SLOT + (unsigned)wid * 1024u, so_ = kso + (unsigned)(t) * 12288u + (unsigned)wid * 1024u; \
        DMA16(m0_, kvo, rs, so_); DMA16(m0_ + 4096u, kvo, rs, so_ + 4096u); DMA16(m0_ + 8192u, kvo, rs, so_ + 8192u); } } while (0)
#define MLA_DMA_V(t) do { if (wid < 4) { const unsigned m0_ = ldsb + MLA_VOFF + (unsigned)((t) & 3) * MV_SLOT + (unsigned)wid * 1024u, so_ = vso + (unsigned)(t) * 8192u + (unsigned)wid * 1024u; \
        DMA16(m0_, kvo, rs, so_); DMA16(m0_ + 4096u, kvo, rs, so_ + 4096u); } } while (0)
#define MLA_SYNC() asm volatile("s_waitcnt vmcnt(0)\n\ts_barrier" ::: "memory")
    MLA_DMA_K(0); MLA_DMA_V(0); MLA_DMA_K(1); MLA_DMA_V(1); MLA_DMA_K(2); MLA_DMA_K(3);
    MLA_SYNC();
    f32x16 o0 = (f32x16){}, o1 = (f32x16){}, sA0, sA1, sB0, sB1, negm = (f32x16){};
    unsigned pkA[16], pkB[16];
    float m, ls = 0.f;
    {
        mla_qk(buf, qr, negm, prow, hi, sA0, sA1);
        if (qw0 < 63) {
            const int q8 = qw0 + r32 - 8 * hi;
#pragma unroll
            for (int r = 0; r < 16; ++r) { if (16 * (r >> 3) + (r & 7) > q8) sA0[r] = -INFINITY; if (32 + 16 * (r >> 3) + (r & 7) > q8) sA1[r] = -INFINITY; }
        }
        float mx = rowmax32(sA0, sA1);
        mx = x32_max(mx);
        m = mx;
#pragma unroll
        for (int r = 0; r < 16; ++r) { sA0[r] -= m; sA1[r] -= m; negm[r] = -m; }
    }
#define MLA_PV_HALF(PKP, vs_, sh) do { \
          const bf16x8 pa_ = mk8((u32x4){PKP[8 * (sh)], PKP[8 * (sh) + 1], PKP[8 * (sh) + 2], PKP[8 * (sh) + 3]}), pb_ = mk8((u32x4){PKP[8 * (sh) + 4], PKP[8 * (sh) + 5], PKP[8 * (sh) + 6], PKP[8 * (sh) + 7]}); \
          o0 = __builtin_amdgcn_mfma_f32_32x32x16_bf16(vf_[0], pa_, o0, 0, 0, 0); o1 = __builtin_amdgcn_mfma_f32_32x32x16_bf16(vf_[1], pa_, o1, 0, 0, 0); \
          o0 = __builtin_amdgcn_mfma_f32_32x32x16_bf16(vf_[2], pb_, o0, 0, 0, 0); o1 = __builtin_amdgcn_mfma_f32_32x32x16_bf16(vf_[3], pb_, o1, 0, 0, 0); } while (0)
#define MLA_VLOAD(vs_, sh) do { vf_[0] = mla_vfrag(vs_, 2 * (sh), 0, lane); vf_[1] = mla_vfrag(vs_, 2 * (sh), 1, lane); vf_[2] = mla_vfrag(vs_, 2 * (sh) + 1, 0, lane); vf_[3] = mla_vfrag(vs_, 2 * (sh) + 1, 1, lane); } while (0)
#define MLA_STEP(C0, C1, N0, N1, PKP, PKC, t, PVON) do { \
        const bool deep_ = (t) + 4 < NT; \
        if (64 * ((t) - 1) <= qw0 + 31) {            \
        if ((t) > 0 && 64 * (t) + 63 > qw0) { const int q8_ = qw0 + r32 - 64 * (t) - 8 * hi; \
            _Pragma("unroll") for (int r = 0; r < 16; ++r) { if (16 * (r >> 3) + (r & 7) > q8_) C0[r] = -INFINITY; if (32 + 16 * (r >> 3) + (r & 7) > q8_) C1[r] = -INFINITY; } } \
        float ps_ = 0.f, pt_ = 0.f; \
        { const LAS unsigned char* kp_ = buf + (((t) + 1) % 5) * MK_SLOT + hi * 1024 + prow * 16; \
          const LAS unsigned char* vs_ = buf + MLA_VOFF + (((t) + 3) & 3) * MV_SLOT;        \
          bf16x8 kf_[6], vf_[4]; \
          _Pragma("unroll") for (int d0 = 0; d0 < 3; ++d0) { kf_[2 * d0] = *(const LAS bf16x8*)(kp_ + d0 * 2048); kf_[2 * d0 + 1] = *(const LAS bf16x8*)(kp_ + d0 * 2048 + 512); } \
          if (PVON) MLA_VLOAD(vs_, 0); \
          __builtin_amdgcn_sched_barrier(0); \
          N0 = __builtin_amdgcn_mfma_f32_32x32x16_bf16(kf_[0], qr[0], negm, 0, 0, 0); \
          N1 = __builtin_amdgcn_mfma_f32_32x32x16_bf16(kf_[1], qr[0], negm, 0, 0, 0); \
          _Pragma("unroll") for (int d0 = 1; d0 < 3; ++d0) { \
              N0 = __builtin_amdgcn_mfma_f32_32x32x16_bf16(kf_[2 * d0], qr[d0], N0, 0, 0, 0); \
              N1 = __builtin_amdgcn_mfma_f32_32x32x16_bf16(kf_[2 * d0 + 1], qr[d0], N1, 0, 0, 0); } \
          if (PVON) MLA_PV_HALF(PKP, vs_, 0); \
          _Pragma("unroll") for (int r = 0; r < 8; ++r) { PKC[r] = pk2(ex2(C0[2 * r]), ex2(C0[2 * r + 1])); ps_ = dot2_ones(PKC[r], ps_); } \
          _Pragma("unroll") for (int g_ = 0; g_ < (PVON ? 10 : 6); ++g_) { __builtin_amdgcn_sched_group_barrier(0x008, 1, 0); __builtin_amdgcn_sched_group_barrier(0x002, (PVON ? 3 : 4), 0); } \
          __builtin_amdgcn_sched_barrier(0); \
          _Pragma("unroll") for (int d0 = 3; d0 < 6; ++d0) { kf_[2 * d0 - 6] = *(const LAS bf16x8*)(kp_ + d0 * 2048); kf_[2 * d0 - 5] = *(const LAS bf16x8*)(kp_ + d0 * 2048 + 512); } \
          if (PVON) MLA_VLOAD(vs_, 1); \
          __builtin_amdgcn_sched_barrier(0); \
          _Pragma("unroll") for (int d0 = 3; d0 < 6; ++d0) { \
              N0 = __builtin_amdgcn_mfma_f32_32x32x16_bf16(kf_[2 * d0 - 6], qr[d0], N0, 0, 0, 0); \
              N1 = __builtin_amdgcn_mfma_f32_32x32x16_bf16(kf_[2 * d0 - 5], qr[d0], N1, 0, 0, 0); } \
          if (PVON) MLA_PV_HALF(PKP, vs_, 1); \
          _Pragma("unroll") for (int r = 0; r < 8; ++r) { PKC[8 + r] = pk2(ex2(C1[2 * r]), ex2(C1[2 * r + 1])); pt_ = dot2_ones(PKC[8 + r], pt_); } \
          _Pragma("unroll") for (int g_ = 0; g_ < (PVON ? 10 : 6); ++g_) { __builtin_amdgcn_sched_group_barrier(0x008, 1, 0); __builtin_amdgcn_sched_group_barrier(0x002, (PVON ? 3 : 4), 0); } \
          __builtin_amdgcn_sched_barrier(0); } \
          \
        if (__any(!(ps_ + pt_ < MLA_BIG))) { \
            mla_qk(buf + ((t) % 5) * MK_SLOT, qr, negm, prow, hi, C0, C1); \
            if (64 * (t) + 63 > qw0) { const int q8_ = qw0 + r32 - 64 * (t) - 8 * hi; \
                _Pragma("unroll") for (int r = 0; r < 16; ++r) { if (16 * (r >> 3) + (r & 7) > q8_) C0[r] = -INFINITY; if (32 + 16 * (r >> 3) + (r & 7) > q8_) C1[r] = -INFINITY; } } \
            float mx_ = rowmax32(C0, C1); \
            mx_ = x32_max(mx_); \
            const float d_ = fmaxf(mx_, 0.f), f_ = ex2(-d_); m += d_; ls *= f_; \
            ps_ = 0.f; pt_ = 0.f; \
            _Pragma("unroll") for (int r = 0; r < 16; ++r) { o0[r] *= f_; o1[r] *= f_; negm[r] = -m; N0[r] -= d_; N1[r] -= d_; } \
            _Pragma("unroll") for (int r = 0; r < 8; ++r) { PKC[r] = pk2(ex2(C0[2 * r] - d_), ex2(C0[2 * r + 1] - d_)); PKC[8 + r] = pk2(ex2(C1[2 * r] - d_), ex2(C1[2 * r + 1] - d_)); ps_ = dot2_ones(PKC[r], ps_); pt_ = dot2_ones(PKC[8 + r], pt_); } \
        } \
        ls += ps_ + pt_; \
        } \
          \
        if (deep_) { MLA_DMA_K((t) + 4); MLA_DMA_V((t) + 2); } else if ((t) + 2 < NT) MLA_DMA_V((t) + 2); \
        if (deep_) asm volatile("s_waitcnt vmcnt(10)\n\ts_barrier" ::: "memory"); \
        else MLA_SYNC(); \
    } while (0)
    MLA_STEP(sA0, sA1, sB0, sB1, pkB, pkA, 0, false);
#pragma unroll 1
    for (int t = 1; t < NT; t += 2) {
        MLA_STEP(sB0, sB1, sA0, sA1, pkA, pkB, t, true);
        MLA_STEP(sA0, sA1, sB0, sB1, pkB, pkA, t + 1, true);
    }
    ls = x32_add(ls);
    const float inv = rcpf(ls);
    bf16_t* op = AO + (tb + qw0 + r32) * AOW + 256 + h * 64;
    store_ot(op, o0, inv, hi); store_ot(op + 32, o1, inv, hi);
#undef MLA_STEP
#undef MLA_VLOAD
#undef MLA_PV_HALF
#undef MLA_DMA_K
#undef MLA_DMA_V
#undef MLA_SYNC
}

__device__ __forceinline__ void attention_phase(const Params& p, const Ctx& c0, int l) {
    const Ctx c = launder(c0);
    unsigned char* const wsl = launder_ptr(p.ws);
    { const float* bt = (const float*)(wsl + WS_TAB); LAS float* lb = (LAS float*)(c.lds + LDS_BTAB); for (int i = c.tid; i < 20 * 132; i += NWG_THREADS) lb[i] = bt[i]; }
    __syncthreads();
    for (int rep = 0; rep < REPS(16); ++rep) for (int u = c.gw; u < 4096; u += c.NGW) { const int qt = u & 511, h = (u >> 9) & 3, b = u >> 11; sb_unit(p, c, b, h, qt); }
    for (int rep = 0; rep < REPS(16); ++rep) for (int u = c.gw; u < 8192; u += c.NGW) { const int qt = u & 511, hq = (u >> 9) & 7, b = u >> 12; sw_unit(p, c, l, b, hq, qt); }
    for (int rep = 0; rep < REPS(18); ++rep) for (int u = c.vcu; u < 256; u += c.G) { const int h = u & 3, tblk = (u >> 2) & 31, b = u >> 7; dil_unit(p, c, b, tblk, h); }
    for (int rep = 0; rep < REPS(19); ++rep) for (int v = c.vcu; v < 256; v += c.G) {
        const int bh = v >> 5, s = v & 31;
#pragma unroll 1
        for (int i = 0; i < 2; ++i) mla_unit(p, c, bh >> 2, bh & 3, i ? s : 63 - s);
    }
}

__global__ void __launch_bounds__(NWG_THREADS, 2) fwd_kernel(Params p) {
    extern __shared__ __attribute__((aligned(16))) unsigned char lds_raw[];
    Ctx c;
    c.lds = (LAS unsigned char*)lds_raw;
    c.tid = threadIdx.x; c.lane = c.tid & 63; c.wid = __builtin_amdgcn_readfirstlane(c.tid >> 6);
    c.G = gridDim.x; { const int bx = blockIdx.x; c.vcu = (c.G % 8 == 0) ? (bx % 8) * (c.G / 8) + bx / 8 : bx; }
    c.gw = blockIdx.x * 8 + c.wid; c.NGW = c.G * 8;
    volatile LAS unsigned* lctl = (volatile LAS unsigned*)(c.lds + LDS_CTL);
    if (c.tid < 64) lctl[c.tid] = 0u;
    __syncthreads();
    unsigned* ctl = (unsigned*)(p.ws + WS_CTL);
    XcdBarrier bar = xcd_barrier_post(ctl + CW_BAR, lctl + 8);
    bar.x = (unsigned)__builtin_amdgcn_readfirstlane((int)bar.x);
    const int bx = blockIdx.x;

    for (int rep = 0; rep < REPS(0); ++rep) prologue(p, c);
#pragma unroll 1
    for (int l = 0; l < 2; ++l) {
        unsigned char* ws = launder_ptr(p.ws);
        bf16_t* H = (bf16_t*)(ws + WS_H); bf16_t* PROJ = (bf16_t*)(ws + WS_PROJ); bf16_t* Y = (bf16_t*)(ws + WS_Y);
        bf16_t* const RS = (bf16_t*)p.out;
        const void* xin = l == 0 ? (const void*)p.in[I_X] : (const void*)RS;
        for (int rep = 0; rep < REPS(1); ++rep) rmsnorm_phase<false>(p, c, xin, l == 0, p.in[I_N1G] + l * DM, H, nullptr, nullptr);
        xcd_barrier(bar);
        if (PH(2)) for (int rep = 0; rep < REPS(2); ++rep) {
            if (rep) xcd_barrier(bar);
            pg8::SchedPlain S{(const char*)(ws + WS_WIN) + (size_t)l * PW * 1024 * 2, DM * 2, 1024 * 2, 128, 12, c.G, bx, 1};
            pg8::EpiInProj E{PROJ, (const float*)(ws + WS_TAB) + 20 * 132 + l * 128};
            pg8::gemm_phase<pg8::EpiInProj, pg8::SchedPlain, true>(c, (const char*)H, 1024, S, E);
        }
        xcd_barrier(bar);
        for (int rep = 0; rep < REPS(3); ++rep) {
#pragma unroll 1
            for (int q = 0; q < 2; ++q) {
                pg8::SchedPlain S{(const char*)(ws + (q ? WS_WKV : WS_WQ)) + (size_t)l * 512 * 256 * 2, PW * 2, 256 * 2, 128, 2, c.G, bx, 0};
                pg8::EpiBf16 E{H, 1024, q * 512};
                pg8::gemm_phase<pg8::EpiBf16, pg8::SchedPlain, true>(c, (const char*)(PROJ + (q ? PC_CKV : PC_CQ)), 256, S, E);
            }
        }
        xcd_barrier(bar);
        for (int rep = 0; rep < REPS(4); ++rep) mla_finalize(p, c, l);
        xcd_barrier(bar);
        if (PH(5)) for (int rep = 0; rep < REPS(5); ++rep) { if (rep) xcd_barrier(bar); attention_phase(p, c, l); }
        xcd_barrier(bar);
        if (PH(6)) for (int rep = 0; rep < REPS(6); ++rep) { if (rep) xcd_barrier(bar); merge_phase(p, c, l); }
        xcd_barrier(bar);
        if (PH(7)) {
            pg8::SchedPlain S{(const char*)(ws + WS_WOUT) + (size_t)l * 1024 * 1024 * 2, DM * 2, 1024 * 2, 128, 4, c.G, bx, 0};
            pg8::EpiResid E{xin, l == 0, RS};
            pg8::gemm_phase<pg8::EpiResid, pg8::SchedPlain, true>(c, (const char*)Y, 1024, S, E);
        }
        xcd_barrier(bar);
        if (l == 0) {
            if (PH(8)) rmsnorm_phase<false>(p, c, RS, 0, p.in[I_N2G], H, nullptr, nullptr);
            xcd_barrier(bar);
            if (PH(9)) for (int rep = 0; rep < REPS(9); ++rep) {
                if (rep) xcd_barrier(bar);
                pg8::SchedPlain S{(const char*)(ws + WS_WGUD), DM * 2, 1024 * 2, 128, 16, c.G, bx, 0};
                pg8::EpiSwiglu E{PROJ, 2048};
                pg8::gemm_phase<pg8::EpiSwiglu, pg8::SchedPlain, true>(c, (const char*)H, 1024, S, E);
            }
            xcd_barrier(bar);
            if (PH(10)) {
                pg8::SchedPlain S{(const char*)(ws + WS_WDD), 2048 * 2, 2048 * 2, 128, 4, c.G, bx, 0};
                pg8::EpiResid E{RS, 0, RS};
                pg8::gemm_phase<pg8::EpiResid, pg8::SchedPlain, true>(c, (const char*)PROJ, 2048, S, E);
            }
            xcd_barrier(bar);
        } else {
            if (PH(11)) rmsnorm_phase<true>(p, c, RS, 0, p.in[I_N2G] + DM, H, p.in[I_WR], p.in[I_BR]);
            xcd_barrier(bar);
            pg8::MoeInfo mi; mi.load((const unsigned*)(ws + WS_CTL));
            if (PH(12)) {
                const int U = mi.ts[16] * 6, T0 = __builtin_amdgcn_readfirstlane(U % c.G), hv = (T0 > 0 && 2 * T0 <= c.G) ? 1 : 0, Uf = hv ? U - T0 : U;
                pg8::EpiSwigluMoe E{mi, PROJ, (const float*)(ws + WS_MW)};
                if (Uf > 0) {
                    pg8::SchedMoeUp S{mi, (const char*)(ws + WS_WGUE), (const int*)(ws + WS_MTOK), 2048, c.G, bx, 0, Uf, 0};
                    pg8::gemm_phase<pg8::EpiSwigluMoe, pg8::SchedMoeUp, true>(c, (const char*)H, 1024, S, E);
                }
                if (hv) {
                    pg8::SchedMoeUp S{mi, (const char*)(ws + WS_WGUE), (const int*)(ws + WS_MTOK), 2048, c.G, bx, Uf, T0, 1};
                    pg8::gemm_phase<pg8::EpiSwigluMoe, pg8::SchedMoeUp, true, 1>(c, (const char*)H, 1024, S, E);
                }
            }
            xcd_barrier(bar);
#pragma unroll 1
            for (int k = 0; k < 2; ++k) {
                if (k) xcd_barrier(bar);
                const int r0 = k ? mi.ts[8] : mi.ts[0], nMk = (k ? mi.ts[16] : mi.ts[8]) - r0, U = nMk * 4;
                const int T0 = __builtin_amdgcn_readfirstlane(U % c.G), nsub = T0 == 0 ? 1 : (4 * T0 <= c.G ? 4 : (2 * T0 <= c.G ? 2 : 1)), Uf = nsub == 1 ? U : U - T0;
                pg8::EpiMoeDown E{mi, k ? (const bf16_t*)H : (const bf16_t*)RS, k ? (void*)p.out : (void*)H, k, (const int*)(ws + WS_MTOK)};
                if (Uf > 0) {
                    pg8::SchedMoeDown S{mi, (const char*)(ws + WS_WDE), 1536, r0, nMk, c.G, bx, 0, Uf, 0};
                    pg8::gemm_phase<pg8::EpiMoeDown, pg8::SchedMoeDown, true>(c, (const char*)PROJ, 768, S, E);
                }
                if (nsub == 4) {
                    pg8::SchedMoeDown S{mi, (const char*)(ws + WS_WDE), 1536, r0, nMk, c.G, bx, Uf, T0, 2};
                    pg8::gemm_phase<pg8::EpiMoeDown, pg8::SchedMoeDown, true, 2>(c, (const char*)PROJ, 768, S, E);
                } else if (nsub == 2) {
                    pg8::SchedMoeDown S{mi, (const char*)(ws + WS_WDE), 1536, r0, nMk, c.G, bx, Uf, T0, 1};
                    pg8::gemm_phase<pg8::EpiMoeDown, pg8::SchedMoeDown, true, 1>(c, (const char*)PROJ, 768, S, E);
                }
            }
        }
    }
}

extern "C" void kernel_launch(void* const* d_in, const int* in_sizes, int n_in, void* d_out, int out_size, void* d_ws, size_t ws_size, hipStream_t stream) {
    static int grid = 0;
    if (grid == 0) {
        if (n_in != 24 || ws_size < WS_END) { fprintf(stderr, "kernel_launch: unexpected inputs (n_in %d, ws %zu)\n", n_in, ws_size); grid = -1; return; }
        int dev = 0, cus = 0, per_cu = 0;
        hipGetDevice(&dev); hipDeviceGetAttribute(&cus, hipDeviceAttributeMultiprocessorCount, dev);
        hipFuncSetAttribute((const void*)fwd_kernel, hipFuncAttributeMaxDynamicSharedMemorySize, LDS_BYTES);
        hipOccupancyMaxActiveBlocksPerMultiprocessor(&per_cu, (const void*)fwd_kernel, NWG_THREADS, LDS_BYTES);
        (void)hipGetLastError();
        grid = cus;
    }
    if (grid < 0) return;
    hipMemsetAsync((char*)d_ws + WS_CTL, 0, CTL_BYTES, stream);
    Params p{};
    for (int i = 0; i < 24; ++i) p.in[i] = (const float*)d_in[i];
    p.out = (float*)d_out; p.ws = (unsigned char*)d_ws;
    hipLaunchKernelGGL(fwd_kernel, dim3(grid), dim3(NWG_THREADS), LDS_BYTES, stream, p);
}
```

```cpp
#include <hip/hip_runtime.h>
#include <stdint.h>
#include <stdio.h>

#define LAS __attribute__((address_space(3)))
#ifndef PROBE_REP
#define PROBE_REP -1
#endif
#define REPS(n) ((PROBE_REP == (n)) ? 2 : 1)
#ifndef PHM
#define PHM 0xFFFFFFFFu
#endif
#define PH(n) ((PHM >> (n)) & 1u)
typedef unsigned short bf16_t;
typedef short bf16x8 __attribute__((ext_vector_type(8)));
typedef short s16x4 __attribute__((ext_vector_type(4)));
typedef float f32x2 __attribute__((ext_vector_type(2)));
typedef float f32x4 __attribute__((ext_vector_type(4)));
typedef float f32x16 __attribute__((ext_vector_type(16)));
typedef unsigned u32x2 __attribute__((ext_vector_type(2)));
typedef unsigned u32x4 __attribute__((ext_vector_type(4)));
typedef __bf16 bf16x2_t __attribute__((ext_vector_type(2)));

constexpr int NTOK = 32768, SEQ = 16384, DM = 1024;
constexpr int PW = 3072;
constexpr int PC_AQ = 0, PC_AK = 256, PC_AV = 512, PC_CQ = 768, PC_CKV = 1024, PC_SWQ = 1280, PC_SWK = 1536, PC_SWV = 1600,
              PC_GLOW = 1664, PC_DQ = 1792, PC_DK = 2176, PC_DV = 2560, PC_KPE = 2944;
constexpr int AOW = 896;
constexpr float LOG2E = 1.4426950408889634f;
constexpr float EPS = 1e-6f;
constexpr int NWG_THREADS = 512;

constexpr size_t MiB = 1u << 20;
constexpr size_t WS_CTL = 0, CTL_BYTES = 128 * 1024;
constexpr size_t WS_MTOK = 1 * MiB;
constexpr size_t WS_MW = 3 * MiB;
constexpr size_t WS_ROPE = 5 * MiB;
constexpr size_t WS_TAB = 7 * MiB;
constexpr size_t WS_WIN = 8 * MiB;
constexpr size_t WS_WQ = 20 * MiB;
constexpr size_t WS_WKV = 20 * MiB + 512 * 1024;
constexpr size_t WS_WGB = 21 * MiB;
constexpr size_t WS_WBR = 23 * MiB;
constexpr size_t WS_WOUT = 27 * MiB;
constexpr size_t WS_WGUD = 31 * MiB;
constexpr size_t WS_WDD = 39 * MiB;
constexpr size_t WS_WGUE = 43 * MiB;
constexpr size_t WS_WDE = 67 * MiB;
constexpr size_t WS_H = 80 * MiB;
constexpr size_t WS_PROJ = 144 * MiB;
constexpr size_t WS_AO = 336 * MiB;
constexpr size_t WS_Y = 392 * MiB;
constexpr size_t WS_END = 456 * MiB;
constexpr int CW_BAR = 4096;
constexpr int CW_MOE = 16384;

constexpr int LDS_STAGE = 0;
constexpr int LDS_VSCR = 0;
constexpr int LDS_DOBUF = 36864;
constexpr int LDS_MLA = 36864;
constexpr int LDS_DLSE = 135168;
constexpr int LDS_BTAB = 141312;
constexpr int LDS_CTL = 151872;
constexpr int LDS_BYTES = 152 * 1024;

__device__ __forceinline__ unsigned pk2(float lo, float hi) { f32x2 v = {lo, hi}; bf16x2_t b = __builtin_convertvector(v, bf16x2_t); return __builtin_bit_cast(unsigned, b); }
__device__ __forceinline__ float bf2f(unsigned short b) { return __uint_as_float(((unsigned)b) << 16); }
__device__ __forceinline__ float bflo(unsigned w) { return __uint_as_float(w << 16); }
__device__ __forceinline__ float bfhi(unsigned w) { return __uint_as_float(w & 0xffff0000u); }
__device__ __forceinline__ float ex2(float x) { return __builtin_amdgcn_exp2f(x); }
__device__ __forceinline__ float lg2(float x) { return __builtin_amdgcn_logf(x); }
__device__ __forceinline__ float rcpf(float x) { return __builtin_amdgcn_rcpf(x); }
template <int CTRL> __device__ __forceinline__ float dppx(float v) { return __uint_as_float((unsigned)__builtin_amdgcn_update_dpp(0, (int)__float_as_uint(v), CTRL, 0xf, 0xf, false)); }
__device__ __forceinline__ float row16_sum(float v) {
    v += dppx<0xB1>(v); v += dppx<0x4E>(v); v += dppx<0x141>(v); v += dppx<0x140>(v); return v;
}
__device__ __forceinline__ float x16_add(float v) { auto r = __builtin_amdgcn_permlane16_swap(__float_as_uint(v), __float_as_uint(v), false, false); return __uint_as_float(r[0]) + __uint_as_float(r[1]); }
__device__ __forceinline__ float x32_add(float v) { auto r = __builtin_amdgcn_permlane32_swap(__float_as_uint(v), __float_as_uint(v), false, false); return __uint_as_float(r[0]) + __uint_as_float(r[1]); }
__device__ __forceinline__ float x32_max(float v) { auto r = __builtin_amdgcn_permlane32_swap(__float_as_uint(v), __float_as_uint(v), false, false); return fmaxf(__uint_as_float(r[0]), __uint_as_float(r[1])); }
__device__ __forceinline__ float x32_other(float v, int hi) { auto r = __builtin_amdgcn_permlane32_swap(__float_as_uint(v), __float_as_uint(v), false, false); return __uint_as_float(hi ? r[0] : r[1]); }
__device__ __forceinline__ f32x4 unpk4(unsigned a, unsigned b) { return (f32x4){__builtin_bit_cast(float, a << 16), __builtin_bit_cast(float, a & 0xffff0000u), __builtin_bit_cast(float, b << 16), __builtin_bit_cast(float, b & 0xffff0000u)}; }
__device__ __forceinline__ float wave_sum(float v) { return x32_add(x16_add(row16_sum(v))); }
__device__ __forceinline__ int sigma32(int i) { return 16 * ((i >> 2) & 1) + (i & 3) + 4 * (i >> 3); }
__device__ __forceinline__ int pi32(int i) { const int h = (i >> 2) & 1, r = (i & 3) + 4 * (i >> 3); return 16 * (r >> 3) + 8 * h + (r & 7); }
__device__ __forceinline__ bf16x8 mk8(u32x4 v) { return __builtin_bit_cast(bf16x8, v); }

#define XB_TMO      128
#define XB_XCNT(j)  (256  + 64 * (j))
#define XB_XSUB(j)  (1280 + 64 * (j))
#define XB_XGEN(j)  (2304 + 64 * (j))
#define XB_TOP      3328
#define XB_TOPGEN   3392
#define XCD_BAR_WORDS 3456
#define XB_SPIN_CAP (1u << 20)
__device__ __forceinline__ unsigned xb_ld(unsigned* p)              { return __hip_atomic_load(p, __ATOMIC_RELAXED, __HIP_MEMORY_SCOPE_AGENT); }
__device__ __forceinline__ unsigned xb_add(unsigned* p, unsigned v) { return __hip_atomic_fetch_add(p, v, __ATOMIC_RELAXED, __HIP_MEMORY_SCOPE_AGENT); }
__device__ __forceinline__ unsigned xb_xcc_id() { return (unsigned)__builtin_amdgcn_s_getreg((3 << 11) | 20) & 0xFu; }
#define XB_SPIN(cond, bar) do { unsigned _sp = 0; while (cond) { __builtin_amdgcn_s_sleep(1); \
    if ((++_sp & 255u) == 0u) { if (xb_ld(&(bar)[XB_TMO])) break; if (_sp > XB_SPIN_CAP) { atomicAdd(&(bar)[XB_TMO], 1u); break; } } } } while (0)
struct XcdBarrier { unsigned* bar; unsigned x; volatile LAS unsigned* st; };
__device__ __forceinline__ XcdBarrier xcd_barrier_post(unsigned* bar, volatile LAS unsigned* st) {
    XcdBarrier b; b.bar = bar; b.x = xb_xcc_id(); b.st = st;
    if (threadIdx.x == 0) (void)xb_add(&bar[XB_XCNT(b.x)], 1u);
    return b;
}
__device__ __forceinline__ void xcd_barrier_complete(unsigned* bar, unsigned x, unsigned& nloc, unsigned& nx) {
    const unsigned G = gridDim.x * gridDim.y * gridDim.z;
    unsigned sum, cnt, mine, sp = 0u;
    for (;;) {
        sum = 0u; cnt = 0u; mine = 0u;
#pragma unroll
        for (unsigned j = 0; j < 16; ++j) { const unsigned c = xb_ld(&bar[XB_XCNT(j)]); sum += c; cnt += (c > 0u) ? 1u : 0u; mine = (j == x) ? c : mine; }
        if (sum == G) break;
        __builtin_amdgcn_s_sleep(1);
        if ((++sp & 255u) == 0u) { if (xb_ld(&bar[XB_TMO])) break; if (sp > XB_SPIN_CAP) { atomicAdd(&bar[XB_TMO], 1u); break; } }
    }
    nloc = mine > 0u ? mine : 1u; nx = cnt > 0u ? cnt : 1u;
}
__device__ __noinline__ void xcd_barrier(const XcdBarrier b) {
    asm volatile("s_waitcnt vmcnt(0)" ::: "memory");
    __syncthreads();
    if (threadIdx.x == 0) {
        unsigned* bar = b.bar;
        __builtin_amdgcn_s_waitcnt(0);
        unsigned nloc = b.st[0], nx = b.st[1];
        if (nloc == 0u) { xcd_barrier_complete(bar, b.x, nloc, nx); b.st[0] = nloc; b.st[1] = nx; }
        const unsigned old = xb_add(&bar[XB_XSUB(b.x)], 1u);
        const unsigned gen = old / nloc;
        if (old + 1u == (gen + 1u) * nloc) {
            __builtin_amdgcn_fence(__ATOMIC_RELEASE, "agent");
            asm volatile("s_waitcnt vmcnt(0)" ::: "memory");
            const unsigned og = xb_add(&bar[XB_TOP], 1u);
            const unsigned tg = og / nx;
            if (og + 1u == (tg + 1u) * nx) xb_add(&bar[XB_TOPGEN], 1u);
            else XB_SPIN(xb_ld(&bar[XB_TOPGEN]) == tg, bar);
            __builtin_amdgcn_fence(__ATOMIC_ACQUIRE, "agent");
            xb_add(&bar[XB_XGEN(b.x)], 1u);
            asm volatile("s_waitcnt vmcnt(0)" ::: "memory");
        } else {
            XB_SPIN(xb_ld(&bar[XB_XGEN(b.x)]) == gen, bar);
            __builtin_amdgcn_fence(__ATOMIC_ACQUIRE, "agent");
            asm volatile("s_waitcnt vmcnt(0)" ::: "memory");
        }
    }
    __syncthreads();
}

struct Params { const float* in[24]; float* out; unsigned char* ws; };
enum { I_X = 0, I_N1G, I_WIN, I_GQA, I_WQB, I_GKVA, I_WKVB, I_GMLA, I_GSW, I_GDIL, I_SINKS, I_RELB, I_WGA, I_WGB, I_BG, I_WBR, I_WOUT, I_N2G,
       I_WGUD, I_WDD, I_WR, I_BR, I_WGUE, I_WDE };

struct Ctx {
    LAS unsigned char* lds;
    int tid, lane, wid, G, vcu, gw, NGW;
};
__device__ __forceinline__ unsigned char* launder_ptr(unsigned char* q) { size_t z = 0; asm volatile("" : "+s"(z)); return q + z; }
__device__ __forceinline__ Ctx launder(const Ctx& c0) {
    Ctx c = c0; int t, w = c0.wid;
    asm volatile("" : "+s"(w));
    asm volatile("v_mbcnt_lo_u32_b32 %0, -1, 0\n\tv_mbcnt_hi_u32_b32 %0, -1, %0" : "=v"(t));
    __builtin_assume(t >= 0 && t < 64); __builtin_assume(w >= 0 && w < 8);
    c.lane = t; c.tid = (w << 6) | t; c.wid = w; c.gw = (int)blockIdx.x * 8 + w;
    return c;
}

__device__ __forceinline__ int inproj_map(int c) {
    if (c < 1280) return c;
    if (c < 1312) return PC_KPE + (c - 1280);
    if (c < 1568) return PC_SWQ + (c - 1312);
    if (c < 1632) return PC_SWK + (c - 1568);
    if (c < 1696) return PC_SWV + (c - 1632);
    return PC_DQ + (c - 1696);
}
struct ItemRegs { f32x4 v[8]; float ks[8]; };
struct ItemInfo { bf16_t* WT; int ldt, dst, k0; float scale; };
__device__ __forceinline__ void item_load(const LAS unsigned* JT, int id, int& j, int lane, ItemRegs& r, ItemInfo& inf) {
    while (id >= (int)JT[(j + 1) * 12 + 11]) ++j;
    const LAS unsigned* e = JT + j * 12;
    const float* W = (const float*)(((unsigned long long)e[1] << 32) | e[0]);
    inf.WT = (bf16_t*)(((unsigned long long)e[3] << 32) | e[2]);
    const float* ks = (const float*)(((unsigned long long)e[5] << 32) | e[4]);
    const int ldw = (int)e[6], N = (int)e[8], mode = (int)(e[10] & 255u), add = (int)(e[10] >> 8);
    inf.ldt = (int)e[9];
    const int it = id - (int)e[11], nblk = N / 32, kb = it / nblk, nb = it % nblk, cc0 = nb * 32;
    float scale = 1.f; int dst;
    if (mode == 0) dst = cc0 + add;
    else if (mode == 3) { dst = cc0 + add; scale = -LOG2E; }
    else if (mode == 1) { dst = inproj_map(cc0); if (cc0 < 256) scale = 0.125f * LOG2E; }
    else { const int half = N / 2; const int isu = cc0 >= half ? 1 : 0; const int cc = cc0 - isu * half; dst = 256 * (cc / 128) + 128 * isu + (cc % 128);
           scale = isu ? (-1.f / LOG2E) : -LOG2E; }
    inf.dst = dst; inf.k0 = kb * 64; inf.scale = scale;
#pragma unroll
    for (int i = 0; i < 8; ++i) { const int kk = kb * 64 + (lane >> 3) + 8 * i; r.v[i] = *(const f32x4*)(W + (size_t)kk * ldw + cc0 + 4 * (lane & 7)); r.ks[i] = ks ? ks[kk] : 1.f; }
}
__device__ __forceinline__ void item_finish(const ItemRegs& r, const ItemInfo& inf, LAS float* scr, int lane) {
#pragma unroll
    for (int i = 0; i < 8; ++i) { const int kk = (lane >> 3) + 8 * i; const float sc = inf.scale * r.ks[i];
        LAS float* d = scr + kk * 33 + 4 * (lane & 7); d[0] = r.v[i].x * sc; d[1] = r.v[i].y * sc; d[2] = r.v[i].z * sc; d[3] = r.v[i].w * sc; }
    asm volatile("s_waitcnt lgkmcnt(0)" ::: "memory");
    const int c = lane & 7;
#pragma unroll
    for (int j = 0; j < 4; ++j) { const int n = (lane >> 3) + 8 * j; const LAS float* sp = scr + (8 * c) * 33 + n;
        u32x4 o; o.x = pk2(sp[0 * 33], sp[1 * 33]); o.y = pk2(sp[2 * 33], sp[3 * 33]); o.z = pk2(sp[4 * 33], sp[5 * 33]); o.w = pk2(sp[6 * 33], sp[7 * 33]);
        *(u32x4*)(inf.WT + (size_t)(inf.dst + n) * inf.ldt + inf.k0 + 8 * c) = o; }
    asm volatile("s_waitcnt lgkmcnt(0)" ::: "memory");
}
__device__ __forceinline__ int t5_bucket(int d) {
    if (d < 16) return d;
    int b = 16 + (int)(__log2f((float)d * (1.f / 16.f)) * (16.f / 7.f));
    return b > 31 ? 31 : b;
}
__device__ __forceinline__ void prologue(const Params& p, const Ctx& c0) {
    const Ctx c = launder(c0);
    unsigned char* ws = launder_ptr(p.ws);
    LAS float* scr = (LAS float*)(c.lds + c.wid * 16384);
    LAS unsigned* JT = (LAS unsigned*)(c.lds + 131072);
    if (c.tid == 0) {
        int nj = 0, first = 0;
#define JOB(W, ldw, K, N, WT, ldt, mode, add, ks) do { LAS unsigned* e_ = JT + nj * 12; const unsigned long long w_ = (unsigned long long)(W), t_ = (unsigned long long)(WT), k_ = (unsigned long long)(ks); \
        e_[0] = (unsigned)w_; e_[1] = (unsigned)(w_ >> 32); e_[2] = (unsigned)t_; e_[3] = (unsigned)(t_ >> 32); e_[4] = (unsigned)k_; e_[5] = (unsigned)(k_ >> 32); \
        e_[6] = (unsigned)(ldw); e_[7] = (unsigned)(K); e_[8] = (unsigned)(N); e_[9] = (unsigned)(ldt); e_[10] = (unsigned)(mode) | ((unsigned)(add) << 8); e_[11] = (unsigned)first; \
        first += ((K) / 64) * ((N) / 32); ++nj; } while (0)
        for (int l = 0; l < 2; ++l) {
            bf16_t* win = (bf16_t*)(ws + WS_WIN) + (size_t)l * PW * 1024;
            JOB(p.in[I_WIN] + (size_t)l * 1024 * 2848, 2848, 1024, 2848, win, 1024, 1, 0, (const float*)nullptr);
            JOB(p.in[I_WGA] + (size_t)l * 1024 * 128, 128, 1024, 128, win, 1024, 0, PC_GLOW, (const float*)nullptr);
            JOB(p.in[I_WQB] + (size_t)l * 256 * 384, 384, 256, 384, (bf16_t*)(ws + WS_WQ) + (size_t)l * 512 * 256, 256, 0, 0, p.in[I_GQA] + l * 256);
            JOB(p.in[I_WKVB] + (size_t)l * 256 * 512, 512, 256, 512, (bf16_t*)(ws + WS_WKV) + (size_t)l * 512 * 256, 256, 0, 0, p.in[I_GKVA] + l * 256);
            JOB(p.in[I_WGB] + (size_t)l * 128 * 4096, 4096, 128, 4096, (bf16_t*)(ws + WS_WGB) + (size_t)l * 4096 * 128, 128, 3, 0, (const float*)nullptr);
            bf16_t* wbr = (bf16_t*)(ws + WS_WBR) + (size_t)l * 1024 * 1024;
            const float* wb = p.in[I_WBR] + (size_t)l * 896 * 1024;
            JOB(wb, 1024, 256, 1024, wbr, 256, 0, 0, (const float*)nullptr);
            JOB(wb + (size_t)256 * 1024, 1024, 256, 1024, wbr + 1024 * 256, 256, 0, 0, (const float*)nullptr);
            JOB(wb + (size_t)512 * 1024, 1024, 256, 1024, wbr + 2 * 1024 * 256, 256, 0, 0, (const float*)nullptr);
            JOB(wb + (size_t)768 * 1024, 1024, 128, 1024, wbr + 3 * 1024 * 256, 128, 0, 0, (const float*)nullptr);
            JOB(p.in[I_WOUT] + (size_t)l * 1024 * 1024, 1024, 1024, 1024, (bf16_t*)(ws + WS_WOUT) + (size_t)l * 1024 * 1024, 1024, 0, 0, (const float*)nullptr);
        }
        JOB(p.in[I_WGUD], 4096, 1024, 4096, (bf16_t*)(ws + WS_WGUD), 1024, 2, 0, (const float*)nullptr);
        JOB(p.in[I_WDD], 1024, 2048, 1024, (bf16_t*)(ws + WS_WDD), 2048, 0, 0, (const float*)nullptr);
        for (int e = 0; e < 8; ++e) {
            JOB(p.in[I_WGUE] + (size_t)e * 1024 * 1536, 1536, 1024, 1536, (bf16_t*)(ws + WS_WGUE) + (size_t)e * 1536 * 1024, 1024, 2, 0, (const float*)nullptr);
            JOB(p.in[I_WDE] + (size_t)e * 768 * 1024, 1024, 768, 1024, (bf16_t*)(ws + WS_WDE) + (size_t)e * 1024 * 768, 768, 0, 0, (const float*)nullptr);
        }
#undef JOB
        JT[nj * 12 + 11] = (unsigned)first;
        JT[1023] = (unsigned)nj;
    }
    __syncthreads();
    {
        const int nj = (int)JT[1023], total = (int)JT[nj * 12 + 11];
        const int lo = (int)(((long long)c.gw * total) / c.NGW), hi = (int)(((long long)(c.gw + 1) * total) / c.NGW);
        int j = 0; ItemRegs ra, rb; ItemInfo ia, ib;
        if (lo < hi) item_load(JT, lo, j, c.lane, ra, ia);
        for (int id = lo; id < hi; ++id) {
            if (id + 1 < hi) item_load(JT, id + 1, j, c.lane, rb, ib);
            item_finish(ra, ia, scr, c.lane);
            ra = rb; ia = ib;
        }
    }
    __syncthreads();
    const int gt = c.gw * 64 + c.lane, NGT = c.NGW * 64;
    for (int l = 0; l < 2; ++l) {
        u32x4* z = (u32x4*)((bf16_t*)(ws + WS_WIN) + (size_t)l * PW * 1024 + (size_t)2976 * 1024);
        for (int i = gt; i < 96 * 1024 / 8; i += NGT) z[i] = (u32x4){0u, 0u, 0u, 0u};
        u32x4* z2 = (u32x4*)((bf16_t*)(ws + WS_WQ) + (size_t)l * 512 * 256 + (size_t)384 * 256);
        for (int i = gt; i < 128 * 256 / 8; i += NGT) z2[i] = (u32x4){0u, 0u, 0u, 0u};
    }
    {
        f32x2* rt = (f32x2*)(ws + WS_ROPE);
        for (int i = gt; i < SEQ * 16; i += NGT) {
            const int pos = i >> 4, j = i & 15;
            const double c4 = (j & 3) == 0 ? 1.0 : ((j & 3) == 1 ? 0.56234132519034908 : ((j & 3) == 2 ? 0.31622776601683794 : 0.17782794100389228));
            const double d4 = (j >> 2) == 0 ? 1.0 : ((j >> 2) == 1 ? 0.1 : ((j >> 2) == 2 ? 0.01 : 0.001));
            const float inv = (float)(c4 * d4);
            const float ang = (float)pos * inv;
            const double rev = (double)ang * 0.15915494309189535;
            const float fr = (float)(rev - rint(rev));
            rt[i] = (f32x2){__builtin_amdgcn_cosf(fr), __builtin_amdgcn_sinf(fr)};
        }
    }
    {
        float* bt = (float*)(ws + WS_TAB);
        for (int i = gt; i < 20 * 132; i += NGT) {
            const int hd = i / 132, d = i % 132;
            const int dil = hd < 8 ? 1 : (hd < 12 ? 1 : (hd < 16 ? 4 : 16));
            bt[i] = p.in[I_RELB][t5_bucket(d * dil) * 20 + hd] * LOG2E;
        }
        float* bn = bt + 20 * 132 + 256;
        for (int i = gt; i < 2 * 4096; i += NGT) bn[i] = -p.in[I_BG][i] * LOG2E;
        float* gt_ = bt + 20 * 132;
        for (int i = gt; i < 2 * 4 * 32; i += NGT) {
            const int l = i >> 7, t = (i >> 5) & 3, j = i & 31;
            const float sc = 0.17677669529663687f * LOG2E;
            float v;
            if (t == 0) v = p.in[I_GSW][l * 64 + j] * sc; else if (t == 1) v = p.in[I_GSW][l * 64 + 32 + j];
            else if (t == 2) v = p.in[I_GDIL][l * 64 + j] * sc; else v = p.in[I_GDIL][l * 64 + 32 + j];
            gt_[i] = v;
        }
    }
}

template <bool ROUTE>
__device__ __forceinline__ void rmsnorm_phase(const Params& p, const Ctx& c0, const void* xv, int x_f32, const float* g, bf16_t* h, const float* wr, const float* br) {
    const Ctx c = launder(c0);
    unsigned char* const wsl = launder_ptr(p.ws);
    const int lane = c.lane;
    f32x4 gv[4];
#pragma unroll
    for (int j = 0; j < 4; ++j) gv[j] = *(const f32x4*)(g + 4 * lane + 256 * j);
    f32x4 wv[ROUTE ? 32 : 1];
    if (ROUTE) {
#pragma unroll
        for (int j = 0; j < 4; ++j)
#pragma unroll
            for (int cc = 0; cc < 4; ++cc) { const float* w = wr + (size_t)(4 * lane + 256 * j + cc) * 8; wv[(j * 4 + cc) * 2] = *(const f32x4*)w; wv[(j * 4 + cc) * 2 + 1] = *(const f32x4*)(w + 4); }
    }
    int* mtok = (int*)(wsl + WS_MTOK); float* mw = (float*)(wsl + WS_MW); unsigned* ctl = (unsigned*)(wsl + WS_CTL);
    int my_tok = 0, my_e0 = 0, my_e1 = 0; float my_w0 = 0.f, my_w1 = 0.f; int nmine = 0;
    const bool wg_agg = ROUTE && (NTOK % c.NGW) == 0 && (NTOK / c.NGW) <= 64;
    LAS unsigned* rcnt = (LAS unsigned*)c.lds;
#define ROUTE_FLUSH(WG) do { \
        const bool act = lane < nmine; \
        unsigned cntv = 0; int pos0 = 0, pos1 = 0; \
        _Pragma("unroll") for (int k = 0; k < 2; ++k) { \
            const int me = k == 0 ? my_e0 : my_e1; \
            _Pragma("unroll") for (int e = 0; e < 8; ++e) { \
                const unsigned long long mask = __ballot(act && me == e); \
                if (lane == k * 8 + e) cntv = (unsigned)__popcll(mask); \
                if (me == e) { const int r = __popcll(mask & ((1ull << lane) - 1ull)); if (k == 0) pos0 = r; else pos1 = r; } } } \
        unsigned base = 0; \
        if (WG) { \
            if (lane < 16) rcnt[c.wid * 16 + lane] = cntv; \
            __syncthreads(); \
            if (c.wid == 0 && lane < 16) { \
                unsigned tot = 0; \
                _Pragma("unroll") for (int w = 0; w < 8; ++w) tot += rcnt[w * 16 + lane]; \
                unsigned wb = 0; \
                if (tot) wb = __hip_atomic_fetch_add(ctl + CW_MOE + 64 * lane, tot, __ATOMIC_RELAXED, __HIP_MEMORY_SCOPE_AGENT); \
                rcnt[128 + lane] = wb; } \
            __syncthreads(); \
            if (lane < 16) { base = rcnt[128 + lane]; for (int w = 0; w < c.wid; ++w) base += rcnt[w * 16 + lane]; } \
        } else { \
            if (lane < 16 && cntv) base = __hip_atomic_fetch_add(ctl + CW_MOE + 64 * lane, cntv, __ATOMIC_RELAXED, __HIP_MEMORY_SCOPE_AGENT); \
        } \
        const unsigned b0 = (unsigned)__builtin_amdgcn_ds_bpermute(my_e0 * 4, (int)base), b1 = (unsigned)__builtin_amdgcn_ds_bpermute((8 + my_e1) * 4, (int)base); \
        if (act) { \
            mtok[my_e0 * NTOK + b0 + pos0] = my_tok; mw[my_e0 * NTOK + b0 + pos0] = my_w0; \
            mtok[(8 + my_e1) * NTOK + b1 + pos1] = my_tok; mw[(8 + my_e1) * NTOK + b1 + pos1] = my_w1; } \
    } while (0)
    const float* x = (const float*)xv; const bf16_t* xb = (const bf16_t*)xv;
#define RMS_LOAD(dst, row) do { if (x_f32) { _Pragma("unroll") for (int j = 0; j < 4; ++j) dst[j] = ((const f32x4*)(x + (size_t)(row) * DM) + lane)[64 * j]; } \
        else { _Pragma("unroll") for (int j = 0; j < 4; ++j) { const u32x2 w_ = ((const u32x2*)(xb + (size_t)(row) * DM) + lane)[64 * j]; dst[j] = unpk4(w_.x, w_.y); } } } while (0)
    f32x4 nv[4];
    if (c.gw < NTOK) RMS_LOAD(nv, c.gw);
    for (int m = c.gw; m < NTOK; m += c.NGW) {
        f32x4 v[4]; float s = 0.f;
#pragma unroll
        for (int j = 0; j < 4; ++j) v[j] = nv[j];
        if (m + c.NGW < NTOK) RMS_LOAD(nv, m + c.NGW);
#pragma unroll
        for (int j = 0; j < 4; ++j) s += (v[j].x * v[j].x + v[j].y * v[j].y) + (v[j].z * v[j].z + v[j].w * v[j].w);
        const float rs = __builtin_amdgcn_rsqf(wave_sum(s) * (1.f / DM) + EPS);
        unsigned long long* o8 = (unsigned long long*)(h + (size_t)m * DM) + lane;
#pragma unroll
        for (int j = 0; j < 4; ++j) { v[j] = v[j] * rs * gv[j]; o8[64 * j] = (unsigned long long)pk2(v[j].x, v[j].y) | ((unsigned long long)pk2(v[j].z, v[j].w) << 32); }
        if (ROUTE) {
            float lg[8];
#pragma unroll
            for (int e = 0; e < 8; ++e) lg[e] = 0.f;
#pragma unroll
            for (int j = 0; j < 4; ++j)
#pragma unroll
                for (int cc = 0; cc < 4; ++cc) { const float xv = v[j][cc]; const f32x4 a = wv[(j * 4 + cc) * 2], b = wv[(j * 4 + cc) * 2 + 1];
                    lg[0] += xv * a.x; lg[1] += xv * a.y; lg[2] += xv * a.z; lg[3] += xv * a.w; lg[4] += xv * b.x; lg[5] += xv * b.y; lg[6] += xv * b.z; lg[7] += xv * b.w; }
#pragma unroll
            for (int e = 0; e < 8; ++e) lg[e] = wave_sum(lg[e]) + br[e];
            int e0 = 0; float v0 = lg[0];
#pragma unroll
            for (int e = 1; e < 8; ++e) if (lg[e] > v0) { v0 = lg[e]; e0 = e; }
            int e1 = -1; float v1 = -3.0e38f;
#pragma unroll
            for (int e = 0; e < 8; ++e) if (e != e0 && lg[e] > v1) { v1 = lg[e]; e1 = e; }
            const float t = ex2((v1 - v0) * LOG2E);
            const float w0 = 1.f / (1.f + t), w1 = t / (1.f + t);
            if (lane == nmine) { my_tok = m; my_e0 = e0; my_e1 = e1; my_w0 = w0; my_w1 = w1; }
            ++nmine;
            if (nmine == 64 || (!wg_agg && m + c.NGW >= NTOK)) { ROUTE_FLUSH(false); nmine = 0; }
        }
    }
    if (ROUTE && wg_agg) { ROUTE_FLUSH(true); }
#undef ROUTE_FLUSH
}

constexpr int SLOT_BYTES = 24576, SLOT_BOFF = 8192, NSLOT = 6;
struct Unit { int pm, pn, e, sa, sb; };
#define DMA16(m0v, voff, rsrc, soff) asm volatile("s_mov_b32 m0, %0\n\ts_nop 0\n\tbuffer_load_dwordx4 %1, %2, %3 offen lds" :: "s"(m0v), "v"(voff), "s"(rsrc), "s"(soff) : "m0", "memory")

template <int BM>
struct SubFrags { bf16x8 xf[2][BM / 64], wf[2][2]; };
template <int BM>
__device__ __forceinline__ void ld_frags(const LAS unsigned char* sl, SubFrags<BM>& F, int ks, int wr, int wc, int r32, int hi) {
    constexpr int MB = BM / 64;
    const int s32 = sigma32(r32);
    const unsigned xrow = (unsigned)(wr * (BM / 2) + r32) * 64u, kx = (r32 >> 2) & 3;
    const unsigned wrow = SLOT_BOFF + (unsigned)(wc * 64 + s32) * 64u, kw = (s32 >> 2) & 3;
#pragma unroll
    for (int mb = 0; mb < MB; ++mb) F.xf[ks][mb] = *(const LAS bf16x8*)(sl + xrow + mb * 2048 + (((2 * ks + hi) ^ kx) << 4));
#pragma unroll
    for (int nb = 0; nb < 2; ++nb) F.wf[ks][nb] = *(const LAS bf16x8*)(sl + wrow + nb * 2048 + (((2 * ks + hi) ^ kw) << 4));
}
template <int BM>
__device__ __forceinline__ void mma_sub_pipe(const LAS unsigned char* nxt, SubFrags<BM>& F, f32x16 (&acc)[BM / 64][2], int wr, int wc, int r32, int hi) {
    constexpr int MB = BM / 64;
#pragma unroll
    for (int ks = 0; ks < 2; ++ks) {
        __builtin_amdgcn_s_setprio(1);
#pragma unroll
        for (int mb = 0; mb < MB; ++mb)
#pragma unroll
            for (int nb = 0; nb < 2; ++nb) acc[mb][nb] = __builtin_amdgcn_mfma_f32_32x32x16_bf16(F.wf[ks][nb], F.xf[ks][mb], acc[mb][nb], 0, 0, 0);
        __builtin_amdgcn_s_setprio(0);
        __builtin_amdgcn_sched_barrier(0);
        ld_frags<BM>(nxt, F, ks, wr, wc, r32, hi);
        __builtin_amdgcn_sched_barrier(0);
    }
}

namespace pg8 {
constexpr int HALF = 128, HTB = HALF * 64 * 2;
__device__ __forceinline__ int lds_byte(int r, int c) { const int st = (r >> 4) * 2 + (c >> 5), rr = r & 15, cc = c & 31, ob = rr * 64 + cc * 2; return st * 1024 + (ob ^ (((ob >> 9) & 1) << 5)); }
__device__ __forceinline__ void stage_rc(int b, int& R, int& C) { const int st = b / 1024, sb = b % 1024, swz = sb ^ (((sb >> 9) & 1) << 5); R = (st >> 1) * 16 + swz / 64; C = (st & 1) * 32 + (swz % 64) / 2; }
__device__ __forceinline__ int perm32(int rho) { const int n = rho >> 4, i = rho & 15; return 8 * (i >> 2) + 4 * n + (i & 3); }

__device__ __forceinline__ const char* uni_ptr(const char* q) {
    const unsigned long long v = (unsigned long long)q;
    const unsigned lo = (unsigned)__builtin_amdgcn_readfirstlane((int)(unsigned)v), hi = (unsigned)__builtin_amdgcn_readfirstlane((int)(unsigned)(v >> 32));
    return (const char*)(((unsigned long long)hi << 32) | lo);
}
template <class Epi, class Sched, bool ALIGN_EPI, int SUB = 0>
__device__ __forceinline__ void gemm_phase(const Ctx& c0, const char* Abase, int K, const Sched& S, const Epi& E) {
    const Ctx c = launder(c0);
    LAS unsigned char* lds = c.lds + LDS_STAGE;
    const int tid = c.tid, wid = c.wid, lane = c.lane, wr = wid >> 2, wc = wid & 3, fr = lane & 15, fq = lane >> 4;
    int nt = K / 64; asm volatile("" : "+s"(nt));
    int R[2], C[2]; unsigned voffB[2];
#pragma unroll
    for (int i = 0; i < 2; ++i) { stage_rc(tid * 16 + i * 8192, R[i], C[i]); const int Rb = (R[i] & ~31) + perm32(R[i] & 31); voffB[i] = (unsigned)(Rb * S.ldb2 + C[i] * 2); }
    const size_t kstep = 128;
    const size_t hstepB = (size_t)HALF * S.ldb2;
    const unsigned ldsw = (unsigned)wid * 1024u;
    const int aoff = lds_byte(wr * 64 + fr, fq * 8), boff = lds_byte(wc * 32 + fr, fq * 8);
#define PG8_SA(b, h) (((b) * 2 + (h)) * HTB)
#define PG8_SB(b, h) ((4 + (b) * 2 + (h)) * HTB)
#define PG8_STAGE(bufoff, gbase, voff) do { const char* gb_ = (const char*)(gbase); asm volatile("" : "+s"(gb_));     \
        _Pragma("unroll") for (int _i = 0; _i < 2; ++_i) { unsigned vo_ = (voff)[_i]; asm volatile("" : "+v"(vo_)); \
        __builtin_amdgcn_global_load_lds((const unsigned*)(gb_ + vo_), (LAS unsigned*)(lds + (bufoff) + ldsw + _i * 8192), 16, 0, 0); } } while (0)
#define PG8_LDA(dst, b, h) do { _Pragma("unroll") for (int m = 0; m < 4; ++m) _Pragma("unroll") for (int k = 0; k < 2; ++k) dst[m][k] = *(const LAS bf16x8*)(lds + PG8_SA(b, h) + aoff + m * 2048 + k * 1024); } while (0)
#define PG8_LDB(dst, b, h) do { _Pragma("unroll") for (int n = 0; n < 2; ++n) _Pragma("unroll") for (int k = 0; k < 2; ++k) dst[n][k] = *(const LAS bf16x8*)(lds + PG8_SB(b, h) + boff + n * 2048 + k * 1024); } while (0)
#define PG8_MMA(ai, bj, At, Bt) do { __builtin_amdgcn_s_setprio(1); _Pragma("unroll") for (int m = 0; m < 4; ++m) _Pragma("unroll") for (int n = 0; n < 2; ++n) _Pragma("unroll") for (int k = 0; k < 2; ++k) \
        acc[ai][bj][m][n] = __builtin_amdgcn_mfma_f32_16x16x32_bf16(Bt[n][k], At[m][k], acc[ai][bj][m][n], 0, 0, 0); __builtin_amdgcn_s_setprio(0); } while (0)
#define PG8_WAIT_V(n) asm volatile("s_waitcnt vmcnt(" #n ")" ::: "memory")
#define PG8_WAIT_L(n) asm volatile("s_waitcnt lgkmcnt(" #n ")" ::: "memory")
#define PG8_BAR __builtin_amdgcn_s_barrier()
#define PG8_SCHED __builtin_amdgcn_sched_barrier(0)
    constexpr bool AFF = Sched::AFFINE;
    unsigned voffA[2] = {0u, 0u}; size_t hstepA = 0;
    if constexpr (AFF) {
#pragma unroll
        for (int i = 0; i < 2; ++i) voffA[i] = (unsigned)(R[i] * S.lda2 + C[i] * 2);
        hstepA = (size_t)HALF * S.lda2;
    }
#define PG8_STA(bufoff, abase, h, vv) do { if constexpr (AFF) PG8_STAGE(bufoff, (abase) + (h) * hstepA, voffA); else PG8_STAGE(bufoff, abase, (vv)[h]); } while (0)
    Unit cur, nxt; int ui = 0;
    if (!S.next(0, cur)) return;
    f32x4 acc[2][2][4][2];
    if constexpr (SUB == 0) E.init(acc, cur, wr, wc, fr, fq);
    else E.template init_sub<SUB>(acc, cur, wr, wc, fr, fq);
    bf16x8 At[4][2], B0[2][2], B1[2][2];
    unsigned vA[2][2] = {{0u, 0u}, {0u, 0u}}, vAn[2][2] = {{0u, 0u}, {0u, 0u}};
    const char* uA = Abase;
    if constexpr (AFF) uA = Abase + S.a_unit_off(cur) + (SUB ? (size_t)cur.sa * hstepA : (size_t)0); else S.a_offs(cur, R, C, vA);
    const char* cB = S.b_ptr(cur) + (SUB == 2 ? (size_t)cur.sb * hstepB : (size_t)0);
    PG8_STAGE(PG8_SB(0, 0), cB, voffB); PG8_STAGE(PG8_SB(0, 1), cB + hstepB, voffB); PG8_STA(PG8_SA(0, 0), uA, 0, vA); PG8_STA(PG8_SA(0, 1), uA, 1, vA);
    if (wr == 1) PG8_BAR;
    PG8_WAIT_V(2); PG8_BAR;
    PG8_STAGE(PG8_SB(1, 0), cB + kstep, voffB); PG8_STA(PG8_SA(1, 0), uA + kstep, 0, vA); PG8_STAGE(PG8_SB(1, 1), cB + hstepB + kstep, voffB);
    PG8_WAIT_V(6); PG8_BAR;
#define PG8_WAIT_N(n) asm volatile("s_waitcnt vmcnt(%0)" :: "n"(n) : "memory")
#define PG8_WAIT_R() do { if (rlx) PG8_WAIT_N(NS + 8); else PG8_WAIT_N(8); } while (0)
    constexpr int NS = SUB ? 0 : Epi::NSTORE;
    for (;;) {
        const bool has_next = S.next(ui + 1, nxt);
        const char* nuA = uA;
        if constexpr (AFF) { if (has_next) nuA = Abase + S.a_unit_off(nxt) + (SUB ? (size_t)nxt.sa * hstepA : (size_t)0); }
        else {
            if (has_next) { int td = tid; asm volatile("" : "+v"(td)); int R2[2], C2[2]; stage_rc(td * 16, R2[0], C2[0]); stage_rc(td * 16 + 8192, R2[1], C2[1]); S.a_offs(nxt, R2, C2, vAn); }
            else {
#pragma unroll
                for (int h = 0; h < 2; ++h) { vAn[h][0] = vA[h][0]; vAn[h][1] = vA[h][1]; }
            }
        }
        const char* nB = has_next ? S.b_ptr(nxt) + (SUB == 2 ? (size_t)nxt.sb * hstepB : (size_t)0) : cB;
        for (int t = 0; t < nt; t += 2) {
            const bool last = (t == nt - 2);
            const bool rlx = NS > 0 && t == 0 && ui > 0;
            const char* a1 = uA + (size_t)(t + 1) * kstep;
            const char* a2 = last ? nuA : uA + (size_t)(t + 2) * kstep; const char* b2 = last ? nB : cB + (size_t)(t + 2) * kstep;
            const char* a3 = a2 + kstep; const char* b3 = b2 + kstep;
            unsigned va2[2][2] = {{0u, 0u}, {0u, 0u}};
            if constexpr (!AFF) {
#pragma unroll
                for (int h = 0; h < 2; ++h) { va2[h][0] = last ? vAn[h][0] : vA[h][0]; va2[h][1] = last ? vAn[h][1] : vA[h][1]; }
            }
            PG8_LDB(B0, 0, 0); if constexpr (SUB < 2) PG8_LDB(B1, 0, 1); PG8_SCHED; PG8_LDA(At, 0, 0); if (NS == 0 || t > 0 || ui == 0) PG8_STA(PG8_SA(1, 1), a1, 1, vA);
            PG8_WAIT_R(); PG8_WAIT_L(0); PG8_BAR; PG8_MMA(0, 0, At, B0); if constexpr (SUB < 2) PG8_MMA(0, 1, At, B1); PG8_BAR; PG8_SCHED;
            if constexpr (SUB == 0) PG8_LDA(At, 0, 1); PG8_STAGE(PG8_SB(0, 0), b2, voffB); PG8_STAGE(PG8_SB(0, 1), b2 + hstepB, voffB); PG8_STA(PG8_SA(0, 0), a2, 0, va2);
            PG8_WAIT_R(); PG8_WAIT_L(0); PG8_BAR; if constexpr (SUB == 0) { PG8_MMA(1, 0, At, B0); PG8_MMA(1, 1, At, B1); } PG8_BAR; PG8_SCHED;
            PG8_LDB(B0, 1, 0); if constexpr (SUB < 2) PG8_LDB(B1, 1, 1); PG8_SCHED; PG8_LDA(At, 1, 0); PG8_STA(PG8_SA(0, 1), a2, 1, va2);
            PG8_WAIT_R(); PG8_WAIT_L(0); PG8_BAR; PG8_MMA(0, 0, At, B0); if constexpr (SUB < 2) PG8_MMA(0, 1, At, B1); PG8_BAR; PG8_SCHED;
            if constexpr (SUB == 0) PG8_LDA(At, 1, 1); PG8_STAGE(PG8_SB(1, 0), b3, voffB); PG8_STAGE(PG8_SB(1, 1), b3 + hstepB, voffB); PG8_STA(PG8_SA(1, 0), a3, 0, va2);
            PG8_WAIT_V(8); PG8_WAIT_L(0); PG8_BAR; if constexpr (SUB == 0) { PG8_MMA(1, 0, At, B0); PG8_MMA(1, 1, At, B1); } PG8_BAR; PG8_SCHED;
        }
        if constexpr (ALIGN_EPI) { if (wr == 0) PG8_BAR; }
        if (NS > 0) PG8_STA(PG8_SA(1, 1), nuA + kstep, 1, vAn);
        int ln = tid; asm volatile("" : "+v"(ln)); ln &= 63;
        if constexpr (SUB == 0) E(acc, cur, wr, wc, ln & 15, ln >> 4); else E.template run_sub<SUB>(acc, cur, wr, wc, ln & 15, ln >> 4);
        if (!has_next) break;
        if constexpr (SUB == 0) E.init(acc, nxt, wr, wc, ln & 15, ln >> 4); else E.template init_sub<SUB>(acc, nxt, wr, wc, ln & 15, ln >> 4);
        cur = nxt; cB = nB; uA = nuA; ++ui;
        if constexpr (!AFF) {
#pragma unroll
            for (int h = 0; h < 2; ++h) { vA[h][0] = vAn[h][0]; vA[h][1] = vAn[h][1]; }
        }
        if constexpr (ALIGN_EPI) { if (wr == 1) PG8_BAR; }
    }
    PG8_WAIT_V(0);
    if constexpr (!ALIGN_EPI) { if (wr == 0) PG8_BAR; }
    PG8_BAR;
#undef PG8_SA
#undef PG8_SB
#undef PG8_STAGE
#undef PG8_STA
#undef PG8_LDA
#undef PG8_LDB
#undef PG8_MMA
#undef PG8_WAIT_V
#undef PG8_WAIT_L
#undef PG8_BAR
#undef PG8_SCHED
#undef PG8_WAIT_R
#undef PG8_WAIT_N
}

__device__ __forceinline__ u32x4 pack8(const f32x4& a, const f32x4& b) { u32x4 w; w.x = pk2(a[0], a[1]); w.y = pk2(a[2], a[3]); w.z = pk2(b[0], b[1]); w.w = pk2(b[2], b[3]); return w; }

struct SchedPlain {
    static constexpr bool AFFINE = true;
    const char* Bt; int lda2, ldb2; int nM, nN, G, c;
    __device__ __forceinline__ size_t a_unit_off(const Unit& u) const { return (size_t)u.pm * 256 * lda2; }
    __device__ __forceinline__ bool next(int i, Unit& u) const {
        const int L = i * G + c; if (L >= nM * nN) return false;
        const int nig = 8 * nN, gid = L / nig, fm = gid * 8, wi = L % nig; int gsz = nM - fm; gsz = gsz < 8 ? gsz : 8;
        u.pm = fm + wi % gsz; u.pn = wi / gsz; u.e = 0; u.sa = 0; u.sb = 0; return true;
    }
    __device__ __forceinline__ void a_offs(const Unit& u, const int (&R)[2], const int (&C)[2], unsigned (&v)[2][2]) const {
#pragma unroll
        for (int h = 0; h < 2; ++h)
#pragma unroll
            for (int i = 0; i < 2; ++i) v[h][i] = (unsigned)(u.pm * 256 + h * 128 + R[i]) * (unsigned)lda2 + (unsigned)(C[i] * 2);
    }
    __device__ __forceinline__ const char* b_ptr(const Unit& u) const { return Bt + (size_t)u.pn * 256 * ldb2; }
};

struct EpiInProj {
    static constexpr int NSTORE = 16;
    bf16_t* O; const float* gtab;
    __device__ __forceinline__ void init(f32x4 (&acc)[2][2][4][2], const Unit&, int, int, int, int) const {
#pragma unroll
        for (int a = 0; a < 2; ++a)
#pragma unroll
            for (int b = 0; b < 2; ++b)
#pragma unroll
                for (int m = 0; m < 4; ++m)
#pragma unroll
                    for (int n = 0; n < 2; ++n) acc[a][b][m][n] = (f32x4){0.f, 0.f, 0.f, 0.f};
    }
    __device__ __forceinline__ void operator()(const f32x4 (&acc)[2][2][4][2], const Unit& u, int wr, int wc, int fr, int fq) const {
#pragma unroll
        for (int bj = 0; bj < 2; ++bj) {
            const int col = u.pn * 256 + bj * 128 + wc * 32, grp = col >> 5;
            int t = -1;
            if (grp >= 40 && grp < 48) t = 0; else if (grp >= 48 && grp < 50) t = 1; else if (grp >= 56 && grp < 68) t = 2; else if (grp >= 68 && grp < 80) t = 3;
            int sh = 0;
            if (grp >= 56 && grp < 92) { const int gg = ((grp - 56) % 12) >> 2; sh = 2 * gg; }
            const int smask = (1 << sh) - 1, sstr = SEQ >> sh;
            bf16_t* const Ob = O + col + 8 * fq;
            const int row0 = u.pm * 256 + wr * 64 + fr;
            if (t >= 0) {
                const f32x4 g0 = *(const f32x4*)(gtab + t * 32 + 8 * fq), g1 = *(const f32x4*)(gtab + t * 32 + 8 * fq + 4);
#pragma unroll
                for (int ai = 0; ai < 2; ++ai)
#pragma unroll
                    for (int m = 0; m < 4; ++m) {
                        f32x4 v0 = acc[ai][bj][m][0], v1 = acc[ai][bj][m][1];
                        float s = (v0[0] * v0[0] + v0[1] * v0[1]) + (v0[2] * v0[2] + v0[3] * v0[3]) + (v1[0] * v1[0] + v1[1] * v1[1]) + (v1[2] * v1[2] + v1[3] * v1[3]);
                        s = x32_add(x16_add(s));
                        const float rs = __builtin_amdgcn_rsqf(s * (1.f / 32.f) + EPS);
                        v0 = v0 * rs * g0; v1 = v1 * rs * g1;
                        const int row = row0 + ai * 128 + m * 16, sq = row & (SEQ - 1);
                        *(u32x4*)(Ob + (size_t)((row & ~(SEQ - 1)) + (sq & smask) * sstr + (sq >> sh)) * PW) = pack8(v0, v1);
                    }
            } else {
#pragma unroll
                for (int ai = 0; ai < 2; ++ai)
#pragma unroll
                    for (int m = 0; m < 4; ++m) {
                        const int row = row0 + ai * 128 + m * 16, sq = row & (SEQ - 1);
                        *(u32x4*)(Ob + (size_t)((row & ~(SEQ - 1)) + (sq & smask) * sstr + (sq >> sh)) * PW) = pack8(acc[ai][bj][m][0], acc[ai][bj][m][1]);
                    }
            }
        }
    }
};
struct EpiBf16 {
    static constexpr int NSTORE = 16;
    bf16_t* O; int ldo; int coff;
    __device__ __forceinline__ void init(f32x4 (&acc)[2][2][4][2], const Unit&, int, int, int, int) const {
#pragma unroll
        for (int a = 0; a < 2; ++a)
#pragma unroll
            for (int b = 0; b < 2; ++b)
#pragma unroll
                for (int m = 0; m < 4; ++m)
#pragma unroll
                    for (int n = 0; n < 2; ++n) acc[a][b][m][n] = (f32x4){0.f, 0.f, 0.f, 0.f};
    }
    __device__ __forceinline__ void operator()(const f32x4 (&acc)[2][2][4][2], const Unit& u, int wr, int wc, int fr, int fq) const {
#pragma unroll
        for (int ai = 0; ai < 2; ++ai)
#pragma unroll
            for (int m = 0; m < 4; ++m) {
                const int row = u.pm * 256 + ai * 128 + wr * 64 + m * 16 + fr;
#pragma unroll
                for (int bj = 0; bj < 2; ++bj) *(u32x4*)(O + (size_t)row * ldo + coff + u.pn * 256 + bj * 128 + wc * 32 + 8 * fq) = pack8(acc[ai][bj][m][0], acc[ai][bj][m][1]);
            }
    }
};
struct EpiResid {
    static constexpr int NSTORE = 16;
    const void* res; int res_f32; bf16_t* out;
    __device__ __forceinline__ void init(f32x4 (&acc)[2][2][4][2], const Unit& u, int wr, int wc, int fr, int fq) const {
        if (res_f32) {
            const float* rf = (const float*)res;
#pragma unroll
            for (int ai = 0; ai < 2; ++ai)
#pragma unroll
                for (int m = 0; m < 4; ++m) {
                    const int row = u.pm * 256 + ai * 128 + wr * 64 + m * 16 + fr;
#pragma unroll
                    for (int bj = 0; bj < 2; ++bj) {
                        const size_t o = (size_t)row * DM + u.pn * 256 + bj * 128 + wc * 32 + 8 * fq;
                        acc[ai][bj][m][0] = *(const f32x4*)(rf + o); acc[ai][bj][m][1] = *(const f32x4*)(rf + o + 4);
                    }
                }
        } else {
            const bf16_t* rb = (const bf16_t*)res;
#pragma unroll
            for (int ai = 0; ai < 2; ++ai)
#pragma unroll
                for (int m = 0; m < 4; ++m) {
                    const int row = u.pm * 256 + ai * 128 + wr * 64 + m * 16 + fr;
#pragma unroll
                    for (int bj = 0; bj < 2; ++bj) {
                        const u32x4 w = *(const u32x4*)(rb + (size_t)row * DM + u.pn * 256 + bj * 128 + wc * 32 + 8 * fq);
                        acc[ai][bj][m][0] = unpk4(w.x, w.y); acc[ai][bj][m][1] = unpk4(w.z, w.w);
                    }
                }
        }
    }
    __device__ __forceinline__ void operator()(const f32x4 (&acc)[2][2][4][2], const Unit& u, int wr, int wc, int fr, int fq) const {
#pragma unroll
        for (int ai = 0; ai < 2; ++ai)
#pragma unroll
            for (int m = 0; m < 4; ++m) {
                const int row = u.pm * 256 + ai * 128 + wr * 64 + m * 16 + fr;
#pragma unroll
                for (int bj = 0; bj < 2; ++bj)
                    *(u32x4*)(out + (size_t)row * DM + u.pn * 256 + bj * 128 + wc * 32 + 8 * fq) = pack8(acc[ai][bj][m][0], acc[ai][bj][m][1]);
            }
    }
};
struct EpiSwiglu {
    static constexpr int NSTORE = 8;
    bf16_t* O; int ldo;
    __device__ __forceinline__ void init(f32x4 (&acc)[2][2][4][2], const Unit&, int, int, int, int) const {
#pragma unroll
        for (int a = 0; a < 2; ++a)
#pragma unroll
            for (int b = 0; b < 2; ++b)
#pragma unroll
                for (int m = 0; m < 4; ++m)
#pragma unroll
                    for (int n = 0; n < 2; ++n) acc[a][b][m][n] = (f32x4){0.f, 0.f, 0.f, 0.f};
    }
    __device__ __forceinline__ void operator()(const f32x4 (&acc)[2][2][4][2], const Unit& u, int wr, int wc, int fr, int fq) const {
#pragma unroll
        for (int ai = 0; ai < 2; ++ai)
#pragma unroll
            for (int m = 0; m < 4; ++m) {
                f32x4 v[2];
#pragma unroll
                for (int n = 0; n < 2; ++n)
#pragma unroll
                    for (int q = 0; q < 4; ++q) { const float g = acc[ai][0][m][n][q], uu = acc[ai][1][m][n][q]; v[n][q] = g * uu * rcpf(1.f + ex2(g)); }
                const int row = u.pm * 256 + ai * 128 + wr * 64 + m * 16 + fr;
                *(u32x4*)(O + (size_t)row * ldo + u.pn * 128 + wc * 32 + 8 * fq) = pack8(v[0], v[1]);
            }
    }
};

struct MoeInfo {
    int cnt[16], ts[17];
    __device__ __forceinline__ void load(const unsigned* ctl) {
        int s = 0;
#pragma unroll
        for (int g = 0; g < 16; ++g) { cnt[g] = (int)__builtin_amdgcn_readfirstlane(ctl[CW_MOE + 64 * g]); ts[g] = s; s += (cnt[g] + 255) >> 8; }
        ts[16] = s;
    }
    __device__ __forceinline__ void find(int rt, int& g, int& t0, int& n) const {
        g = 0; t0 = 0; n = cnt[0];
#pragma unroll
        for (int q = 1; q < 16; ++q) if (rt >= ts[q]) { g = q; t0 = ts[q]; n = cnt[q]; }
    }
};
struct SchedMoeUp {
    static constexpr bool AFFINE = false; static constexpr int lda2 = 0;
    MoeInfo mi; const char* W; const int* mtok; int ldb2; int G, c; int u0, nu, sh;
    __device__ __forceinline__ size_t a_unit_off(const Unit&) const { return 0; }
    __device__ __forceinline__ bool next(int i, Unit& u) const {
        const int nM = mi.ts[16], nN = 6; const int q = i * G + c; if (q >= (nu << sh)) return false;
        const int L = u0 + (q >> sh);
        const int nig = 8 * nN, gid = L / nig, fm = gid * 8, wi = L % nig; int gsz = nM - fm; gsz = gsz < 8 ? gsz : 8;
        u.pm = fm + wi % gsz; u.pn = wi / gsz; int g, t0, n; mi.find(u.pm, g, t0, n); u.e = g; u.sa = q & ((1 << sh) - 1); u.sb = 0; return true;
    }
    __device__ __forceinline__ void a_offs(const Unit& u, const int (&R)[2], const int (&C)[2], unsigned (&v)[2][2]) const {
        int g, t0, n; mi.find(u.pm, g, t0, n);
#pragma unroll
        for (int h = 0; h < 2; ++h)
#pragma unroll
            for (int i = 0; i < 2; ++i) { const int pos = (u.pm - t0) * 256 + (u.sa + h) * 128 + R[i]; const int tok = pos < n ? mtok[g * NTOK + pos] : 0; v[h][i] = (unsigned)tok * 2048u + (unsigned)(C[i] * 2); }
    }
    __device__ __forceinline__ const char* b_ptr(const Unit& u) const { return W + (size_t)(u.e & 7) * (1536 * 1024 * 2) + (size_t)u.pn * 256 * 2048; }
};
struct SchedMoeDown {
    static constexpr bool AFFINE = true; static constexpr int lda2 = 1536;
    MoeInfo mi; const char* W; int ldb2; int r0, nM, G, c; int u0, nu, sh;
    __device__ __forceinline__ size_t a_unit_off(const Unit& u) const { return (size_t)u.pm * 256 * 1536; }
    __device__ __forceinline__ bool next(int i, Unit& u) const {
        const int nN = 4; const int q = i * G + c; if (q >= (nu << sh)) return false;
        const int L = u0 + (q >> sh), sub = q & ((1 << sh) - 1);
        const int nig = 8 * nN, gid = L / nig, fm = gid * 8, wi = L % nig; int gsz = nM - fm; gsz = gsz < 8 ? gsz : 8;
        u.pm = r0 + fm + wi % gsz; u.pn = wi / gsz; int g, t0, n; mi.find(u.pm, g, t0, n); u.e = g;
        u.sa = sh == 2 ? (sub >> 1) : sub; u.sb = sh == 2 ? (sub & 1) : 0; return true;
    }
    __device__ __forceinline__ void a_offs(const Unit& u, const int (&R)[2], const int (&C)[2], unsigned (&v)[2][2]) const {
#pragma unroll
        for (int h = 0; h < 2; ++h)
#pragma unroll
            for (int i = 0; i < 2; ++i) v[h][i] = (unsigned)(u.pm * 256 + h * 128 + R[i]) * 1536u + (unsigned)(C[i] * 2);
    }
    __device__ __forceinline__ const char* b_ptr(const Unit& u) const { return W + (size_t)(u.e & 7) * (1024 * 768 * 2) + (size_t)u.pn * 256 * 1536; }
};
struct EpiSwigluMoe {
    static constexpr int NSTORE = 8;
    MoeInfo mi; bf16_t* O; const float* mw;
    template <int SUB>
    __device__ __forceinline__ void init_sub(f32x4 (&acc)[2][2][4][2], const Unit&, int, int, int, int) const {
#pragma unroll
        for (int a = 0; a < (SUB ? 1 : 2); ++a)
#pragma unroll
            for (int b = 0; b < 2; ++b)
#pragma unroll
                for (int m = 0; m < 4; ++m)
#pragma unroll
                    for (int n = 0; n < 2; ++n) acc[a][b][m][n] = (f32x4){0.f, 0.f, 0.f, 0.f};
    }
    template <int SUB>
    __device__ __forceinline__ void run_sub(const f32x4 (&acc)[2][2][4][2], const Unit& u, int wr, int wc, int fr, int fq) const {
        constexpr int NA = SUB ? 1 : 2;
        int g, t0, n; mi.find(u.pm, g, t0, n);
        float wv[NA][4];
#pragma unroll
        for (int ai = 0; ai < NA; ++ai)
#pragma unroll
            for (int m = 0; m < 4; ++m) { const int pos = (u.pm - t0) * 256 + (u.sa + ai) * 128 + wr * 64 + m * 16 + fr; wv[ai][m] = pos < n ? mw[g * NTOK + pos] : 0.f; }
#pragma unroll
        for (int ai = 0; ai < NA; ++ai)
#pragma unroll
            for (int m = 0; m < 4; ++m) {
                f32x4 v[2];
#pragma unroll
                for (int nn = 0; nn < 2; ++nn)
#pragma unroll
                    for (int q = 0; q < 4; ++q) { const float gg = acc[ai][0][m][nn][q], uu = acc[ai][1][m][nn][q]; v[nn][q] = wv[ai][m] * gg * uu * rcpf(1.f + ex2(gg)); }
                const int row = u.pm * 256 + (u.sa + ai) * 128 + wr * 64 + m * 16 + fr;
                *(u32x4*)(O + (size_t)row * 768 + u.pn * 128 + wc * 32 + 8 * fq) = pack8(v[0], v[1]);
            }
    }
    __device__ __forceinline__ void init(f32x4 (&acc)[2][2][4][2], const Unit& u, int wr, int wc, int fr, int fq) const { init_sub<0>(acc, u, wr, wc, fr, fq); }
    __device__ __forceinline__ void operator()(const f32x4 (&acc)[2][2][4][2], const Unit& u, int wr, int wc, int fr, int fq) const { run_sub<0>(acc, u, wr, wc, fr, fq); }
};
struct EpiMoeDown {
    static constexpr int NSTORE = 0;
    MoeInfo mi; const bf16_t* src; void* dst; int dst_f32; const int* mtok;
    template <int SUB>
    __device__ __forceinline__ void init_sub(f32x4 (&acc)[2][2][4][2], const Unit& u, int wr, int wc, int fr, int fq) const {
        constexpr int NA = SUB ? 1 : 2, NB = SUB == 2 ? 1 : 2;
        int g, t0, n; mi.find(u.pm, g, t0, n);
#pragma unroll
        for (int ai = 0; ai < NA; ++ai)
#pragma unroll
            for (int m = 0; m < 4; ++m) {
                const int pos = (u.pm - t0) * 256 + (u.sa + ai) * 128 + wr * 64 + m * 16 + fr;
                const int tok = pos < n ? mtok[g * NTOK + pos] : -1;
#pragma unroll
                for (int bj = 0; bj < NB; ++bj) {
                    if (tok >= 0) { const u32x4 w = *(const u32x4*)(src + (size_t)tok * DM + u.pn * 256 + (u.sb + bj) * 128 + wc * 32 + 8 * fq); acc[ai][bj][m][0] = unpk4(w.x, w.y); acc[ai][bj][m][1] = unpk4(w.z, w.w); }
                    else { acc[ai][bj][m][0] = (f32x4){0.f, 0.f, 0.f, 0.f}; acc[ai][bj][m][1] = (f32x4){0.f, 0.f, 0.f, 0.f}; }
                }
            }
    }
    template <int SUB>
    __device__ __forceinline__ void run_sub(const f32x4 (&acc)[2][2][4][2], const Unit& u, int wr, int wc, int fr, int fq) const {
        constexpr int NA = SUB ? 1 : 2, NB = SUB == 2 ? 1 : 2;
        int g, t0, n; mi.find(u.pm, g, t0, n);
        int tk[NA][4];
#pragma unroll
        for (int ai = 0; ai < NA; ++ai)
#pragma unroll
            for (int m = 0; m < 4; ++m) { const int pos = (u.pm - t0) * 256 + (u.sa + ai) * 128 + wr * 64 + m * 16 + fr; tk[ai][m] = pos < n ? mtok[g * NTOK + pos] : -1; }
        if (dst_f32) {
            float* out = (float*)dst;
#pragma unroll
            for (int ai = 0; ai < NA; ++ai)
#pragma unroll
                for (int m = 0; m < 4; ++m) {
                    if (tk[ai][m] >= 0) {
#pragma unroll
                        for (int bj = 0; bj < NB; ++bj) {
                            const size_t o = (size_t)tk[ai][m] * DM + u.pn * 256 + (u.sb + bj) * 128 + wc * 32 + 8 * fq;
                            *(f32x4*)(out + o) = acc[ai][bj][m][0]; *(f32x4*)(out + o + 4) = acc[ai][bj][m][1];
                        }
                    }
                }
        } else {
            bf16_t* out = (bf16_t*)dst;
#pragma unroll
            for (int ai = 0; ai < NA; ++ai)
#pragma unroll
                for (int m = 0; m < 4; ++m) {
                    if (tk[ai][m] >= 0) {
#pragma unroll
                        for (int bj = 0; bj < NB; ++bj)
                            *(u32x4*)(out + (size_t)tk[ai][m] * DM + u.pn * 256 + (u.sb + bj) * 128 + wc * 32 + 8 * fq) = pack8(acc[ai][bj][m][0], acc[ai][bj][m][1]);
                    }
                }
        }
    }
    __device__ __forceinline__ void init(f32x4 (&acc)[2][2][4][2], const Unit& u, int wr, int wc, int fr, int fq) const { init_sub<0>(acc, u, wr, wc, fr, fq); }
    __device__ __forceinline__ void operator()(const f32x4 (&acc)[2][2][4][2], const Unit& u, int wr, int wc, int fr, int fq) const { run_sub<0>(acc, u, wr, wc, fr, fq); }
};
}

__device__ __forceinline__ void st16_bf16(bf16_t* p, const f32x16& v) {
    u32x4 a, b;
    a.x = pk2(v[0], v[1]); a.y = pk2(v[2], v[3]); a.z = pk2(v[4], v[5]); a.w = pk2(v[6], v[7]);
    b.x = pk2(v[8], v[9]); b.y = pk2(v[10], v[11]); b.z = pk2(v[12], v[13]); b.w = pk2(v[14], v[15]);
    *(u32x4*)p = a; *(u32x4*)(p + 8) = b;
}
__device__ __forceinline__ void merge_phase(const Params& p, const Ctx& c0, int l) {
    const Ctx c = launder(c0);
    unsigned char* const wsl = launder_ptr(p.ws);
    LAS unsigned char* lds = c.lds + LDS_STAGE;
    const int tid = c.tid, lane = c.lane, wid = c.wid, wr = wid >> 2, wc = wid & 3, fr = lane & 15, fq = lane >> 4;
    const float* bneg = (const float*)(wsl + WS_TAB) + 20 * 132 + 256 + l * 4096; bf16_t* Y = (bf16_t*)(wsl + WS_Y);
    constexpr int HTB = 16384, KTB = 3 * HTB;
    const int NU = 256 * 4;
    int R[2], C[2];
    unsigned vAg[2], vAb[2], vB1[2], vB2[2];
#pragma unroll
    for (int i = 0; i < 2; ++i) { pg8::stage_rc(tid * 16 + i * 8192, R[i], C[i]); const int Rb = (R[i] & ~31) + pg8::perm32(R[i] & 31);
        vAg[i] = (unsigned)(R[i] * (PW * 2) + C[i] * 2); vAb[i] = (unsigned)(R[i] * (AOW * 2) + C[i] * 2); vB1[i] = (unsigned)(Rb * 256 + C[i] * 2); vB2[i] = (unsigned)(Rb * 512 + C[i] * 2); }
    const char* pPG = (const char*)(wsl + WS_PROJ) + PC_GLOW * 2; const char* pAO = (const char*)(wsl + WS_AO);
    const char* pGB = (const char*)(wsl + WS_WGB) + (size_t)l * 4096 * 128 * 2; const char* pBR = (const char*)(wsl + WS_WBR) + (size_t)l * 1024 * 1024 * 2;
    const unsigned ldsw = (unsigned)wid * 1024u;
    const int aoff = pg8::lds_byte(wr * 64 + fr, fq * 8), boff = pg8::lds_byte(wc * 32 + fr, fq * 8);
#define UNIT_OF(i, pm, pn, ok) do { const int L_ = (i) * c.G + (int)blockIdx.x; ok = L_ < NU; if (ok) { const int gid_ = L_ / 32, wi_ = L_ % 32; pm = gid_ * 8 + wi_ % 8; pn = wi_ / 8; } } while (0)
    int pml = 0, pnl = 0, jl = 0, iul = 0, bl = 0; bool okl = false;
    UNIT_OF(0, pml, pnl, okl);
    if (!okl) return;
#define L_STAGE() do { const int i_ = jl < 18 ? jl / 6 : 3, jj_ = jl - 6 * i_, nkb_ = i_ < 3 ? 4 : 2; const bool isg_ = jj_ >= nkb_; const int kc_ = isg_ ? jj_ - nkb_ : jj_; \
        const size_t lda2_ = isg_ ? PW * 2 : AOW * 2, ldb2_ = isg_ ? 256 : (i_ < 3 ? 512 : 256); \
        const char* ua_ = (isg_ ? pPG : pAO + i_ * 512) + kc_ * 128 + (size_t)pml * 128 * lda2_; \
        const char* ub_ = (isg_ ? pGB + (size_t)i_ * (1024 * 128 * 2) : pBR + (size_t)i_ * (1024 * 256 * 2)) + kc_ * 128 + (size_t)pnl * 256 * ldb2_; \
        LAS unsigned char* d_ = lds + bl * KTB + ldsw; \
        _Pragma("unroll") for (int q_ = 0; q_ < 2; ++q_) { \
            __builtin_amdgcn_global_load_lds((const unsigned*)(ua_ + (isg_ ? vAg[q_] : vAb[q_])), (LAS unsigned*)(d_ + q_ * 8192), 16, 0, 0); \
            __builtin_amdgcn_global_load_lds((const unsigned*)(ub_ + (ldb2_ == 256 ? vB1[q_] : vB2[q_])), (LAS unsigned*)(d_ + HTB + q_ * 8192), 16, 0, 0); \
            __builtin_amdgcn_global_load_lds((const unsigned*)(ub_ + 128 * ldb2_ + (ldb2_ == 256 ? vB1[q_] : vB2[q_])), (LAS unsigned*)(d_ + 2 * HTB + q_ * 8192), 16, 0, 0); } \
        bl = bl == 2 ? 0 : bl + 1; \
        if (jl + 1 < 22) ++jl; else { int pm2_ = 0, pn2_ = 0; bool ok2_; UNIT_OF(iul + 1, pm2_, pn2_, ok2_); if (ok2_) { ++iul; jl = 0; pml = pm2_; pnl = pn2_; } } } while (0)
#define L_WAITV(n) asm volatile("s_waitcnt vmcnt(" #n ")" ::: "memory")
#define L_BAR __builtin_amdgcn_s_barrier()
    bf16x8 At[4][2], B0[2][2], B1[2][2];
    f32x4 acc[2][4][2];
#define L_STEP() do { const LAS unsigned char* b_ = lds + bc * KTB; \
        _Pragma("unroll") for (int n = 0; n < 2; ++n) _Pragma("unroll") for (int k = 0; k < 2; ++k) { B0[n][k] = *(const LAS bf16x8*)(b_ + HTB + boff + n * 2048 + k * 1024); B1[n][k] = *(const LAS bf16x8*)(b_ + 2 * HTB + boff + n * 2048 + k * 1024); } \
        __builtin_amdgcn_sched_barrier(0); \
        _Pragma("unroll") for (int m = 0; m < 4; ++m) _Pragma("unroll") for (int k = 0; k < 2; ++k) At[m][k] = *(const LAS bf16x8*)(b_ + aoff + m * 2048 + k * 1024); \
        L_STAGE(); \
        L_WAITV(6); asm volatile("s_waitcnt lgkmcnt(0)" ::: "memory"); L_BAR; \
        __builtin_amdgcn_s_setprio(1); \
        _Pragma("unroll") for (int m = 0; m < 4; ++m) _Pragma("unroll") for (int n = 0; n < 2; ++n) _Pragma("unroll") for (int k = 0; k < 2; ++k) { \
            acc[0][m][n] = __builtin_amdgcn_mfma_f32_16x16x32_bf16(B0[n][k], At[m][k], acc[0][m][n], 0, 0, 0); \
            acc[1][m][n] = __builtin_amdgcn_mfma_f32_16x16x32_bf16(B1[n][k], At[m][k], acc[1][m][n], 0, 0, 0); } \
        __builtin_amdgcn_s_setprio(0); \
        L_BAR; __builtin_amdgcn_sched_barrier(0); \
        bc = bc == 2 ? 0 : bc + 1; } while (0)
    L_STAGE(); L_STAGE();
    L_WAITV(6); L_BAR;
    if (wr == 1) L_BAR;
    int bc = 0, pm = pml, pn = pnl; bool ok = true;
    pm = 0; pn = 0; UNIT_OF(0, pm, pn, ok);
#pragma unroll 1
    for (int iu = 0; ok; ++iu) {
        unsigned yy[2][4][2][2];
#pragma unroll
        for (int a = 0; a < 2; ++a)
#pragma unroll
            for (int m = 0; m < 4; ++m) { yy[a][m][0][0] = 0u; yy[a][m][0][1] = 0u; yy[a][m][1][0] = 0u; yy[a][m][1][1] = 0u; }
#pragma unroll 1
        for (int i = 0; i < 4; ++i) {
            const int nkb = i < 3 ? 4 : 2;
#pragma unroll
            for (int a = 0; a < 2; ++a)
#pragma unroll
                for (int m = 0; m < 4; ++m) { acc[a][m][0] = (f32x4){0.f, 0.f, 0.f, 0.f}; acc[a][m][1] = (f32x4){0.f, 0.f, 0.f, 0.f}; }
#pragma unroll 1
            for (int kc = 0; kc < nkb; ++kc) L_STEP();
            unsigned tpk[2][4][2][2];
            __builtin_amdgcn_sched_barrier(0);
#pragma unroll
            for (int bj = 0; bj < 2; ++bj) {
                int fqb = fq; asm volatile("" : "+v"(fqb));
                const float* bp = bneg + i * 1024 + pn * 256 + bj * 128 + wc * 32 + 8 * fqb;
                const f32x4 b0 = *(const f32x4*)bp, b1 = *(const f32x4*)(bp + 4);
#pragma unroll
                for (int m = 0; m < 4; ++m) {
#pragma unroll
                    for (int n = 0; n < 2; ++n) { tpk[bj][m][n][0] = pk2(acc[bj][m][n][0], acc[bj][m][n][1]); tpk[bj][m][n][1] = pk2(acc[bj][m][n][2], acc[bj][m][n][3]); }
                    acc[bj][m][0] = b0; acc[bj][m][1] = b1;
                }
            }
            __builtin_amdgcn_sched_barrier(0);
#pragma unroll 1
            for (int kc = 0; kc < 2; ++kc) L_STEP();
#pragma unroll
            for (int bj = 0; bj < 2; ++bj)
#pragma unroll
                for (int m = 0; m < 4; ++m)
#pragma unroll
                    for (int n = 0; n < 2; ++n) {
                        const float y0 = bflo(yy[bj][m][n][0]) + bflo(tpk[bj][m][n][0]) * rcpf(1.f + ex2(acc[bj][m][n][0]));
                        const float y1 = bfhi(yy[bj][m][n][0]) + bfhi(tpk[bj][m][n][0]) * rcpf(1.f + ex2(acc[bj][m][n][1]));
                        const float y2 = bflo(yy[bj][m][n][1]) + bflo(tpk[bj][m][n][1]) * rcpf(1.f + ex2(acc[bj][m][n][2]));
                        const float y3 = bfhi(yy[bj][m][n][1]) + bfhi(tpk[bj][m][n][1]) * rcpf(1.f + ex2(acc[bj][m][n][3]));
                        yy[bj][m][n][0] = pk2(y0, y1); yy[bj][m][n][1] = pk2(y2, y3);
                    }
        }
#pragma unroll
        for (int m = 0; m < 4; ++m) {
            int lb = lane; asm volatile("" : "+v"(lb));
            const int row = pm * 128 + wr * 64 + m * 16 + (lb & 15);
#pragma unroll
            for (int bj = 0; bj < 2; ++bj)
                *(u32x4*)(Y + (size_t)row * DM + pn * 256 + bj * 128 + wc * 32 + 8 * (lb >> 4)) = (u32x4){yy[bj][m][0][0], yy[bj][m][0][1], yy[bj][m][1][0], yy[bj][m][1][1]};
        }
        UNIT_OF(iu + 1, pm, pn, ok);
    }
    if (wr == 0) L_BAR;
    L_WAITV(0); L_BAR;
#undef UNIT_OF
#undef L_STAGE
#undef L_WAITV
#undef L_BAR
#undef L_STEP
}

__device__ __forceinline__ void mla_finalize(const Params& p, const Ctx& c0, int l) {
    const Ctx c = launder(c0);
    unsigned char* const wsl = launder_ptr(p.ws);
    const bf16_t* PROJ = (const bf16_t*)(wsl + WS_PROJ); const bf16_t* RAW = (const bf16_t*)(wsl + WS_H);
    bf16_t* QM = (bf16_t*)(wsl + WS_Y); bf16_t* KM = QM + (size_t)NTOK * 384; bf16_t* VM = KM + (size_t)NTOK * 384;
    const f32x2* rope = (const f32x2*)(wsl + WS_ROPE);
    const float* gq = p.in[I_GMLA] + l * 192; const float* gk = gq + 96;
    const int lane = c.lane, hd = lane >> 4, sub = lane & 15;
    const float SC = 0.10206207261596575f * LOG2E;
    f32x4 gqn = *(const f32x4*)(gq + 4 * sub), gkn = *(const f32x4*)(gk + 4 * sub);
    const float gq1 = gq[64 + sub], gq2 = gq[80 + sub], gk1 = gk[64 + sub], gk2 = gk[80 + sub];
    u32x2 n_cq, n_ck, n_qn, n_kn, n_vn; unsigned short n_x1, n_x2, n_p1, n_p2; f32x2 n_cs;
#define FIN_LOAD(m_) do { const bf16_t* pr_ = PROJ + (size_t)(m_) * PW; const bf16_t* rw_ = RAW + (size_t)(m_) * 1024; \
        n_cq = *(const u32x2*)(pr_ + PC_CQ + 4 * lane); n_ck = *(const u32x2*)(pr_ + PC_CKV + 4 * lane); n_cs = rope[(size_t)((m_) & (SEQ - 1)) * 16 + sub]; \
        n_qn = *(const u32x2*)(rw_ + hd * 96 + 4 * sub); n_x1 = rw_[hd * 96 + 64 + sub]; n_x2 = rw_[hd * 96 + 80 + sub]; \
        n_kn = *(const u32x2*)(rw_ + 512 + hd * 128 + 4 * sub); n_vn = *(const u32x2*)(rw_ + 512 + hd * 128 + 64 + 4 * sub); n_p1 = pr_[PC_KPE + sub]; n_p2 = pr_[PC_KPE + 16 + sub]; } while (0)
    if (c.gw < NTOK) FIN_LOAD(c.gw);
    for (int m = c.gw; m < NTOK; m += c.NGW) {
        const u32x2 cq = n_cq, ck = n_ck, qn = n_qn, kn = n_kn, vn = n_vn; const f32x2 cs = n_cs;
        const float x1r = bf2f(n_x1), x2r = bf2f(n_x2), p1 = bf2f(n_p1), p2 = bf2f(n_p2);
        if (m + c.NGW < NTOK) FIN_LOAD(m + c.NGW);
        float sq = bflo(cq.x) * bflo(cq.x) + bfhi(cq.x) * bfhi(cq.x) + bflo(cq.y) * bflo(cq.y) + bfhi(cq.y) * bfhi(cq.y);
        float sk = bflo(ck.x) * bflo(ck.x) + bfhi(ck.x) * bfhi(ck.x) + bflo(ck.y) * bflo(ck.y) + bfhi(ck.y) * bfhi(ck.y);
        const float rsq = __builtin_amdgcn_rsqf(wave_sum(sq) * (1.f / 256.f) + EPS), rsk = __builtin_amdgcn_rsqf(wave_sum(sk) * (1.f / 256.f) + EPS);
        float q0 = bflo(qn.x) * rsq, q1 = bfhi(qn.x) * rsq, q2 = bflo(qn.y) * rsq, q3 = bfhi(qn.y) * rsq;
        const float x1 = x1r * rsq, x2 = x2r * rsq;
        const float y1 = x1 * cs.x - x2 * cs.y, y2 = x2 * cs.x + x1 * cs.y;
        float ss = q0 * q0 + q1 * q1 + q2 * q2 + q3 * q3 + y1 * y1 + y2 * y2;
        ss = row16_sum(ss);
        float rr = __builtin_amdgcn_rsqf(ss * (1.f / 96.f) + EPS) * SC;
        bf16_t* qo = QM + (size_t)m * 384 + hd * 96;
        *(u32x2*)(qo + 4 * sub) = (u32x2){pk2(q0 * rr * gqn.x, q1 * rr * gqn.y), pk2(q2 * rr * gqn.z, q3 * rr * gqn.w)};
        qo[64 + sub] = (bf16_t)(pk2(y1 * rr * gq1, 0.f) & 0xffffu); qo[80 + sub] = (bf16_t)(pk2(y2 * rr * gq2, 0.f) & 0xffffu);
        float k0 = bflo(kn.x) * rsk, k1 = bfhi(kn.x) * rsk, k2 = bflo(kn.y) * rsk, k3 = bfhi(kn.y) * rsk;
        const float z1 = p1 * cs.x - p2 * cs.y, z2 = p2 * cs.x + p1 * cs.y;
        float sk2 = k0 * k0 + k1 * k1 + k2 * k2 + k3 * k3 + z1 * z1 + z2 * z2;
        sk2 = row16_sum(sk2);
        const float rk = __builtin_amdgcn_rsqf(sk2 * (1.f / 96.f) + EPS);
        const int bb = m >> 14, pos = m & (SEQ - 1), T = pos >> 6, kk = pos & 63;
        bf16_t* kt = KM + ((size_t)((bb * 4 + hd) * 256 + T)) * (12 * 64 * 8) + kk * 8;
        *(u32x2*)(kt + (sub >> 1) * 512 + 4 * (sub & 1)) = (u32x2){pk2(k0 * rk * gkn.x, k1 * rk * gkn.y), pk2(k2 * rk * gkn.z, k3 * rk * gkn.w)};
        kt[(8 + (sub >> 3)) * 512 + (sub & 7)] = (bf16_t)(pk2(z1 * rk * gk1, 0.f) & 0xffffu); kt[(10 + (sub >> 3)) * 512 + (sub & 7)] = (bf16_t)(pk2(z2 * rk * gk2, 0.f) & 0xffffu);
        bf16_t* vt_ = VM + ((size_t)((bb * 4 + hd) * 256 + T)) * (8 * 16 * 32) + ((sub >> 3) * 4 + (kk >> 4)) * 512 + (kk & 15) * 32 + (4 * sub & 31);
        *(u32x2*)vt_ = (u32x2){pk2(bflo(vn.x) * rsk, bfhi(vn.x) * rsk), pk2(bflo(vn.y) * rsk, bfhi(vn.y) * rsk)};
    }
#undef FIN_LOAD
}

__device__ __forceinline__ s16x4 tr16(const LAS unsigned char* p) { return __builtin_bit_cast(s16x4, __builtin_amdgcn_ds_read_tr16_b64_v4i16((LAS s16x4*)p)); }
__device__ __forceinline__ bf16x8 vfrag(const LAS unsigned char* vt, int VP, int s, int db, int lane) {
    const int hi = lane >> 5, q4 = (lane & 15) >> 2, pp = lane & 3, g1 = (lane >> 4) & 1;
    const LAS unsigned char* a = vt + (16 * s + 8 * hi + q4) * VP + (32 * db + 16 * g1 + 4 * pp) * 2;
    const s16x4 lo = tr16(a), hh = tr16(a + 4 * VP);
    return (bf16x8){lo[0], lo[1], lo[2], lo[3], hh[0], hh[1], hh[2], hh[3]};
}
__device__ __forceinline__ bf16x8 pfrag(const f32x16& pv, int s) {
    u32x4 w; w.x = pk2(pv[8 * s], pv[8 * s + 1]); w.y = pk2(pv[8 * s + 2], pv[8 * s + 3]); w.z = pk2(pv[8 * s + 4], pv[8 * s + 5]); w.w = pk2(pv[8 * s + 6], pv[8 * s + 7]);
    return mk8(w);
}
__device__ __forceinline__ float dot2_ones(unsigned pk, float c) { return __builtin_amdgcn_fdot2_f32_bf16(__builtin_bit_cast(bf16x2_t, pk), __builtin_bit_cast(bf16x2_t, 0x3F803F80u), c, false); }
__device__ __forceinline__ int keyof(int r, int hi) { return 16 * (r >> 3) + 8 * hi + (r & 7); }
__device__ __forceinline__ void store_ot(bf16_t* rowp, const f32x16& o, float sc, int hi) {
#pragma unroll
    for (int g = 0; g < 4; ++g) *(u32x2*)(rowp + 8 * g + 4 * hi) = (u32x2){pk2(o[4 * g] * sc, o[4 * g + 1] * sc), pk2(o[4 * g + 2] * sc, o[4 * g + 3] * sc)};
}

__device__ __forceinline__ void sb_unit(const Params& p, const Ctx& c0, int b, int h, int qt) {
    const Ctx c = launder(c0);
    unsigned char* const wsl = launder_ptr(p.ws);
    const bf16_t* PROJ = (const bf16_t*)(wsl + WS_PROJ); bf16_t* AO = (bf16_t*)(wsl + WS_AO);
    LAS unsigned char* vt = c.lds + LDS_VSCR + c.wid * 4608;
    const int lane = c.lane, r32 = lane & 31, hi = lane >> 5;
    const size_t tb = (size_t)b * SEQ;
    const bf16_t* qp = PROJ + (tb + qt * 32 + r32) * PW + PC_AQ + h * 64 + 8 * hi;
    bf16x8 qr[4];
#pragma unroll
    for (int d0 = 0; d0 < 4; ++d0) qr[d0] = *(const bf16x8*)(qp + 16 * d0);
    f32x16 o0 = (f32x16){}, o1 = (f32x16){};
    float R = 0.f;
    const int prow = pi32(r32);
    bf16x8 kf[4], nkf[4]; u32x4 vr[4], nvr[4];
#define SB_LOAD(KF, VR, kt_) do { const bf16_t* kp_ = PROJ + (tb + (kt_) * 32 + prow) * PW + PC_AK + h * 64 + 8 * hi; \
        _Pragma("unroll") for (int d0 = 0; d0 < 4; ++d0) KF[d0] = *(const bf16x8*)(kp_ + 16 * d0); \
        _Pragma("unroll") for (int i = 0; i < 4; ++i) { const int id = lane + 64 * i; VR[i] = *(const u32x4*)(PROJ + (tb + (kt_) * 32 + (id >> 3)) * PW + PC_AV + h * 64 + (id & 7) * 8); } } while (0)
    SB_LOAD(kf, vr, qt);
    for (int kt = qt; kt >= 0; --kt) {
        if (kt > 0) SB_LOAD(nkf, nvr, kt - 1);
        f32x16 z = (f32x16){};
#pragma unroll
        for (int d0 = 0; d0 < 4; ++d0) z = __builtin_amdgcn_mfma_f32_32x32x16_bf16(kf[d0], qr[d0], z, 0, 0, 0);
#pragma unroll
        for (int i = 0; i < 4; ++i) { const int id = lane + 64 * i; *(LAS u32x4*)(vt + (id >> 3) * 144 + (id & 7) * 16) = vr[i]; }
        f32x16 L; const bool diag = kt == qt;
#pragma unroll
        for (int r = 0; r < 16; ++r) {
            const float zz = z[r];
            float lv = -(fmaxf(zz, 0.f) + lg2(1.f + ex2(-fabsf(zz))));
            if (diag && keyof(r, hi) >= r32) lv = 0.f;
            L[r] = lv;
        }
        float ta = 0.f, tb2 = 0.f;
#pragma unroll
        for (int r = 0; r < 8; ++r) { ta += L[r]; tb2 += L[8 + r]; }
        const float pa = x32_other(ta, hi), pb = x32_other(tb2, hi);
        const float afterA = hi ? (pb + tb2) : (pa + tb2 + pb);
        const float afterB = hi ? 0.f : pb;
        f32x16 a;
        {
            float run = R + afterA;
#pragma unroll
            for (int r = 7; r >= 0; --r) { a[r] = ex2(z[r] + L[r] + run); run += L[r]; }
            run = R + afterB;
#pragma unroll
            for (int r = 15; r >= 8; --r) { a[r] = ex2(z[r] + L[r] + run); run += L[r]; }
        }
        if (diag) {
#pragma unroll
            for (int r = 0; r < 16; ++r) if (keyof(r, hi) >= r32) a[r] = 0.f;
        }
        R += (ta + pa) + (tb2 + pb);
#pragma unroll
        for (int s = 0; s < 2; ++s) {
            const bf16x8 pf = pfrag(a, s);
            o0 = __builtin_amdgcn_mfma_f32_32x32x16_bf16(vfrag(vt, 144, s, 0, lane), pf, o0, 0, 0, 0);
            o1 = __builtin_amdgcn_mfma_f32_32x32x16_bf16(vfrag(vt, 144, s, 1, lane), pf, o1, 0, 0, 0);
        }
        if (__all(R < -160.f)) break;
#pragma unroll
        for (int i = 0; i < 4; ++i) { kf[i] = nkf[i]; vr[i] = nvr[i]; }
    }
#undef SB_LOAD
    bf16_t* op = AO + (tb + qt * 32 + r32) * AOW + h * 64;
    store_ot(op, o0, 1.f, hi); store_ot(op + 32, o1, 1.f, hi);
}

__device__ __forceinline__ void local_attn(const bf16_t* PROJ, LAS unsigned char* vt, const LAS float* btab, int qcol, int kcol, int vcol,
                                           size_t tb, int dil, int rr, int m0, int W, int lane, f32x16& o, float& m, float& lsum) {
    const int r32 = lane & 31, hi = lane >> 5, prow = pi32(r32);
    const bf16_t* qp = PROJ + (tb + (size_t)(m0 + r32) * dil + rr) * PW + qcol + 8 * hi;
    const bf16x8 q0 = *(const bf16x8*)qp, q1 = *(const bf16x8*)(qp + 16);
    bf16x8 kf[5][2]; u32x4 vr[5][2];
#pragma unroll
    for (int ti = 0; ti < 5; ++ti) {
        const int k0 = m0 - 128 + 32 * ti;
        if (k0 >= 0) {
            const bf16_t* kp = PROJ + (tb + (size_t)(k0 + prow) * dil + rr) * PW + kcol + 8 * hi;
            kf[ti][0] = *(const bf16x8*)kp; kf[ti][1] = *(const bf16x8*)(kp + 16);
#pragma unroll
            for (int i = 0; i < 2; ++i) { const int id = lane + 64 * i; vr[ti][i] = *(const u32x4*)(PROJ + (tb + (size_t)(k0 + (id >> 2)) * dil + rr) * PW + vcol + (id & 3) * 8); }
        } else { kf[ti][0] = kf[ti][1] = (bf16x8){}; vr[ti][0] = vr[ti][1] = (u32x4){0u, 0u, 0u, 0u}; }
    }
    o = (f32x16){}; m = -1e30f; lsum = 0.f;
#pragma unroll
    for (int ti = 0; ti < 5; ++ti) {
        const int dl = 128 - 32 * ti, k0 = m0 - dl;
        if (k0 < 0) continue;
        f32x16 s = (f32x16){};
        s = __builtin_amdgcn_mfma_f32_32x32x16_bf16(kf[ti][0], q0, s, 0, 0, 0);
        s = __builtin_amdgcn_mfma_f32_32x32x16_bf16(kf[ti][1], q1, s, 0, 0, 0);
#pragma unroll
        for (int i = 0; i < 2; ++i) { const int id = lane + 64 * i; *(LAS u32x4*)(vt + (id >> 2) * 80 + (id & 3) * 16) = vr[ti][i]; }
        float mx = -INFINITY;
#pragma unroll
        for (int r = 0; r < 16; ++r) {
            const int dist = dl + r32 - keyof(r, hi);
            const int di = dist < 0 ? 0 : (dist > 131 ? 131 : dist);
            float v = s[r] + btab[di];
            if (dl == 0) { if (dist < 0) v = -INFINITY; }
            if (dl == 128) { if (dist > W) v = -INFINITY; }
            s[r] = v; mx = fmaxf(mx, v);
        }
        mx = x32_max(mx);
        const float mn = fmaxf(m, mx), f = ex2(m - mn);
        m = mn;
        float ps = 0.f;
#pragma unroll
        for (int r = 0; r < 16; ++r) { s[r] = ex2(s[r] - mn); ps += s[r]; }
        lsum = lsum * f + ps;
#pragma unroll
        for (int r = 0; r < 16; ++r) o[r] *= f;
#pragma unroll
        for (int st = 0; st < 2; ++st) o = __builtin_amdgcn_mfma_f32_32x32x16_bf16(vfrag(vt, 80, st, 0, lane), pfrag(s, st), o, 0, 0, 0);
    }
}

__device__ __forceinline__ void sw_unit(const Params& p, const Ctx& c0, int l, int b, int hq, int qt) {
    const Ctx c = launder(c0);
    unsigned char* const wsl = launder_ptr(p.ws);
    const bf16_t* PROJ = (const bf16_t*)(wsl + WS_PROJ); bf16_t* AO = (bf16_t*)(wsl + WS_AO);
    LAS unsigned char* vt = c.lds + LDS_VSCR + c.wid * 4608;
    const LAS float* btab = (const LAS float*)(c.lds + LDS_BTAB) + hq * 132;
    const int lane = c.lane, r32 = lane & 31, hi = lane >> 5, kv = hq >> 2;
    f32x16 o; float m, ls;
    local_attn(PROJ, vt, btab, PC_SWQ + hq * 32, PC_SWK + kv * 32, PC_SWV + kv * 32, (size_t)b * SEQ, 1, 0, qt * 32, 127, lane, o, m, ls);
    ls = x32_add(ls);
    const float sk = p.in[I_SINKS][l * 8 + hq] * LOG2E;
    const float mf = fmaxf(m, sk), f = ex2(m - mf);
    const float den = ls * f + ex2(sk - mf);
    store_ot(AO + ((size_t)b * SEQ + qt * 32 + r32) * AOW + 512 + hq * 32, o, f * rcpf(den), hi);
}

__device__ __forceinline__ void dil_unit(const Params& p, const Ctx& c0, int b, int tblk, int h) {
    const Ctx c = launder(c0);
    unsigned char* const wsl = launder_ptr(p.ws);
    const bf16_t* PROJ = (const bf16_t*)(wsl + WS_PROJ); bf16_t* AO = (bf16_t*)(wsl + WS_AO);
    LAS unsigned char* vt = c.lds + LDS_VSCR + c.wid * 4608;
    LAS bf16_t* obuf = (LAS bf16_t*)(c.lds + LDS_DOBUF); LAS float* lse = (LAS float*)(c.lds + LDS_DLSE);
    const int lane = c.lane, r32 = lane & 31, hi = lane >> 5;
    const int T0 = tblk * 512;
#pragma unroll 1
    for (int g = 0; g < 3; ++g) {
        const int dil = g == 0 ? 1 : (g == 1 ? 4 : 16), sh = g == 0 ? 0 : (g == 1 ? 2 : 4);
        const LAS float* btab = (const LAS float*)(c.lds + LDS_BTAB) + (8 + 4 * g + h) * 132;
#pragma unroll 1
        for (int jj = 0; jj < 2; ++jj) {
            const int j = 2 * c.wid + jj;
            const int ntr = 16 >> sh;
            const int rr = j / ntr, sub = j % ntr;
            const int m0 = (T0 >> sh) + 32 * sub;
            f32x16 o; float m, ls;
            local_attn(PROJ, vt, btab, PC_DQ + g * 128 + h * 32, PC_DK + g * 128 + h * 32, PC_DV + g * 128 + h * 32, (size_t)b * SEQ + (size_t)rr * (SEQ >> sh), 1, 0, m0, 128, lane, o, m, ls);
            ls = x32_add(ls);
            const float inv = rcpf(ls);
            const int tl = ((m0 + r32) << sh) + rr - T0;
            LAS bf16_t* ob = obuf + (tl * 3 + g) * 32;
#pragma unroll
            for (int q = 0; q < 4; ++q) *(LAS u32x2*)(ob + 8 * q + 4 * hi) = (u32x2){pk2(o[4 * q] * inv, o[4 * q + 1] * inv), pk2(o[4 * q + 2] * inv, o[4 * q + 3] * inv)};
            if (hi == 0) lse[tl * 3 + g] = m + lg2(ls);
        }
    }
    __syncthreads();
    {
        const int tl = c.tid;
        const float l0 = lse[tl * 3], l1 = lse[tl * 3 + 1], l2 = lse[tl * 3 + 2];
        const float mx = fmaxf(l0, fmaxf(l1, l2));
        float w0 = ex2(l0 - mx), w1 = ex2(l1 - mx), w2 = ex2(l2 - mx); const float iv = rcpf(w0 + w1 + w2); w0 *= iv; w1 *= iv; w2 *= iv;
        const LAS u32x4* ob = (const LAS u32x4*)(obuf + tl * 96);
        u32x4* dst = (u32x4*)(AO + ((size_t)b * SEQ + T0 + tl) * AOW + 768 + h * 32);
#pragma unroll
        for (int q = 0; q < 4; ++q) {
            const u32x4 a = ob[q], bq = ob[4 + q], cq = ob[8 + q];
            u32x4 r;
            r.x = pk2(w0 * bflo(a.x) + w1 * bflo(bq.x) + w2 * bflo(cq.x), w0 * bfhi(a.x) + w1 * bfhi(bq.x) + w2 * bfhi(cq.x));
            r.y = pk2(w0 * bflo(a.y) + w1 * bflo(bq.y) + w2 * bflo(cq.y), w0 * bfhi(a.y) + w1 * bfhi(bq.y) + w2 * bfhi(cq.y));
            r.z = pk2(w0 * bflo(a.z) + w1 * bflo(bq.z) + w2 * bflo(cq.z), w0 * bfhi(a.z) + w1 * bfhi(bq.z) + w2 * bfhi(cq.z));
            r.w = pk2(w0 * bflo(a.w) + w1 * bflo(bq.w) + w2 * bflo(cq.w), w0 * bfhi(a.w) + w1 * bfhi(bq.w) + w2 * bfhi(cq.w));
            dst[q] = r;
        }
    }
    __syncthreads();
}

#ifndef MLA_BIG
#define MLA_BIG 1.0995116e12f
#endif
constexpr int MK_SLOT = 12288, MV_SLOT = 8192, MLA_VOFF = 5 * MK_SLOT;
__device__ __forceinline__ void mla_qk(const LAS unsigned char* ks, const bf16x8 (&qr)[6], const f32x16& negm, int prow, int hi, f32x16& s0, f32x16& s1) {
    bf16x8 kf[12];
    const LAS unsigned char* kp = ks + hi * 1024 + prow * 16;
#pragma unroll
    for (int d0 = 0; d0 < 6; ++d0) { kf[2 * d0] = *(const LAS bf16x8*)(kp + d0 * 2048); kf[2 * d0 + 1] = *(const LAS bf16x8*)(kp + d0 * 2048 + 512); }
    __builtin_amdgcn_sched_barrier(0);
    s0 = __builtin_amdgcn_mfma_f32_32x32x16_bf16(kf[0], qr[0], negm, 0, 0, 0);
    s1 = __builtin_amdgcn_mfma_f32_32x32x16_bf16(kf[1], qr[0], negm, 0, 0, 0);
#pragma unroll
    for (int d0 = 1; d0 < 6; ++d0) {
        s0 = __builtin_amdgcn_mfma_f32_32x32x16_bf16(kf[2 * d0], qr[d0], s0, 0, 0, 0);
        s1 = __builtin_amdgcn_mfma_f32_32x32x16_bf16(kf[2 * d0 + 1], qr[d0], s1, 0, 0, 0);
    }
    __builtin_amdgcn_sched_barrier(0);
}
__device__ __forceinline__ bf16x8 mla_vfrag(const LAS unsigned char* vs, int s, int db, int lane) {
    const int hi = lane >> 5, q4 = (lane & 15) >> 2, pp = lane & 3, g1 = (lane >> 4) & 1;
    const LAS unsigned char* a = vs + (db * 4 + s) * 1024 + (8 * hi + q4) * 64 + (16 * g1 + 4 * pp) * 2;
    const s16x4 lo = tr16(a), hh = tr16(a + 256);
    return (bf16x8){lo[0], lo[1], lo[2], lo[3], hh[0], hh[1], hh[2], hh[3]};
}
__device__ __forceinline__ float max3f(float a, float b, float c) { return fmaxf(fmaxf(a, b), c); }
__device__ __forceinline__ float rowmax32(const f32x16& a, const f32x16& b) {
    float x = max3f(a[0], a[1], a[2]), y = max3f(b[0], b[1], b[2]);
    x = max3f(x, a[3], a[4]); y = max3f(y, b[3], b[4]); x = max3f(x, a[5], a[6]); y = max3f(y, b[5], b[6]);
    x = max3f(x, a[7], a[8]); y = max3f(y, b[7], b[8]); x = max3f(x, a[9], a[10]); y = max3f(y, b[9], b[10]);
    x = max3f(x, a[11], a[12]); y = max3f(y, b[11], b[12]); x = max3f(x, a[13], a[14]); y = max3f(y, b[13], b[14]);
    return max3f(x, y, fmaxf(a[15], b[15]));
}
__device__ __forceinline__ void mla_unit(const Params& p, const Ctx& c0, int b, int h, int qb) {
    const Ctx c = launder(c0);
    unsigned char* const wsl = launder_ptr(p.ws);
    const bf16_t* QM = (const bf16_t*)(wsl + WS_Y);
    bf16_t* AO = (bf16_t*)(wsl + WS_AO);
    LAS unsigned char* buf = c.lds + LDS_MLA;
    const int lane = c.lane, wid = c.wid, r32 = lane & 31, hi = lane >> 5, prow = pi32(r32);
    const size_t tb = (size_t)b * SEQ; const int q0 = qb * 256, qw0 = q0 + wid * 32;
    const bf16_t* qp = QM + (tb + qw0 + r32) * 384 + h * 96 + 8 * hi;
    bf16x8 qr[6];
#pragma unroll
    for (int d0 = 0; d0 < 6; ++d0) qr[d0] = *(const bf16x8*)(qp + 16 * d0);
    const int NT = (q0 + 256) / 64;
    const __amdgpu_buffer_rsrc_t rs = __builtin_amdgcn_make_buffer_rsrc((void*)wsl, (short)0, 0x7fffffff, 0x00020000);
    const unsigned ldsb = (unsigned)(__SIZE_TYPE__)buf;
    const unsigned kvo = (unsigned)lane * 16u;
    const unsigned kso = (unsigned)(WS_Y + (size_t)NTOK * 384 * 2) + (unsigned)(((size_t)(b * 4 + h) * 256) * (12 * 1024)), vso = (unsigned)(WS_Y + (size_t)NTOK * 768 * 2) + (unsigned)(((size_t)(b * 4 + h) * 256) * (8 * 1024));
#define MLA_DMA_K(t) do { if (wid < 4) { const unsigned m0_ = ldsb + (unsigned)((t) % 5) * MK_SLOT + (unsigned)wid * 1024u, so_ = kso + (unsigned)(t) * 12288u + (unsigned)wid * 1024u; \
        DMA16(m0_, kvo, rs, so_); DMA16(m0_ + 4096u, kvo, rs, so_ + 4096u); DMA16(m0_ + 8192u, kvo, rs, so_ + 8192u); } } while (0)
#define MLA_DMA_V(t) do { if (wid < 4) { const unsigned m0_ = ldsb + MLA_VOFF + (unsigned)((t) & 3) * MV_SLOT + (unsigned)wid * 1024u, so_ = vso + (unsigned)(t) * 8192u + (unsigned)wid * 1024u; \
        DMA16(m0_, kvo, rs, so_); DMA16(m0_ + 4096u, kvo, rs, so_ + 4096u); } } while (0)
#define MLA_SYNC() asm volatile("s_waitcnt vmcnt(0)\n\ts_barrier" ::: "memory")
    MLA_DMA_K(0); MLA_DMA_V(0); MLA_DMA_K(1); MLA_DMA_V(1); MLA_DMA_K(2); MLA_DMA_K(3);
    MLA_SYNC();
    f32x16 o0 = (f32x16){}, o1 = (f32x16){}, sA0, sA1, sB0, sB1, negm = (f32x16){};
    unsigned pkA[16], pkB[16];
    float m, ls = 0.f;
    {
        mla_qk(buf, qr, negm, prow, hi, sA0, sA1);
        if (qw0 < 63) {
            const int q8 = qw0 + r32 - 8 * hi;
#pragma unroll
            for (int r = 0; r < 16; ++r) { if (16 * (r >> 3) + (r & 7) > q8) sA0[r] = -INFINITY; if (32 + 16 * (r >> 3) + (r & 7) > q8) sA1[r] = -INFINITY; }
        }
        float mx = rowmax32(sA0, sA1);
        mx = x32_max(mx);
        m = mx;
#pragma unroll
        for (int r = 0; r < 16; ++r) { sA0[r] -= m; sA1[r] -= m; negm[r] = -m; }
    }
#define MLA_PV_HALF(PKP, vs_, sh) do { \
          const bf16x8 pa_ = mk8((u32x4){PKP[8 * (sh)], PKP[8 * (sh) + 1], PKP[8 * (sh) + 2], PKP[8 * (sh) + 3]}), pb_ = mk8((u32x4){PKP[8 * (sh) + 4], PKP[8 * (sh) + 5], PKP[8 * (sh) + 6], PKP[8 * (sh) + 7]}); \
          o0 = __builtin_amdgcn_mfma_f32_32x32x16_bf16(vf_[0], pa_, o0, 0, 0, 0); o1 = __builtin_amdgcn_mfma_f32_32x32x16_bf16(vf_[1], pa_, o1, 0, 0, 0); \
          o0 = __builtin_amdgcn_mfma_f32_32x32x16_bf16(vf_[2], pb_, o0, 0, 0, 0); o1 = __builtin_amdgcn_mfma_f32_32x32x16_bf16(vf_[3], pb_, o1, 0, 0, 0); } while (0)
#define MLA_VLOAD(vs_, sh) do { vf_[0] = mla_vfrag(vs_, 2 * (sh), 0, lane); vf_[1] = mla_vfrag(vs_, 2 * (sh), 1, lane); vf_[2] = mla_vfrag(vs_, 2 * (sh) + 1, 0, lane); vf_[3] = mla_vfrag(vs_, 2 * (sh) + 1, 1, lane); } while (0)
#define MLA_STEP(C0, C1, N0, N1, PKP, PKC, t, PVON) do { \
        const bool deep_ = (t) + 4 < NT; \
        if (64 * ((t) - 1) <= qw0 + 31) {            \
        if ((t) > 0 && 64 * (t) + 63 > qw0) { const int q8_ = qw0 + r32 - 64 * (t) - 8 * hi; \
            _Pragma("unroll") for (int r = 0; r < 16; ++r) { if (16 * (r >> 3) + (r & 7) > q8_) C0[r] = -INFINITY; if (32 + 16 * (r >> 3) + (r & 7) > q8_) C1[r] = -INFINITY; } } \
        float ps_ = 0.f, pt_ = 0.f; \
        { const LAS unsigned char* kp_ = buf + (((t) + 1) % 5) * MK_SLOT + hi * 1024 + prow * 16; \
          const LAS unsigned char* vs_ = buf + MLA_VOFF + (((t) + 3) & 3) * MV_SLOT;        \
          bf16x8 kf_[6], vf_[4]; \
          _Pragma("unroll") for (int d0 = 0; d0 < 3; ++d0) { kf_[2 * d0] = *(const LAS bf16x8*)(kp_ + d0 * 2048); kf_[2 * d0 + 1] = *(const LAS bf16x8*)(kp_ + d0 * 2048 + 512); } \
          if (PVON) MLA_VLOAD(vs_, 0); \
          __builtin_amdgcn_sched_barrier(0); \
          N0 = __builtin_amdgcn_mfma_f32_32x32x16_bf16(kf_[0], qr[0], negm, 0, 0, 0); \
          N1 = __builtin_amdgcn_mfma_f32_32x32x16_bf16(kf_[1], qr[0], negm, 0, 0, 0); \
          _Pragma("unroll") for (int d0 = 1; d0 < 3; ++d0) { \
              N0 = __builtin_amdgcn_mfma_f32_32x32x16_bf16(kf_[2 * d0], qr[d0], N0, 0, 0, 0); \
              N1 = __builtin_amdgcn_mfma_f32_32x32x16_bf16(kf_[2 * d0 + 1], qr[d0], N1, 0, 0, 0); } \
          if (PVON) MLA_PV_HALF(PKP, vs_, 0); \
          _Pragma("unroll") for (int r = 0; r < 8; ++r) { PKC[r] = pk2(ex2(C0[2 * r]), ex2(C0[2 * r + 1])); ps_ = dot2_ones(PKC[r], ps_); } \
          _Pragma("unroll") for (int g_ = 0; g_ < (PVON ? 10 : 6); ++g_) { __builtin_amdgcn_sched_group_barrier(0x008, 1, 0); __builtin_amdgcn_sched_group_barrier(0x002, (PVON ? 3 : 4), 0); } \
          __builtin_amdgcn_sched_barrier(0); \
          _Pragma("unroll") for (int d0 = 3; d0 < 6; ++d0) { kf_[2 * d0 - 6] = *(const LAS bf16x8*)(kp_ + d0 * 2048); kf_[2 * d0 - 5] = *(const LAS bf16x8*)(kp_ + d0 * 2048 + 512); } \
          if (PVON) MLA_VLOAD(vs_, 1); \
          __builtin_amdgcn_sched_barrier(0); \
          _Pragma("unroll") for (int d0 = 3; d0 < 6; ++d0) { \
              N0 = __builtin_amdgcn_mfma_f32_32x32x16_bf16(kf_[2 * d0 - 6], qr[d0], N0, 0, 0, 0); \
              N1 = __builtin_amdgcn_mfma_f32_32x32x16_bf16(kf_[2 * d0 - 5], qr[d0], N1, 0, 0, 0); } \
          if (PVON) MLA_PV_HALF(PKP, vs_, 1); \
          _Pragma("unroll") for (int r = 0; r < 8; ++r) { PKC[8 + r] = pk2(ex2(C1[2 * r]), ex2(C1[2 * r + 1])); pt_ = dot2_ones(PKC[8 + r], pt_); } \
          _Pragma("unroll") for (int g_ = 0; g_ < (PVON ? 10 : 6); ++g_) { __builtin_amdgcn_sched_group_barrier(0x008, 1, 0); __builtin_amdgcn_sched_group_barrier(0x002, (PVON ? 3 : 4), 0); } \
          __builtin_amdgcn_sched_barrier(0); } \
          \
        if (__any(!(ps_ + pt_ < MLA_BIG))) { \
            mla_qk(buf + ((t) % 5) * MK_SLOT, qr, negm, prow, hi, C0, C1); \
            if (64 * (t) + 63 > qw0) { const int q8_ = qw0 + r32 - 64 * (t) - 8 * hi; \
                _Pragma("unroll") for (int r = 0; r < 16; ++r) { if (16 * (r >> 3) + (r & 7) > q8_) C0[r] = -INFINITY; if (32 + 16 * (r >> 3) + (r & 7) > q8_) C1[r] = -INFINITY; } } \
            float mx_ = rowmax32(C0, C1); \
            mx_ = x32_max(mx_); \
            const float d_ = fmaxf(mx_, 0.f), f_ = ex2(-d_); m += d_; ls *= f_; \
            ps_ = 0.f; pt_ = 0.f; \
            _Pragma("unroll") for (int r = 0; r < 16; ++r) { o0[r] *= f_; o1[r] *= f_; negm[r] = -m; N0[r] -= d_; N1[r] -= d_; } \
            _Pragma("unroll") for (int r = 0; r < 8; ++r) { PKC[r] = pk2(ex2(C0[2 * r] - d_), ex2(C0[2 * r + 1] - d_)); PKC[8 + r] = pk2(ex2(C1[2 * r] - d_), ex2(C1[2 * r + 1] - d_)); ps_ = dot2_ones(PKC[r], ps_); pt_ = dot2_ones(PKC[8 + r], pt_); } \
        } \
        ls += ps_ + pt_; \
        } \
          \
        if (deep_) { MLA_DMA_K((t) + 4); MLA_DMA_V((t) + 2); } else if ((t) + 2 < NT) MLA_DMA_V((t) + 2); \
        if (deep_) asm volatile("s_waitcnt vmcnt(10)\n\ts_barrier" ::: "memory"); \
        else MLA_SYNC(); \
    } while (0)
    MLA_STEP(sA0, sA1, sB0, sB1, pkB, pkA, 0, false);
#pragma unroll 1
    for (int t = 1; t < NT; t += 2) {
        MLA_STEP(sB0, sB1, sA0, sA1, pkA, pkB, t, true);
        MLA_STEP(sA0, sA1, sB0, sB1, pkB, pkA, t + 1, true);
    }
    ls = x32_add(ls);
    const float inv = rcpf(ls);
    bf16_t* op = AO + (tb + qw0 + r32) * AOW + 256 + h * 64;
    store_ot(op, o0, inv, hi); store_ot(op + 32, o1, inv, hi);
#undef MLA_STEP
#undef MLA_VLOAD
#undef MLA_PV_HALF
#undef MLA_DMA_K
#undef MLA_DMA_V
#undef MLA_SYNC
}

__device__ __forceinline__ void attention_phase(const Params& p, const Ctx& c0, int l) {
    const Ctx c = launder(c0);
    unsigned char* const wsl = launder_ptr(p.ws);
    { const float* bt = (const float*)(wsl + WS_TAB); LAS float* lb = (LAS float*)(c.lds + LDS_BTAB); for (int i = c.tid; i < 20 * 132; i += NWG_THREADS) lb[i] = bt[i]; }
    __syncthreads();
    for (int rep = 0; rep < REPS(16); ++rep) for (int u = c.gw; u < 4096; u += c.NGW) { const int qt = u & 511, h = (u >> 9) & 3, b = u >> 11; sb_unit(p, c, b, h, qt); }
    for (int rep = 0; rep < REPS(16); ++rep) for (int u = c.gw; u < 8192; u += c.NGW) { const int qt = u & 511, hq = (u >> 9) & 7, b = u >> 12; sw_unit(p, c, l, b, hq, qt); }
    for (int rep = 0; rep < REPS(18); ++rep) for (int u = c.vcu; u < 256; u += c.G) { const int h = u & 3, tblk = (u >> 2) & 31, b = u >> 7; dil_unit(p, c, b, tblk, h); }
    for (int rep = 0; rep < REPS(19); ++rep) for (int v = c.vcu; v < 256; v += c.G) {
        const int bh = v >> 5, s = v & 31;
#pragma unroll 1
        for (int i = 0; i < 2; ++i) mla_unit(p, c, bh >> 2, bh & 3, i ? s : 63 - s);
    }
}

__global__ void __launch_bounds__(NWG_THREADS, 2) fwd_kernel(Params p) {
    extern __shared__ __attribute__((aligned(16))) unsigned char lds_raw[];
    Ctx c;
    c.lds = (LAS unsigned char*)lds_raw;
    c.tid = threadIdx.x; c.lane = c.tid & 63; c.wid = __builtin_amdgcn_readfirstlane(c.tid >> 6);
    c.G = gridDim.x; { const int bx = blockIdx.x; c.vcu = (c.G % 8 == 0) ? (bx % 8) * (c.G / 8) + bx / 8 : bx; }
    c.gw = blockIdx.x * 8 + c.wid; c.NGW = c.G * 8;
    volatile LAS unsigned* lctl = (volatile LAS unsigned*)(c.lds + LDS_CTL);
    if (c.tid < 64) lctl[c.tid] = 0u;
    __syncthreads();
    unsigned* ctl = (unsigned*)(p.ws + WS_CTL);
    XcdBarrier bar = xcd_barrier_post(ctl + CW_BAR, lctl + 8);
    bar.x = (unsigned)__builtin_amdgcn_readfirstlane((int)bar.x);
    const int bx = blockIdx.x;

    for (int rep = 0; rep < REPS(0); ++rep) prologue(p, c);
#pragma unroll 1
    for (int l = 0; l < 2; ++l) {
        unsigned char* ws = launder_ptr(p.ws);
        bf16_t* H = (bf16_t*)(ws + WS_H); bf16_t* PROJ = (bf16_t*)(ws + WS_PROJ); bf16_t* Y = (bf16_t*)(ws + WS_Y);
        bf16_t* const RS = (bf16_t*)p.out;
        const void* xin = l == 0 ? (const void*)p.in[I_X] : (const void*)RS;
        for (int rep = 0; rep < REPS(1); ++rep) rmsnorm_phase<false>(p, c, xin, l == 0, p.in[I_N1G] + l * DM, H, nullptr, nullptr);
        xcd_barrier(bar);
        if (PH(2)) for (int rep = 0; rep < REPS(2); ++rep) {
            if (rep) xcd_barrier(bar);
            pg8::SchedPlain S{(const char*)(ws + WS_WIN) + (size_t)l * PW * 1024 * 2, DM * 2, 1024 * 2, 128, 12, c.G, bx};
            pg8::EpiInProj E{PROJ, (const float*)(ws + WS_TAB) + 20 * 132 + l * 128};
            pg8::gemm_phase<pg8::EpiInProj, pg8::SchedPlain, true>(c, (const char*)H, 1024, S, E);
        }
        xcd_barrier(bar);
        for (int rep = 0; rep < REPS(3); ++rep) {
#pragma unroll 1
            for (int q = 0; q < 2; ++q) {
                pg8::SchedPlain S{(const char*)(ws + (q ? WS_WKV : WS_WQ)) + (size_t)l * 512 * 256 * 2, PW * 2, 256 * 2, 128, 2, c.G, bx};
                pg8::EpiBf16 E{H, 1024, q * 512};
                pg8::gemm_phase<pg8::EpiBf16, pg8::SchedPlain, true>(c, (const char*)(PROJ + (q ? PC_CKV : PC_CQ)), 256, S, E);
            }
        }
        xcd_barrier(bar);
        for (int rep = 0; rep < REPS(4); ++rep) mla_finalize(p, c, l);
        xcd_barrier(bar);
        if (PH(5)) for (int rep = 0; rep < REPS(5); ++rep) { if (rep) xcd_barrier(bar); attention_phase(p, c, l); }
        xcd_barrier(bar);
        if (PH(6)) for (int rep = 0; rep < REPS(6); ++rep) { if (rep) xcd_barrier(bar); merge_phase(p, c, l); }
        xcd_barrier(bar);
        if (PH(7)) {
            pg8::SchedPlain S{(const char*)(ws + WS_WOUT) + (size_t)l * 1024 * 1024 * 2, DM * 2, 1024 * 2, 128, 4, c.G, bx};
            pg8::EpiResid E{xin, l == 0, RS};
            pg8::gemm_phase<pg8::EpiResid, pg8::SchedPlain, true>(c, (const char*)Y, 1024, S, E);
        }
        xcd_barrier(bar);
        if (l == 0) {
            if (PH(8)) rmsnorm_phase<false>(p, c, RS, 0, p.in[I_N2G], H, nullptr, nullptr);
            xcd_barrier(bar);
            if (PH(9)) for (int rep = 0; rep < REPS(9); ++rep) {
                if (rep) xcd_barrier(bar);
                pg8::SchedPlain S{(const char*)(ws + WS_WGUD), DM * 2, 1024 * 2, 128, 16, c.G, bx};
                pg8::EpiSwiglu E{PROJ, 2048};
                pg8::gemm_phase<pg8::EpiSwiglu, pg8::SchedPlain, true>(c, (const char*)H, 1024, S, E);
            }
            xcd_barrier(bar);
            if (PH(10)) {
                pg8::SchedPlain S{(const char*)(ws + WS_WDD), 2048 * 2, 2048 * 2, 128, 4, c.G, bx};
                pg8::EpiResid E{RS, 0, RS};
                pg8::gemm_phase<pg8::EpiResid, pg8::SchedPlain, true>(c, (const char*)PROJ, 2048, S, E);
            }
            xcd_barrier(bar);
        } else {
            if (PH(11)) rmsnorm_phase<true>(p, c, RS, 0, p.in[I_N2G] + DM, H, p.in[I_WR], p.in[I_BR]);
            xcd_barrier(bar);
            pg8::MoeInfo mi; mi.load((const unsigned*)(ws + WS_CTL));
            if (PH(12)) {
                const int U = mi.ts[16] * 6, T0 = __builtin_amdgcn_readfirstlane(U % c.G), hv = (T0 > 0 && 2 * T0 <= c.G) ? 1 : 0, Uf = hv ? U - T0 : U;
                pg8::EpiSwigluMoe E{mi, PROJ, (const float*)(ws + WS_MW)};
                if (Uf > 0) {
                    pg8::SchedMoeUp S{mi, (const char*)(ws + WS_WGUE), (const int*)(ws + WS_MTOK), 2048, c.G, bx, 0, Uf, 0};
                    pg8::gemm_phase<pg8::EpiSwigluMoe, pg8::SchedMoeUp, true>(c, (const char*)H, 1024, S, E);
                }
                if (hv) {
                    pg8::SchedMoeUp S{mi, (const char*)(ws + WS_WGUE), (const int*)(ws + WS_MTOK), 2048, c.G, bx, Uf, T0, 1};
                    pg8::gemm_phase<pg8::EpiSwigluMoe, pg8::SchedMoeUp, true, 1>(c, (const char*)H, 1024, S, E);
                }
            }
            xcd_barrier(bar);
#pragma unroll 1
            for (int k = 0; k < 2; ++k) {
                if (k) xcd_barrier(bar);
                const int r0 = k ? mi.ts[8] : mi.ts[0], nMk = (k ? mi.ts[16] : mi.ts[8]) - r0, U = nMk * 4;
                const int T0 = __builtin_amdgcn_readfirstlane(U % c.G), nsub = T0 == 0 ? 1 : (4 * T0 <= c.G ? 4 : (2 * T0 <= c.G ? 2 : 1)), Uf = nsub == 1 ? U : U - T0;
                pg8::EpiMoeDown E{mi, k ? (const bf16_t*)H : (const bf16_t*)RS, k ? (void*)p.out : (void*)H, k, (const int*)(ws + WS_MTOK)};
                if (Uf > 0) {
                    pg8::SchedMoeDown S{mi, (const char*)(ws + WS_WDE), 1536, r0, nMk, c.G, bx, 0, Uf, 0};
                    pg8::gemm_phase<pg8::EpiMoeDown, pg8::SchedMoeDown, true>(c, (const char*)PROJ, 768, S, E);
                }
                if (nsub == 4) {
                    pg8::SchedMoeDown S{mi, (const char*)(ws + WS_WDE), 1536, r0, nMk, c.G, bx, Uf, T0, 2};
                    pg8::gemm_phase<pg8::EpiMoeDown, pg8::SchedMoeDown, true, 2>(c, (const char*)PROJ, 768, S, E);
                } else if (nsub == 2) {
                    pg8::SchedMoeDown S{mi, (const char*)(ws + WS_WDE), 1536, r0, nMk, c.G, bx, Uf, T0, 1};
                    pg8::gemm_phase<pg8::EpiMoeDown, pg8::SchedMoeDown, true, 1>(c, (const char*)PROJ, 768, S, E);
                }
            }
        }
    }
}

extern "C" void kernel_launch(void* const* d_in, const int* in_sizes, int n_in, void* d_out, int out_size, void* d_ws, size_t ws_size, hipStream_t stream) {
    static int grid = 0;
    if (grid == 0) {
        if (n_in != 24 || ws_size < WS_END) { fprintf(stderr, "kernel_launch: unexpected inputs (n_in %d, ws %zu)\n", n_in, ws_size); grid = -1; return; }
        int dev = 0, cus = 0, per_cu = 0;
        hipGetDevice(&dev); hipDeviceGetAttribute(&cus, hipDeviceAttributeMultiprocessorCount, dev);
        hipFuncSetAttribute((const void*)fwd_kernel, hipFuncAttributeMaxDynamicSharedMemorySize, LDS_BYTES);
        hipOccupancyMaxActiveBlocksPerMultiprocessor(&per_cu, (const void*)fwd_kernel, NWG_THREADS, LDS_BYTES);
        (void)hipGetLastError();
        grid = cus;
    }
    if (grid < 0) return;
    hipMemsetAsync((char*)d_ws + WS_CTL, 0, CTL_BYTES, stream);
    Params p{};
    for (int i = 0; i < 24; ++i) p.in[i] = (const float*)d_in[i];
    p.out = (float*)d_out; p.ws = (unsigned char*)d_ws;
    hipLaunchKernelGGL(fwd_kernel, dim3(grid), dim3(NWG_THREADS), LDS_BYTES, stream, p);
}
```

```cpp
#include <hip/hip_runtime.h>
#include <stdint.h>
#include <stdio.h>

#define LAS __attribute__((address_space(3)))
#ifndef PROBE_REP
#define PROBE_REP -1
#endif
#define REPS(n) ((PROBE_REP == (n)) ? 2 : 1)
#ifndef PHM
#define PHM 0xFFFFFFFFu
#endif
#define PH(n) ((PHM >> (n)) & 1u)
typedef unsigned short bf16_t;
typedef short bf16x8 __attribute__((ext_vector_type(8)));
typedef short s16x4 __attribute__((ext_vector_type(4)));
typedef float f32x2 __attribute__((ext_vector_type(2)));
typedef float f32x4 __attribute__((ext_vector_type(4)));
typedef float f32x16 __attribute__((ext_vector_type(16)));
typedef unsigned u32x2 __attribute__((ext_vector_type(2)));
typedef unsigned u32x4 __attribute__((ext_vector_type(4)));
typedef __bf16 bf16x2_t __attribute__((ext_vector_type(2)));

constexpr int NTOK = 32768, SEQ = 16384, DM = 1024;
constexpr int PW = 3072;
constexpr int PC_AQ = 0, PC_AK = 256, PC_AV = 512, PC_CQ = 768, PC_CKV = 1024, PC_SWQ = 1280, PC_SWK = 1536, PC_SWV = 1600,
              PC_GLOW = 1664, PC_DQ = 1792, PC_DK = 2176, PC_DV = 2560, PC_KPE = 2944;
constexpr int AOW = 896;
constexpr float LOG2E = 1.4426950408889634f;
constexpr float EPS = 1e-6f;
constexpr int NWG_THREADS = 512;

constexpr size_t MiB = 1u << 20;
constexpr size_t WS_CTL = 0, CTL_BYTES = 1 * MiB;
constexpr size_t WS_MTOK = 1 * MiB;
constexpr size_t WS_MW = 3 * MiB;
constexpr size_t WS_ROPE = 5 * MiB;
constexpr size_t WS_TAB = 7 * MiB;
constexpr size_t WS_WIN = 8 * MiB;
constexpr size_t WS_WQ = 20 * MiB;
constexpr size_t WS_WKV = 20 * MiB + 512 * 1024;
constexpr size_t WS_WGB = 21 * MiB;
constexpr size_t WS_WBR = 23 * MiB;
constexpr size_t WS_WOUT = 27 * MiB;
constexpr size_t WS_WGUD = 31 * MiB;
constexpr size_t WS_WDD = 39 * MiB;
constexpr size_t WS_WGUE = 43 * MiB;
constexpr size_t WS_WDE = 67 * MiB;
constexpr size_t WS_H = 80 * MiB;
constexpr size_t WS_PROJ = 144 * MiB;
constexpr size_t WS_AO = 336 * MiB;
constexpr size_t WS_Y = 392 * MiB;
constexpr size_t WS_END = 456 * MiB;
constexpr int CW_BAR = 4096;
constexpr int CW_MOE = 16384;

constexpr int LDS_STAGE = 0;
constexpr int LDS_VSCR = 0;
constexpr int LDS_DOBUF = 36864;
constexpr int LDS_MLA = 36864;
constexpr int LDS_DLSE = 135168;
constexpr int LDS_BTAB = 141312;
constexpr int LDS_CTL = 151872;
constexpr int LDS_BYTES = 152 * 1024;

__device__ __forceinline__ unsigned pk2(float lo, float hi) { f32x2 v = {lo, hi}; bf16x2_t b = __builtin_convertvector(v, bf16x2_t); return __builtin_bit_cast(unsigned, b); }
__device__ __forceinline__ float bf2f(unsigned short b) { return __uint_as_float(((unsigned)b) << 16); }
__device__ __forceinline__ float bflo(unsigned w) { return __uint_as_float(w << 16); }
__device__ __forceinline__ float bfhi(unsigned w) { return __uint_as_float(w & 0xffff0000u); }
__device__ __forceinline__ float ex2(float x) { return __builtin_amdgcn_exp2f(x); }
__device__ __forceinline__ float lg2(float x) { return __builtin_amdgcn_logf(x); }
__device__ __forceinline__ float rcpf(float x) { return __builtin_amdgcn_rcpf(x); }
template <int CTRL> __device__ __forceinline__ float dppx(float v) { return __uint_as_float((unsigned)__builtin_amdgcn_update_dpp(0, (int)__float_as_uint(v), CTRL, 0xf, 0xf, false)); }
__device__ __forceinline__ float row16_sum(float v) {
    v += dppx<0xB1>(v); v += dppx<0x4E>(v); v += dppx<0x141>(v); v += dppx<0x140>(v); return v;
}
__device__ __forceinline__ float x16_add(float v) { auto r = __builtin_amdgcn_permlane16_swap(__float_as_uint(v), __float_as_uint(v), false, false); return __uint_as_float(r[0]) + __uint_as_float(r[1]); }
__device__ __forceinline__ float x32_add(float v) { auto r = __builtin_amdgcn_permlane32_swap(__float_as_uint(v), __float_as_uint(v), false, false); return __uint_as_float(r[0]) + __uint_as_float(r[1]); }
__device__ __forceinline__ float x32_max(float v) { auto r = __builtin_amdgcn_permlane32_swap(__float_as_uint(v), __float_as_uint(v), false, false); return fmaxf(__uint_as_float(r[0]), __uint_as_float(r[1])); }
__device__ __forceinline__ float x32_other(float v, int hi) { auto r = __builtin_amdgcn_permlane32_swap(__float_as_uint(v), __float_as_uint(v), false, false); return __uint_as_float(hi ? r[0] : r[1]); }
__device__ __forceinline__ f32x4 unpk4(unsigned a, unsigned b) { return (f32x4){__builtin_bit_cast(float, a << 16), __builtin_bit_cast(float, a & 0xffff0000u), __builtin_bit_cast(float, b << 16), __builtin_bit_cast(float, b & 0xffff0000u)}; }
__device__ __forceinline__ float wave_sum(float v) { return x32_add(x16_add(row16_sum(v))); }
__device__ __forceinline__ int sigma32(int i) { return 16 * ((i >> 2) & 1) + (i & 3) + 4 * (i >> 3); }
__device__ __forceinline__ int pi32(int i) { const int h = (i >> 2) & 1, r = (i & 3) + 4 * (i >> 3); return 16 * (r >> 3) + 8 * h + (r & 7); }
__device__ __forceinline__ bf16x8 mk8(u32x4 v) { return __builtin_bit_cast(bf16x8, v); }

#define XB_TMO      128
#define XB_XCNT(j)  (256  + 64 * (j))
#define XB_XSUB(j)  (1280 + 64 * (j))
#define XB_XGEN(j)  (2304 + 64 * (j))
#define XB_TOP      3328
#define XB_TOPGEN   3392
#define XCD_BAR_WORDS 3456
#define XB_SPIN_CAP (1u << 20)
__device__ __forceinline__ unsigned xb_ld(unsigned* p)              { return __hip_atomic_load(p, __ATOMIC_RELAXED, __HIP_MEMORY_SCOPE_AGENT); }
__device__ __forceinline__ unsigned xb_add(unsigned* p, unsigned v) { return __hip_atomic_fetch_add(p, v, __ATOMIC_RELAXED, __HIP_MEMORY_SCOPE_AGENT); }
__device__ __forceinline__ unsigned xb_xcc_id() { return (unsigned)__builtin_amdgcn_s_getreg((3 << 11) | 20) & 0xFu; }
#define XB_SPIN(cond, bar) do { unsigned _sp = 0; while (cond) { __builtin_amdgcn_s_sleep(1); \
    if ((++_sp & 255u) == 0u) { if (xb_ld(&(bar)[XB_TMO])) break; if (_sp > XB_SPIN_CAP) { atomicAdd(&(bar)[XB_TMO], 1u); break; } } } } while (0)
struct XcdBarrier { unsigned* bar; unsigned x; volatile LAS unsigned* st; };
__device__ __forceinline__ XcdBarrier xcd_barrier_post(unsigned* bar, volatile LAS unsigned* st) {
    XcdBarrier b; b.bar = bar; b.x = xb_xcc_id(); b.st = st;
    if (threadIdx.x == 0) (void)xb_add(&bar[XB_XCNT(b.x)], 1u);
    return b;
}
__device__ __forceinline__ void xcd_barrier_complete(unsigned* bar, unsigned x, unsigned& nloc, unsigned& nx) {
    const unsigned G = gridDim.x * gridDim.y * gridDim.z;
    unsigned sum, cnt, mine, sp = 0u;
    for (;;) {
        sum = 0u; cnt = 0u; mine = 0u;
#pragma unroll
        for (unsigned j = 0; j < 16; ++j) { const unsigned c = xb_ld(&bar[XB_XCNT(j)]); sum += c; cnt += (c > 0u) ? 1u : 0u; mine = (j == x) ? c : mine; }
        if (sum == G) break;
        __builtin_amdgcn_s_sleep(1);
        if ((++sp & 255u) == 0u) { if (xb_ld(&bar[XB_TMO])) break; if (sp > XB_SPIN_CAP) { atomicAdd(&bar[XB_TMO], 1u); break; } }
    }
    nloc = mine > 0u ? mine : 1u; nx = cnt > 0u ? cnt : 1u;
}
__device__ __noinline__ void xcd_barrier(const XcdBarrier b) {
    asm volatile("s_waitcnt vmcnt(0)" ::: "memory");
    __syncthreads();
    if (threadIdx.x == 0) {
        unsigned* bar = b.bar;
        __builtin_amdgcn_s_waitcnt(0);
        unsigned nloc = b.st[0], nx = b.st[1];
        if (nloc == 0u) { xcd_barrier_complete(bar, b.x, nloc, nx); b.st[0] = nloc; b.st[1] = nx; }
        const unsigned old = xb_add(&bar[XB_XSUB(b.x)], 1u);
        const unsigned gen = old / nloc;
        if (old + 1u == (gen + 1u) * nloc) {
            __builtin_amdgcn_fence(__ATOMIC_RELEASE, "agent");
            asm volatile("s_waitcnt vmcnt(0)" ::: "memory");
            const unsigned og = xb_add(&bar[XB_TOP], 1u);
            const unsigned tg = og / nx;
            if (og + 1u == (tg + 1u) * nx) xb_add(&bar[XB_TOPGEN], 1u);
            else XB_SPIN(xb_ld(&bar[XB_TOPGEN]) == tg, bar);
            __builtin_amdgcn_fence(__ATOMIC_ACQUIRE, "agent");
            xb_add(&bar[XB_XGEN(b.x)], 1u);
            asm volatile("s_waitcnt vmcnt(0)" ::: "memory");
        } else {
            XB_SPIN(xb_ld(&bar[XB_XGEN(b.x)]) == gen, bar);
            __builtin_amdgcn_fence(__ATOMIC_ACQUIRE, "agent");
            asm volatile("s_waitcnt vmcnt(0)" ::: "memory");
        }
    }
    __syncthreads();
}

struct Params { const float* in[24]; float* out; unsigned char* ws; };
enum { I_X = 0, I_N1G, I_WIN, I_GQA, I_WQB, I_GKVA, I_WKVB, I_GMLA, I_GSW, I_GDIL, I_SINKS, I_RELB, I_WGA, I_WGB, I_BG, I_WBR, I_WOUT, I_N2G,
       I_WGUD, I_WDD, I_WR, I_BR, I_WGUE, I_WDE };

struct Ctx {
    LAS unsigned char* lds;
    int tid, lane, wid, G, vcu, gw, NGW;
};
__device__ __forceinline__ unsigned char* launder_ptr(unsigned char* q) { size_t z = 0; asm volatile("" : "+s"(z)); return q + z; }
__device__ __forceinline__ Ctx launder(const Ctx& c0) {
    Ctx c = c0; int t, w = c0.wid;
    asm volatile("" : "+s"(w));
    asm volatile("v_mbcnt_lo_u32_b32 %0, -1, 0\n\tv_mbcnt_hi_u32_b32 %0, -1, %0" : "=v"(t));
    __builtin_assume(t >= 0 && t < 64); __builtin_assume(w >= 0 && w < 8);
    c.lane = t; c.tid = (w << 6) | t; c.wid = w; c.gw = (int)blockIdx.x * 8 + w;
    return c;
}

__device__ __forceinline__ int inproj_map(int c) {
    if (c < 1280) return c;
    if (c < 1312) return PC_KPE + (c - 1280);
    if (c < 1568) return PC_SWQ + (c - 1312);
    if (c < 1632) return PC_SWK + (c - 1568);
    if (c < 1696) return PC_SWV + (c - 1632);
    return PC_DQ + (c - 1696);
}
struct ItemRegs { f32x4 v[8]; float ks[8]; };
struct ItemInfo { bf16_t* WT; int ldt, dst, k0; float scale; };
__device__ __forceinline__ void item_load(const LAS unsigned* JT, int id, int& j, int lane, ItemRegs& r, ItemInfo& inf) {
    while (id >= (int)JT[(j + 1) * 12 + 11]) ++j;
    const LAS unsigned* e = JT + j * 12;
    const float* W = (const float*)(((unsigned long long)e[1] << 32) | e[0]);
    inf.WT = (bf16_t*)(((unsigned long long)e[3] << 32) | e[2]);
    const float* ks = (const float*)(((unsigned long long)e[5] << 32) | e[4]);
    const int ldw = (int)e[6], N = (int)e[8], mode = (int)(e[10] & 255u), add = (int)(e[10] >> 8);
    inf.ldt = (int)e[9];
    const int it = id - (int)e[11], nblk = N / 32, kb = it / nblk, nb = it % nblk, cc0 = nb * 32;
    float scale = 1.f; int dst;
    if (mode == 0) dst = cc0 + add;
    else if (mode == 3) { dst = cc0 + add; scale = -LOG2E; }
    else if (mode == 1) { dst = inproj_map(cc0); if (cc0 < 256) scale = 0.125f * LOG2E; }
    else { const int half = N / 2; const int isu = cc0 >= half ? 1 : 0; const int cc = cc0 - isu * half; dst = 256 * (cc / 128) + 128 * isu + (cc % 128); }
    inf.dst = dst; inf.k0 = kb * 64; inf.scale = scale;
#pragma unroll
    for (int i = 0; i < 8; ++i) { const int kk = kb * 64 + (lane >> 3) + 8 * i; r.v[i] = *(const f32x4*)(W + (size_t)kk * ldw + cc0 + 4 * (lane & 7)); r.ks[i] = ks ? ks[kk] : 1.f; }
}
__device__ __forceinline__ void item_finish(const ItemRegs& r, const ItemInfo& inf, LAS float* scr, int lane) {
#pragma unroll
    for (int i = 0; i < 8; ++i) { const int kk = (lane >> 3) + 8 * i; const float sc = inf.scale * r.ks[i];
        LAS float* d = scr + kk * 33 + 4 * (lane & 7); d[0] = r.v[i].x * sc; d[1] = r.v[i].y * sc; d[2] = r.v[i].z * sc; d[3] = r.v[i].w * sc; }
    asm volatile("s_waitcnt lgkmcnt(0)" ::: "memory");
    const int c = lane & 7;
#pragma unroll
    for (int j = 0; j < 4; ++j) { const int n = (lane >> 3) + 8 * j; const LAS float* sp = scr + (8 * c) * 33 + n;
        u32x4 o; o.x = pk2(sp[0 * 33], sp[1 * 33]); o.y = pk2(sp[2 * 33], sp[3 * 33]); o.z = pk2(sp[4 * 33], sp[5 * 33]); o.w = pk2(sp[6 * 33], sp[7 * 33]);
        *(u32x4*)(inf.WT + (size_t)(inf.dst + n) * inf.ldt + inf.k0 + 8 * c) = o; }
    asm volatile("s_waitcnt lgkmcnt(0)" ::: "memory");
}
__device__ __forceinline__ int t5_bucket(int d) {
    if (d < 16) return d;
    int b = 16 + (int)(__log2f((float)d * (1.f / 16.f)) * (16.f / 7.f));
    return b > 31 ? 31 : b;
}
__device__ __forceinline__ void prologue(const Params& p, const Ctx& c0) {
    const Ctx c = launder(c0);
    unsigned char* ws = launder_ptr(p.ws);
    LAS float* scr = (LAS float*)(c.lds + c.wid * 16384);
    LAS unsigned* JT = (LAS unsigned*)(c.lds + 131072);
    if (c.tid == 0) {
        int nj = 0, first = 0;
#define JOB(W, ldw, K, N, WT, ldt, mode, add, ks) do { LAS unsigned* e_ = JT + nj * 12; const unsigned long long w_ = (unsigned long long)(W), t_ = (unsigned long long)(WT), k_ = (unsigned long long)(ks); \
        e_[0] = (unsigned)w_; e_[1] = (unsigned)(w_ >> 32); e_[2] = (unsigned)t_; e_[3] = (unsigned)(t_ >> 32); e_[4] = (unsigned)k_; e_[5] = (unsigned)(k_ >> 32); \
        e_[6] = (unsigned)(ldw); e_[7] = (unsigned)(K); e_[8] = (unsigned)(N); e_[9] = (unsigned)(ldt); e_[10] = (unsigned)(mode) | ((unsigned)(add) << 8); e_[11] = (unsigned)first; \
        first += ((K) / 64) * ((N) / 32); ++nj; } while (0)
        for (int l = 0; l < 2; ++l) {
            bf16_t* win = (bf16_t*)(ws + WS_WIN) + (size_t)l * PW * 1024;
            JOB(p.in[I_WIN] + (size_t)l * 1024 * 2848, 2848, 1024, 2848, win, 1024, 1, 0, (const float*)nullptr);
            JOB(p.in[I_WGA] + (size_t)l * 1024 * 128, 128, 1024, 128, win, 1024, 0, PC_GLOW, (const float*)nullptr);
            JOB(p.in[I_WQB] + (size_t)l * 256 * 384, 384, 256, 384, (bf16_t*)(ws + WS_WQ) + (size_t)l * 512 * 256, 256, 0, 0, p.in[I_GQA] + l * 256);
            JOB(p.in[I_WKVB] + (size_t)l * 256 * 512, 512, 256, 512, (bf16_t*)(ws + WS_WKV) + (size_t)l * 512 * 256, 256, 0, 0, p.in[I_GKVA] + l * 256);
            JOB(p.in[I_WGB] + (size_t)l * 128 * 4096, 4096, 128, 4096, (bf16_t*)(ws + WS_WGB) + (size_t)l * 4096 * 128, 128, 3, 0, (const float*)nullptr);
            bf16_t* wbr = (bf16_t*)(ws + WS_WBR) + (size_t)l * 1024 * 1024;
            const float* wb = p.in[I_WBR] + (size_t)l * 896 * 1024;
            JOB(wb, 1024, 256, 1024, wbr, 256, 0, 0, (const float*)nullptr);
            JOB(wb + (size_t)256 * 1024, 1024, 256, 1024, wbr + 1024 * 256, 256, 0, 0, (const float*)nullptr);
            JOB(wb + (size_t)512 * 1024, 1024, 256, 1024, wbr + 2 * 1024 * 256, 256, 0, 0, (const float*)nullptr);
            JOB(wb + (size_t)768 * 1024, 1024, 128, 1024, wbr + 3 * 1024 * 256, 128, 0, 0, (const float*)nullptr);
            JOB(p.in[I_WOUT] + (size_t)l * 1024 * 1024, 1024, 1024, 1024, (bf16_t*)(ws + WS_WOUT) + (size_t)l * 1024 * 1024, 1024, 0, 0, (const float*)nullptr);
        }
        JOB(p.in[I_WGUD], 4096, 1024, 4096, (bf16_t*)(ws + WS_WGUD), 1024, 2, 0, (const float*)nullptr);
        JOB(p.in[I_WDD], 1024, 2048, 1024, (bf16_t*)(ws + WS_WDD), 2048, 0, 0, (const float*)nullptr);
        for (int e = 0; e < 8; ++e) {
            JOB(p.in[I_WGUE] + (size_t)e * 1024 * 1536, 1536, 1024, 1536, (bf16_t*)(ws + WS_WGUE) + (size_t)e * 1536 * 1024, 1024, 2, 0, (const float*)nullptr);
            JOB(p.in[I_WDE] + (size_t)e * 768 * 1024, 1024, 768, 1024, (bf16_t*)(ws + WS_WDE) + (size_t)e * 1024 * 768, 768, 0, 0, (const float*)nullptr);
        }
#undef JOB
        JT[nj * 12 + 11] = (unsigned)first;
        JT[1023] = (unsigned)nj;
    }
    __syncthreads();
    {
        const int nj = (int)JT[1023], total = (int)JT[nj * 12 + 11];
        const int lo = (int)(((long long)c.gw * total) / c.NGW), hi = (int)(((long long)(c.gw + 1) * total) / c.NGW);
        int j = 0; ItemRegs ra, rb; ItemInfo ia, ib;
        if (lo < hi) item_load(JT, lo, j, c.lane, ra, ia);
        for (int id = lo; id < hi; ++id) {
            if (id + 1 < hi) item_load(JT, id + 1, j, c.lane, rb, ib);
            item_finish(ra, ia, scr, c.lane);
            ra = rb; ia = ib;
        }
    }
    __syncthreads();
    const int gt = c.gw * 64 + c.lane, NGT = c.NGW * 64;
    for (int l = 0; l < 2; ++l) {
        u32x4* z = (u32x4*)((bf16_t*)(ws + WS_WIN) + (size_t)l * PW * 1024 + (size_t)2976 * 1024);
        for (int i = gt; i < 96 * 1024 / 8; i += NGT) z[i] = (u32x4){0u, 0u, 0u, 0u};
        u32x4* z2 = (u32x4*)((bf16_t*)(ws + WS_WQ) + (size_t)l * 512 * 256 + (size_t)384 * 256);
        for (int i = gt; i < 128 * 256 / 8; i += NGT) z2[i] = (u32x4){0u, 0u, 0u, 0u};
    }
    {
        f32x2* rt = (f32x2*)(ws + WS_ROPE);
        for (int i = gt; i < SEQ * 16; i += NGT) {
            const int pos = i >> 4, j = i & 15;
            const double c4 = (j & 3) == 0 ? 1.0 : ((j & 3) == 1 ? 0.56234132519034908 : ((j & 3) == 2 ? 0.31622776601683794 : 0.17782794100389228));
            const double d4 = (j >> 2) == 0 ? 1.0 : ((j >> 2) == 1 ? 0.1 : ((j >> 2) == 2 ? 0.01 : 0.001));
            const float inv = (float)(c4 * d4);
            const float ang = (float)pos * inv;
            const double rev = (double)ang * 0.15915494309189535;
            const float fr = (float)(rev - rint(rev));
            rt[i] = (f32x2){__builtin_amdgcn_cosf(fr), __builtin_amdgcn_sinf(fr)};
        }
    }
    {
        float* bt = (float*)(ws + WS_TAB);
        for (int i = gt; i < 20 * 132; i += NGT) {
            const int hd = i / 132, d = i % 132;
            const int dil = hd < 8 ? 1 : (hd < 12 ? 1 : (hd < 16 ? 4 : 16));
            bt[i] = p.in[I_RELB][t5_bucket(d * dil) * 20 + hd] * LOG2E;
        }
        float* bn = bt + 20 * 132 + 256;
        for (int i = gt; i < 2 * 4096; i += NGT) bn[i] = -p.in[I_BG][i] * LOG2E;
        float* gt_ = bt + 20 * 132;
        for (int i = gt; i < 2 * 4 * 32; i += NGT) {
            const int l = i >> 7, t = (i >> 5) & 3, j = i & 31;
            const float sc = 0.17677669529663687f * LOG2E;
            float v;
            if (t == 0) v = p.in[I_GSW][l * 64 + j] * sc; else if (t == 1) v = p.in[I_GSW][l * 64 + 32 + j];
            else if (t == 2) v = p.in[I_GDIL][l * 64 + j] * sc; else v = p.in[I_GDIL][l * 64 + 32 + j];
            gt_[i] = v;
        }
    }
}

template <bool ROUTE>
__device__ __forceinline__ void rmsnorm_phase(const Params& p, const Ctx& c0, const void* xv, int x_f32, const float* g, bf16_t* h, const float* wr, const float* br) {
    const Ctx c = launder(c0);
    unsigned char* const wsl = launder_ptr(p.ws);
    const int lane = c.lane;
    f32x4 gv[4];
#pragma unroll
    for (int j = 0; j < 4; ++j) gv[j] = *(const f32x4*)(g + 4 * lane + 256 * j);
    f32x4 wv[ROUTE ? 32 : 1];
    if (ROUTE) {
#pragma unroll
        for (int j = 0; j < 4; ++j)
#pragma unroll
            for (int cc = 0; cc < 4; ++cc) { const float* w = wr + (size_t)(4 * lane + 256 * j + cc) * 8; wv[(j * 4 + cc) * 2] = *(const f32x4*)w; wv[(j * 4 + cc) * 2 + 1] = *(const f32x4*)(w + 4); }
    }
    int* mtok = (int*)(wsl + WS_MTOK); float* mw = (float*)(wsl + WS_MW); unsigned* ctl = (unsigned*)(wsl + WS_CTL);
    int my_tok = 0, my_e0 = 0, my_e1 = 0; float my_w0 = 0.f, my_w1 = 0.f; int nmine = 0;
    const bool wg_agg = ROUTE && (NTOK % c.NGW) == 0 && (NTOK / c.NGW) <= 64;
    LAS unsigned* rcnt = (LAS unsigned*)c.lds;
#define ROUTE_FLUSH(WG) do { \
        const bool act = lane < nmine; \
        unsigned cntv = 0; int pos0 = 0, pos1 = 0; \
        _Pragma("unroll") for (int k = 0; k < 2; ++k) { \
            const int me = k == 0 ? my_e0 : my_e1; \
            _Pragma("unroll") for (int e = 0; e < 8; ++e) { \
                const unsigned long long mask = __ballot(act && me == e); \
                if (lane == k * 8 + e) cntv = (unsigned)__popcll(mask); \
                if (me == e) { const int r = __popcll(mask & ((1ull << lane) - 1ull)); if (k == 0) pos0 = r; else pos1 = r; } } } \
        unsigned base = 0; \
        if (WG) { \
            if (lane < 16) rcnt[c.wid * 16 + lane] = cntv; \
            __syncthreads(); \
            if (c.wid == 0 && lane < 16) { \
                unsigned tot = 0; \
                _Pragma("unroll") for (int w = 0; w < 8; ++w) tot += rcnt[w * 16 + lane]; \
                unsigned wb = 0; \
                if (tot) wb = __hip_atomic_fetch_add(ctl + CW_MOE + 64 * lane, tot, __ATOMIC_RELAXED, __HIP_MEMORY_SCOPE_AGENT); \
                rcnt[128 + lane] = wb; } \
            __syncthreads(); \
            if (lane < 16) { base = rcnt[128 + lane]; for (int w = 0; w < c.wid; ++w) base += rcnt[w * 16 + lane]; } \
        } else { \
            if (lane < 16 && cntv) base = __hip_atomic_fetch_add(ctl + CW_MOE + 64 * lane, cntv, __ATOMIC_RELAXED, __HIP_MEMORY_SCOPE_AGENT); \
        } \
        const unsigned b0 = (unsigned)__builtin_amdgcn_ds_bpermute(my_e0 * 4, (int)base), b1 = (unsigned)__builtin_amdgcn_ds_bpermute((8 + my_e1) * 4, (int)base); \
        if (act) { \
            mtok[my_e0 * NTOK + b0 + pos0] = my_tok; mw[my_e0 * NTOK + b0 + pos0] = my_w0; \
            mtok[(8 + my_e1) * NTOK + b1 + pos1] = my_tok; mw[(8 + my_e1) * NTOK + b1 + pos1] = my_w1; } \
    } while (0)
    const float* x = (const float*)xv; const bf16_t* xb = (const bf16_t*)xv;
#define RMS_LOAD(dst, row) do { if (x_f32) { _Pragma("unroll") for (int j = 0; j < 4; ++j) dst[j] = ((const f32x4*)(x + (size_t)(row) * DM) + lane)[64 * j]; } \
        else { _Pragma("unroll") for (int j = 0; j < 4; ++j) { const u32x2 w_ = ((const u32x2*)(xb + (size_t)(row) * DM) + lane)[64 * j]; dst[j] = unpk4(w_.x, w_.y); } } } while (0)
    f32x4 nv[4];
    if (c.gw < NTOK) RMS_LOAD(nv, c.gw);
    for (int m = c.gw; m < NTOK; m += c.NGW) {
        f32x4 v[4]; float s = 0.f;
#pragma unroll
        for (int j = 0; j < 4; ++j) v[j] = nv[j];
        if (m + c.NGW < NTOK) RMS_LOAD(nv, m + c.NGW);
#pragma unroll
        for (int j = 0; j < 4; ++j) s += (v[j].x * v[j].x + v[j].y * v[j].y) + (v[j].z * v[j].z + v[j].w * v[j].w);
        const float rs = __builtin_amdgcn_rsqf(wave_sum(s) * (1.f / DM) + EPS);
        unsigned long long* o8 = (unsigned long long*)(h + (size_t)m * DM) + lane;
#pragma unroll
        for (int j = 0; j < 4; ++j) { v[j] = v[j] * rs * gv[j]; o8[64 * j] = (unsigned long long)pk2(v[j].x, v[j].y) | ((unsigned long long)pk2(v[j].z, v[j].w) << 32); }
        if (ROUTE) {
            float lg[8];
#pragma unroll
            for (int e = 0; e < 8; ++e) lg[e] = 0.f;
#pragma unroll
            for (int j = 0; j < 4; ++j)
#pragma unroll
                for (int cc = 0; cc < 4; ++cc) { const float xv = v[j][cc]; const f32x4 a = wv[(j * 4 + cc) * 2], b = wv[(j * 4 + cc) * 2 + 1];
                    lg[0] += xv * a.x; lg[1] += xv * a.y; lg[2] += xv * a.z; lg[3] += xv * a.w; lg[4] += xv * b.x; lg[5] += xv * b.y; lg[6] += xv * b.z; lg[7] += xv * b.w; }
#pragma unroll
            for (int e = 0; e < 8; ++e) lg[e] = wave_sum(lg[e]) + br[e];
            int e0 = 0; float v0 = lg[0];
#pragma unroll
            for (int e = 1; e < 8; ++e) if (lg[e] > v0) { v0 = lg[e]; e0 = e; }
            int e1 = -1; float v1 = -3.0e38f;
#pragma unroll
            for (int e = 0; e < 8; ++e) if (e != e0 && lg[e] > v1) { v1 = lg[e]; e1 = e; }
            const float t = ex2((v1 - v0) * LOG2E);
            const float w0 = 1.f / (1.f + t), w1 = t / (1.f + t);
            if (lane == nmine) { my_tok = m; my_e0 = e0; my_e1 = e1; my_w0 = w0; my_w1 = w1; }
            ++nmine;
            if (nmine == 64 || (!wg_agg && m + c.NGW >= NTOK)) { ROUTE_FLUSH(false); nmine = 0; }
        }
    }
    if (ROUTE && wg_agg) { ROUTE_FLUSH(true); }
#undef ROUTE_FLUSH
}

constexpr int SLOT_BYTES = 24576, SLOT_BOFF = 8192, NSLOT = 6;
struct Unit { int pm, pn, e, sa, sb; };
#define DMA16(m0v, voff, rsrc, soff) asm volatile("s_mov_b32 m0, %0\n\ts_nop 0\n\tbuffer_load_dwordx4 %1, %2, %3 offen lds" :: "s"(m0v), "v"(voff), "s"(rsrc), "s"(soff) : "m0", "memory")

template <int BM>
struct SubFrags { bf16x8 xf[2][BM / 64], wf[2][2]; };
template <int BM>
__device__ __forceinline__ void ld_frags(const LAS unsigned char* sl, SubFrags<BM>& F, int ks, int wr, int wc, int r32, int hi) {
    constexpr int MB = BM / 64;
    const int s32 = sigma32(r32);
    const unsigned xrow = (unsigned)(wr * (BM / 2) + r32) * 64u, kx = (r32 >> 2) & 3;
    const unsigned wrow = SLOT_BOFF + (unsigned)(wc * 64 + s32) * 64u, kw = (s32 >> 2) & 3;
#pragma unroll
    for (int mb = 0; mb < MB; ++mb) F.xf[ks][mb] = *(const LAS bf16x8*)(sl + xrow + mb * 2048 + (((2 * ks + hi) ^ kx) << 4));
#pragma unroll
    for (int nb = 0; nb < 2; ++nb) F.wf[ks][nb] = *(const LAS bf16x8*)(sl + wrow + nb * 2048 + (((2 * ks + hi) ^ kw) << 4));
}
template <int BM>
__device__ __forceinline__ void mma_sub_pipe(const LAS unsigned char* nxt, SubFrags<BM>& F, f32x16 (&acc)[BM / 64][2], int wr, int wc, int r32, int hi) {
    constexpr int MB = BM / 64;
#pragma unroll
    for (int ks = 0; ks < 2; ++ks) {
        __builtin_amdgcn_s_setprio(1);
#pragma unroll
        for (int mb = 0; mb < MB; ++mb)
#pragma unroll
            for (int nb = 0; nb < 2; ++nb) acc[mb][nb] = __builtin_amdgcn_mfma_f32_32x32x16_bf16(F.wf[ks][nb], F.xf[ks][mb], acc[mb][nb], 0, 0, 0);
        __builtin_amdgcn_s_setprio(0);
        __builtin_amdgcn_sched_barrier(0);
        ld_frags<BM>(nxt, F, ks, wr, wc, r32, hi);
        __builtin_amdgcn_sched_barrier(0);
    }
}

namespace pg8 {
constexpr int HALF = 128, HTB = HALF * 64 * 2;
__device__ __forceinline__ int lds_byte(int r, int c) { const int st = (r >> 4) * 2 + (c >> 5), rr = r & 15, cc = c & 31, ob = rr * 64 + cc * 2; return st * 1024 + (ob ^ (((ob >> 9) & 1) << 5)); }
__device__ __forceinline__ void stage_rc(int b, int& R, int& C) { const int st = b / 1024, sb = b % 1024, swz = sb ^ (((sb >> 9) & 1) << 5); R = (st >> 1) * 16 + swz / 64; C = (st & 1) * 32 + (swz % 64) / 2; }
__device__ __forceinline__ int perm32(int rho) { const int n = rho >> 4, i = rho & 15; return 8 * (i >> 2) + 4 * n + (i & 3); }

__device__ __forceinline__ const char* uni_ptr(const char* q) {
    const unsigned long long v = (unsigned long long)q;
    const unsigned lo = (unsigned)__builtin_amdgcn_readfirstlane((int)(unsigned)v), hi = (unsigned)__builtin_amdgcn_readfirstlane((int)(unsigned)(v >> 32));
    return (const char*)(((unsigned long long)hi << 32) | lo);
}
template <class Epi, class Sched, bool ALIGN_EPI, int SUB = 0>
__device__ __forceinline__ void gemm_phase(const Ctx& c0, const char* Abase, int K, const Sched& S, const Epi& E) {
    const Ctx c = launder(c0);
    LAS unsigned char* lds = c.lds + LDS_STAGE;
    const int tid = c.tid, wid = c.wid, lane = c.lane, wr = wid >> 2, wc = wid & 3, fr = lane & 15, fq = lane >> 4;
    int nt = K / 64; asm volatile("" : "+s"(nt));
    int R[2], C[2]; unsigned voffB[2];
#pragma unroll
    for (int i = 0; i < 2; ++i) { stage_rc(tid * 16 + i * 8192, R[i], C[i]); const int Rb = (R[i] & ~31) + perm32(R[i] & 31); voffB[i] = (unsigned)(Rb * S.ldb2 + C[i] * 2); }
    const size_t kstep = 128;
    const size_t hstepB = (size_t)HALF * S.ldb2;
    const unsigned ldsw = (unsigned)wid * 1024u;
    const int aoff = lds_byte(wr * 64 + fr, fq * 8), boff = lds_byte(wc * 32 + fr, fq * 8);
#define PG8_SA(b, h) (((b) * 2 + (h)) * HTB)
#define PG8_SB(b, h) ((4 + (b) * 2 + (h)) * HTB)
#define PG8_STAGE(bufoff, gbase, voff) do { const char* gb_ = (const char*)(gbase); asm volatile("" : "+s"(gb_));     \
        _Pragma("unroll") for (int _i = 0; _i < 2; ++_i) { unsigned vo_ = (voff)[_i]; asm volatile("" : "+v"(vo_)); \
        __builtin_amdgcn_global_load_lds((const unsigned*)(gb_ + vo_), (LAS unsigned*)(lds + (bufoff) + ldsw + _i * 8192), 16, 0, 0); } } while (0)
#define PG8_LDA(dst, b, h) do { _Pragma("unroll") for (int m = 0; m < 4; ++m) _Pragma("unroll") for (int k = 0; k < 2; ++k) dst[m][k] = *(const LAS bf16x8*)(lds + PG8_SA(b, h) + aoff + m * 2048 + k * 1024); } while (0)
#define PG8_LDB(dst, b, h) do { _Pragma("unroll") for (int n = 0; n < 2; ++n) _Pragma("unroll") for (int k = 0; k < 2; ++k) dst[n][k] = *(const LAS bf16x8*)(lds + PG8_SB(b, h) + boff + n * 2048 + k * 1024); } while (0)
#define PG8_MMA(ai, bj, At, Bt) do { __builtin_amdgcn_s_setprio(1); _Pragma("unroll") for (int m = 0; m < 4; ++m) _Pragma("unroll") for (int n = 0; n < 2; ++n) _Pragma("unroll") for (int k = 0; k < 2; ++k) \
        acc[ai][bj][m][n] = __builtin_amdgcn_mfma_f32_16x16x32_bf16(Bt[n][k], At[m][k], acc[ai][bj][m][n], 0, 0, 0); __builtin_amdgcn_s_setprio(0); } while (0)
#define PG8_WAIT_V(n) asm volatile("s_waitcnt vmcnt(" #n ")" ::: "memory")
#define PG8_WAIT_L(n) asm volatile("s_waitcnt lgkmcnt(" #n ")" ::: "memory")
#define PG8_BAR __builtin_amdgcn_s_barrier()
#define PG8_SCHED __builtin_amdgcn_sched_barrier(0)
    constexpr bool AFF = Sched::AFFINE;
    unsigned voffA[2] = {0u, 0u}; size_t hstepA = 0;
    if constexpr (AFF) {
#pragma unroll
        for (int i = 0; i < 2; ++i) voffA[i] = (unsigned)(R[i] * S.lda2 + C[i] * 2);
        hstepA = (size_t)HALF * S.lda2;
    }
#define PG8_STA(bufoff, abase, h, vv) do { if constexpr (AFF) PG8_STAGE(bufoff, (abase) + (h) * hstepA, voffA); else PG8_STAGE(bufoff, abase, (vv)[h]); } while (0)
    Unit cur, nxt; int ui = 0;
    if (!S.next(0, cur)) return;
    f32x4 acc[2][2][4][2];
    if constexpr (SUB == 0) E.init(acc, cur, wr, wc, fr, fq);
    else E.template init_sub<SUB>(acc, cur, wr, wc, fr, fq);
    bf16x8 At[4][2], B0[2][2], B1[2][2];
    unsigned vA[2][2] = {{0u, 0u}, {0u, 0u}}, vAn[2][2] = {{0u, 0u}, {0u, 0u}};
    const char* uA = Abase;
    if constexpr (AFF) uA = Abase + S.a_unit_off(cur) + (SUB ? (size_t)cur.sa * hstepA : (size_t)0); else S.a_offs(cur, R, C, vA);
    const char* cB = S.b_ptr(cur) + (SUB == 2 ? (size_t)cur.sb * hstepB : (size_t)0);
    PG8_STAGE(PG8_SB(0, 0), cB, voffB); PG8_STAGE(PG8_SB(0, 1), cB + hstepB, voffB); PG8_STA(PG8_SA(0, 0), uA, 0, vA); PG8_STA(PG8_SA(0, 1), uA, 1, vA);
    if (wr == 1) PG8_BAR;
    PG8_WAIT_V(2); PG8_BAR;
    PG8_STAGE(PG8_SB(1, 0), cB + kstep, voffB); PG8_STA(PG8_SA(1, 0), uA + kstep, 0, vA); PG8_STAGE(PG8_SB(1, 1), cB + hstepB + kstep, voffB);
    PG8_WAIT_V(6); PG8_BAR;
#define PG8_WAIT_N(n) asm volatile("s_waitcnt vmcnt(%0)" :: "n"(n) : "memory")
#define PG8_WAIT_R() do { if (rlx) PG8_WAIT_N(NS + 8); else PG8_WAIT_N(8); } while (0)
    constexpr int NS = SUB ? 0 : Epi::NSTORE;
    for (;;) {
        const bool has_next = S.next(ui + 1, nxt);
        const char* nuA = uA;
        if constexpr (AFF) { if (has_next) nuA = Abase + S.a_unit_off(nxt) + (SUB ? (size_t)nxt.sa * hstepA : (size_t)0); }
        else {
            if (has_next) { int td = tid; asm volatile("" : "+v"(td)); int R2[2], C2[2]; stage_rc(td * 16, R2[0], C2[0]); stage_rc(td * 16 + 8192, R2[1], C2[1]); S.a_offs(nxt, R2, C2, vAn); }
            else {
#pragma unroll
                for (int h = 0; h < 2; ++h) { vAn[h][0] = vA[h][0]; vAn[h][1] = vA[h][1]; }
            }
        }
        const char* nB = has_next ? S.b_ptr(nxt) + (SUB == 2 ? (size_t)nxt.sb * hstepB : (size_t)0) : cB;
        for (int t = 0; t < nt; t += 2) {
            const bool last = (t == nt - 2);
            const bool rlx = NS > 0 && t == 0 && ui > 0;
            const char* a1 = uA + (size_t)(t + 1) * kstep;
            const char* a2 = last ? nuA : uA + (size_t)(t + 2) * kstep; const char* b2 = last ? nB : cB + (size_t)(t + 2) * kstep;
            const char* a3 = a2 + kstep; const char* b3 = b2 + kstep;
            unsigned va2[2][2] = {{0u, 0u}, {0u, 0u}};
            if constexpr (!AFF) {
#pragma unroll
                for (int h = 0; h < 2; ++h) { va2[h][0] = last ? vAn[h][0] : vA[h][0]; va2[h][1] = last ? vAn[h][1] : vA[h][1]; }
            }
            PG8_LDB(B0, 0, 0); if constexpr (SUB < 2) PG8_LDB(B1, 0, 1); PG8_SCHED; PG8_LDA(At, 0, 0); if (NS == 0 || t > 0 || ui == 0) PG8_STA(PG8_SA(1, 1), a1, 1, vA);
            PG8_WAIT_R(); PG8_WAIT_L(0); PG8_BAR; PG8_MMA(0, 0, At, B0); if constexpr (SUB < 2) PG8_MMA(0, 1, At, B1); PG8_BAR; PG8_SCHED;
            if constexpr (SUB == 0) PG8_LDA(At, 0, 1); PG8_STAGE(PG8_SB(0, 0), b2, voffB); PG8_STAGE(PG8_SB(0, 1), b2 + hstepB, voffB); PG8_STA(PG8_SA(0, 0), a2, 0, va2);
            PG8_WAIT_R(); PG8_WAIT_L(0); PG8_BAR; if constexpr (SUB == 0) { PG8_MMA(1, 0, At, B0); PG8_MMA(1, 1, At, B1); } PG8_BAR; PG8_SCHED;
            PG8_LDB(B0, 1, 0); if constexpr (SUB < 2) PG8_LDB(B1, 1, 1); PG8_SCHED; PG8_LDA(At, 1, 0); PG8_STA(PG8_SA(0, 1), a2, 1, va2);
            PG8_WAIT_R(); PG8_WAIT_L(0); PG8_BAR; PG8_MMA(0, 0, At, B0); if constexpr (SUB < 2) PG8_MMA(0, 1, At, B1); PG8_BAR; PG8_SCHED;
            if constexpr (SUB == 0) PG8_LDA(At, 1, 1); PG8_STAGE(PG8_SB(1, 0), b3, voffB); PG8_STAGE(PG8_SB(1, 1), b3 + hstepB, voffB); PG8_STA(PG8_SA(1, 0), a3, 0, va2);
            PG8_WAIT_V(8); PG8_WAIT_L(0); PG8_BAR; if constexpr (SUB == 0) { PG8_MMA(1, 0, At, B0); PG8_MMA(1, 1, At, B1); } PG8_BAR; PG8_SCHED;
        }
        if constexpr (ALIGN_EPI) { if (wr == 0) PG8_BAR; }
        if (NS > 0) PG8_STA(PG8_SA(1, 1), nuA + kstep, 1, vAn);
        int ln = tid; asm volatile("" : "+v"(ln)); ln &= 63;
        if constexpr (SUB == 0) E(acc, cur, wr, wc, ln & 15, ln >> 4); else E.template run_sub<SUB>(acc, cur, wr, wc, ln & 15, ln >> 4);
        if (!has_next) break;
        if constexpr (SUB == 0) E.init(acc, nxt, wr, wc, ln & 15, ln >> 4); else E.template init_sub<SUB>(acc, nxt, wr, wc, ln & 15, ln >> 4);
        cur = nxt; cB = nB; uA = nuA; ++ui;
        if constexpr (!AFF) {
#pragma unroll
            for (int h = 0; h < 2; ++h) { vA[h][0] = vAn[h][0]; vA[h][1] = vAn[h][1]; }
        }
        if constexpr (ALIGN_EPI) { if (wr == 1) PG8_BAR; }
    }
    PG8_WAIT_V(0);
    if constexpr (!ALIGN_EPI) { if (wr == 0) PG8_BAR; }
    PG8_BAR;
#undef PG8_SA
#undef PG8_SB
#undef PG8_STAGE
#undef PG8_STA
#undef PG8_LDA
#undef PG8_LDB
#undef PG8_MMA
#undef PG8_WAIT_V
#undef PG8_WAIT_L
#undef PG8_BAR
#undef PG8_SCHED
#undef PG8_WAIT_R
#undef PG8_WAIT_N
}

__device__ __forceinline__ u32x4 pack8(const f32x4& a, const f32x4& b) { u32x4 w; w.x = pk2(a[0], a[1]); w.y = pk2(a[2], a[3]); w.z = pk2(b[0], b[1]); w.w = pk2(b[2], b[3]); return w; }

struct SchedPlain {
    static constexpr bool AFFINE = true;
    const char* Bt; int lda2, ldb2; int nM, nN, G, c;
    __device__ __forceinline__ size_t a_unit_off(const Unit& u) const { return (size_t)u.pm * 256 * lda2; }
    __device__ __forceinline__ bool next(int i, Unit& u) const {
        const int L = i * G + c; if (L >= nM * nN) return false;
        const int nig = 8 * nN, gid = L / nig, fm = gid * 8, wi = L % nig; int gsz = nM - fm; gsz = gsz < 8 ? gsz : 8;
        u.pm = fm + wi % gsz; u.pn = wi / gsz; u.e = 0; u.sa = 0; u.sb = 0; return true;
    }
    __device__ __forceinline__ void a_offs(const Unit& u, const int (&R)[2], const int (&C)[2], unsigned (&v)[2][2]) const {
#pragma unroll
        for (int h = 0; h < 2; ++h)
#pragma unroll
            for (int i = 0; i < 2; ++i) v[h][i] = (unsigned)(u.pm * 256 + h * 128 + R[i]) * (unsigned)lda2 + (unsigned)(C[i] * 2);
    }
    __device__ __forceinline__ const char* b_ptr(const Unit& u) const { return Bt + (size_t)u.pn * 256 * ldb2; }
};

struct EpiInProj {
    static constexpr int NSTORE = 16;
    bf16_t* O; const float* gtab;
    __device__ __forceinline__ void init(f32x4 (&acc)[2][2][4][2], const Unit&, int, int, int, int) const {
#pragma unroll
        for (int a = 0; a < 2; ++a)
#pragma unroll
            for (int b = 0; b < 2; ++b)
#pragma unroll
                for (int m = 0; m < 4; ++m)
#pragma unroll
                    for (int n = 0; n < 2; ++n) acc[a][b][m][n] = (f32x4){0.f, 0.f, 0.f, 0.f};
    }
    __device__ __forceinline__ void operator()(const f32x4 (&acc)[2][2][4][2], const Unit& u, int wr, int wc, int fr, int fq) const {
#pragma unroll
        for (int bj = 0; bj < 2; ++bj) {
            const int col = u.pn * 256 + bj * 128 + wc * 32, grp = col >> 5;
            int t = -1;
            if (grp >= 40 && grp < 48) t = 0; else if (grp >= 48 && grp < 50) t = 1; else if (grp >= 56 && grp < 68) t = 2; else if (grp >= 68 && grp < 80) t = 3;
            int sh = 0;
            if (grp >= 56 && grp < 92) { const int gg = ((grp - 56) % 12) >> 2; sh = 2 * gg; }
            const int smask = (1 << sh) - 1, sstr = SEQ >> sh;
            bf16_t* const Ob = O + col + 8 * fq;
            const int row0 = u.pm * 256 + wr * 64 + fr;
            if (t >= 0) {
                const f32x4 g0 = *(const f32x4*)(gtab + t * 32 + 8 * fq), g1 = *(const f32x4*)(gtab + t * 32 + 8 * fq + 4);
#pragma unroll
                for (int ai = 0; ai < 2; ++ai)
#pragma unroll
                    for (int m = 0; m < 4; ++m) {
                        f32x4 v0 = acc[ai][bj][m][0], v1 = acc[ai][bj][m][1];
                        float s = (v0[0] * v0[0] + v0[1] * v0[1]) + (v0[2] * v0[2] + v0[3] * v0[3]) + (v1[0] * v1[0] + v1[1] * v1[1]) + (v1[2] * v1[2] + v1[3] * v1[3]);
                        s = x32_add(x16_add(s));
                        const float rs = __builtin_amdgcn_rsqf(s * (1.f / 32.f) + EPS);
                        v0 = v0 * rs * g0; v1 = v1 * rs * g1;
                        const int row = row0 + ai * 128 + m * 16, sq = row & (SEQ - 1);
                        *(u32x4*)(Ob + (size_t)((row & ~(SEQ - 1)) + (sq & smask) * sstr + (sq >> sh)) * PW) = pack8(v0, v1);
                    }
            } else {
#pragma unroll
                for (int ai = 0; ai < 2; ++ai)
#pragma unroll
                    for (int m = 0; m < 4; ++m) {
                        const int row = row0 + ai * 128 + m * 16, sq = row & (SEQ - 1);
                        *(u32x4*)(Ob + (size_t)((row & ~(SEQ - 1)) + (sq & smask) * sstr + (sq >> sh)) * PW) = pack8(acc[ai][bj][m][0], acc[ai][bj][m][1]);
                    }
            }
        }
    }
};
struct EpiBf16 {
    static constexpr int NSTORE = 16;
    bf16_t* O; int ldo; int coff;
    __device__ __forceinline__ void init(f32x4 (&acc)[2][2][4][2], const Unit&, int, int, int, int) const {
#pragma unroll
        for (int a = 0; a < 2; ++a)
#pragma unroll
            for (int b = 0; b < 2; ++b)
#pragma unroll
                for (int m = 0; m < 4; ++m)
#pragma unroll
                    for (int n = 0; n < 2; ++n) acc[a][b][m][n] = (f32x4){0.f, 0.f, 0.f, 0.f};
    }
    __device__ __forceinline__ void operator()(const f32x4 (&acc)[2][2][4][2], const Unit& u, int wr, int wc, int fr, int fq) const {
#pragma unroll
        for (int ai = 0; ai < 2; ++ai)
#pragma unroll
            for (int m = 0; m < 4; ++m) {
                const int row = u.pm * 256 + ai * 128 + wr * 64 + m * 16 + fr;
#pragma unroll
                for (int bj = 0; bj < 2; ++bj) *(u32x4*)(O + (size_t)row * ldo + coff + u.pn * 256 + bj * 128 + wc * 32 + 8 * fq) = pack8(acc[ai][bj][m][0], acc[ai][bj][m][1]);
            }
    }
};
struct EpiResid {
    static constexpr int NSTORE = 16;
    const void* res; int res_f32; bf16_t* out;
    __device__ __forceinline__ void init(f32x4 (&acc)[2][2][4][2], const Unit& u, int wr, int wc, int fr, int fq) const {
        if (res_f32) {
            const float* rf = (const float*)res;
#pragma unroll
            for (int ai = 0; ai < 2; ++ai)
#pragma unroll
                for (int m = 0; m < 4; ++m) {
                    const int row = u.pm * 256 + ai * 128 + wr * 64 + m * 16 + fr;
#pragma unroll
                    for (int bj = 0; bj < 2; ++bj) {
                        const size_t o = (size_t)row * DM + u.pn * 256 + bj * 128 + wc * 32 + 8 * fq;
                        acc[ai][bj][m][0] = *(const f32x4*)(rf + o); acc[ai][bj][m][1] = *(const f32x4*)(rf + o + 4);
                    }
                }
        } else {
            const bf16_t* rb = (const bf16_t*)res;
#pragma unroll
            for (int ai = 0; ai < 2; ++ai)
#pragma unroll
                for (int m = 0; m < 4; ++m) {
                    const int row = u.pm * 256 + ai * 128 + wr * 64 + m * 16 + fr;
#pragma unroll
                    for (int bj = 0; bj < 2; ++bj) {
                        const u32x4 w = *(const u32x4*)(rb + (size_t)row * DM + u.pn * 256 + bj * 128 + wc * 32 + 8 * fq);
                        acc[ai][bj][m][0] = unpk4(w.x, w.y); acc[ai][bj][m][1] = unpk4(w.z, w.w);
                    }
                }
        }
    }
    __device__ __forceinline__ void operator()(const f32x4 (&acc)[2][2][4][2], const Unit& u, int wr, int wc, int fr, int fq) const {
#pragma unroll
        for (int ai = 0; ai < 2; ++ai)
#pragma unroll
            for (int m = 0; m < 4; ++m) {
                const int row = u.pm * 256 + ai * 128 + wr * 64 + m * 16 + fr;
#pragma unroll
                for (int bj = 0; bj < 2; ++bj)
                    *(u32x4*)(out + (size_t)row * DM + u.pn * 256 + bj * 128 + wc * 32 + 8 * fq) = pack8(acc[ai][bj][m][0], acc[ai][bj][m][1]);
            }
    }
};
struct EpiSwiglu {
    static constexpr int NSTORE = 8;
    bf16_t* O; int ldo;
    __device__ __forceinline__ void init(f32x4 (&acc)[2][2][4][2], const Unit&, int, int, int, int) const {
#pragma unroll
        for (int a = 0; a < 2; ++a)
#pragma unroll
            for (int b = 0; b < 2; ++b)
#pragma unroll
                for (int m = 0; m < 4; ++m)
#pragma unroll
                    for (int n = 0; n < 2; ++n) acc[a][b][m][n] = (f32x4){0.f, 0.f, 0.f, 0.f};
    }
    __device__ __forceinline__ void operator()(const f32x4 (&acc)[2][2][4][2], const Unit& u, int wr, int wc, int fr, int fq) const {
#pragma unroll
        for (int ai = 0; ai < 2; ++ai)
#pragma unroll
            for (int m = 0; m < 4; ++m) {
                f32x4 v[2];
#pragma unroll
                for (int n = 0; n < 2; ++n)
#pragma unroll
                    for (int q = 0; q < 4; ++q) { const float g = acc[ai][0][m][n][q], uu = acc[ai][1][m][n][q]; v[n][q] = g * uu * rcpf(1.f + ex2(-g * LOG2E)); }
                const int row = u.pm * 256 + ai * 128 + wr * 64 + m * 16 + fr;
                *(u32x4*)(O + (size_t)row * ldo + u.pn * 128 + wc * 32 + 8 * fq) = pack8(v[0], v[1]);
            }
    }
};

struct MoeInfo {
    int cnt[16], ts[17];
    __device__ __forceinline__ void load(const unsigned* ctl) {
        int s = 0;
#pragma unroll
        for (int g = 0; g < 16; ++g) { cnt[g] = (int)__builtin_amdgcn_readfirstlane(ctl[CW_MOE + 64 * g]); ts[g] = s; s += (cnt[g] + 255) >> 8; }
        ts[16] = s;
    }
    __device__ __forceinline__ void find(int rt, int& g, int& t0, int& n) const {
        g = 0; t0 = 0; n = cnt[0];
#pragma unroll
        for (int q = 1; q < 16; ++q) if (rt >= ts[q]) { g = q; t0 = ts[q]; n = cnt[q]; }
    }
};
struct SchedMoeUp {
    static constexpr bool AFFINE = false; static constexpr int lda2 = 0;
    MoeInfo mi; const char* W; const int* mtok; int ldb2; int G, c; int u0, nu, sh;
    __device__ __forceinline__ size_t a_unit_off(const Unit&) const { return 0; }
    __device__ __forceinline__ bool next(int i, Unit& u) const {
        const int nM = mi.ts[16], nN = 6; const int q = i * G + c; if (q >= (nu << sh)) return false;
        const int L = u0 + (q >> sh);
        const int nig = 8 * nN, gid = L / nig, fm = gid * 8, wi = L % nig; int gsz = nM - fm; gsz = gsz < 8 ? gsz : 8;
        u.pm = fm + wi % gsz; u.pn = wi / gsz; int g, t0, n; mi.find(u.pm, g, t0, n); u.e = g; u.sa = q & ((1 << sh) - 1); u.sb = 0; return true;
    }
    __device__ __forceinline__ void a_offs(const Unit& u, const int (&R)[2], const int (&C)[2], unsigned (&v)[2][2]) const {
        int g, t0, n; mi.find(u.pm, g, t0, n);
#pragma unroll
        for (int h = 0; h < 2; ++h)
#pragma unroll
            for (int i = 0; i < 2; ++i) { const int pos = (u.pm - t0) * 256 + (u.sa + h) * 128 + R[i]; const int tok = pos < n ? mtok[g * NTOK + pos] : 0; v[h][i] = (unsigned)tok * 2048u + (unsigned)(C[i] * 2); }
    }
    __device__ __forceinline__ const char* b_ptr(const Unit& u) const { return W + (size_t)(u.e & 7) * (1536 * 1024 * 2) + (size_t)u.pn * 256 * 2048; }
};
struct SchedMoeDown {
    static constexpr bool AFFINE = true; static constexpr int lda2 = 1536;
    MoeInfo mi; const char* W; int ldb2; int r0, nM, G, c; int u0, nu, sh;
    __device__ __forceinline__ size_t a_unit_off(const Unit& u) const { return (size_t)u.pm * 256 * 1536; }
    __device__ __forceinline__ bool next(int i, Unit& u) const {
        const int nN = 4; const int q = i * G + c; if (q >= (nu << sh)) return false;
        const int L = u0 + (q >> sh), sub = q & ((1 << sh) - 1);
        const int nig = 8 * nN, gid = L / nig, fm = gid * 8, wi = L % nig; int gsz = nM - fm; gsz = gsz < 8 ? gsz : 8;
        u.pm = r0 + fm + wi % gsz; u.pn = wi / gsz; int g, t0, n; mi.find(u.pm, g, t0, n); u.e = g;
        u.sa = sh == 2 ? (sub >> 1) : sub; u.sb = sh == 2 ? (sub & 1) : 0; return true;
    }
    __device__ __forceinline__ void a_offs(const Unit& u, const int (&R)[2], const int (&C)[2], unsigned (&v)[2][2]) const {
#pragma unroll
        for (int h = 0; h < 2; ++h)
#pragma unroll
            for (int i = 0; i < 2; ++i) v[h][i] = (unsigned)(u.pm * 256 + h * 128 + R[i]) * 1536u + (unsigned)(C[i] * 2);
    }
    __device__ __forceinline__ const char* b_ptr(const Unit& u) const { return W + (size_t)(u.e & 7) * (1024 * 768 * 2) + (size_t)u.pn * 256 * 1536; }
};
struct EpiSwigluMoe {
    static constexpr int NSTORE = 8;
    MoeInfo mi; bf16_t* O; const float* mw;
    template <int SUB>
    __device__ __forceinline__ void init_sub(f32x4 (&acc)[2][2][4][2], const Unit&, int, int, int, int) const {
#pragma unroll
        for (int a = 0; a < (SUB ? 1 : 2); ++a)
#pragma unroll
            for (int b = 0; b < 2; ++b)
#pragma unroll
                for (int m = 0; m < 4; ++m)
#pragma unroll
                    for (int n = 0; n < 2; ++n) acc[a][b][m][n] = (f32x4){0.f, 0.f, 0.f, 0.f};
    }
    template <int SUB>
    __device__ __forceinline__ void run_sub(const f32x4 (&acc)[2][2][4][2], const Unit& u, int wr, int wc, int fr, int fq) const {
        constexpr int NA = SUB ? 1 : 2;
        int g, t0, n; mi.find(u.pm, g, t0, n);
        float wv[NA][4];
#pragma unroll
        for (int ai = 0; ai < NA; ++ai)
#pragma unroll
            for (int m = 0; m < 4; ++m) { const int pos = (u.pm - t0) * 256 + (u.sa + ai) * 128 + wr * 64 + m * 16 + fr; wv[ai][m] = pos < n ? mw[g * NTOK + pos] : 0.f; }
#pragma unroll
        for (int ai = 0; ai < NA; ++ai)
#pragma unroll
            for (int m = 0; m < 4; ++m) {
                f32x4 v[2];
#pragma unroll
                for (int nn = 0; nn < 2; ++nn)
#pragma unroll
                    for (int q = 0; q < 4; ++q) { const float gg = acc[ai][0][m][nn][q], uu = acc[ai][1][m][nn][q]; v[nn][q] = wv[ai][m] * gg * uu * rcpf(1.f + ex2(-gg * LOG2E)); }
                const int row = u.pm * 256 + (u.sa + ai) * 128 + wr * 64 + m * 16 + fr;
                *(u32x4*)(O + (size_t)row * 768 + u.pn * 128 + wc * 32 + 8 * fq) = pack8(v[0], v[1]);
            }
    }
    __device__ __forceinline__ void init(f32x4 (&acc)[2][2][4][2], const Unit& u, int wr, int wc, int fr, int fq) const { init_sub<0>(acc, u, wr, wc, fr, fq); }
    __device__ __forceinline__ void operator()(const f32x4 (&acc)[2][2][4][2], const Unit& u, int wr, int wc, int fr, int fq) const { run_sub<0>(acc, u, wr, wc, fr, fq); }
};
struct EpiMoeDown {
    static constexpr int NSTORE = 0;
    MoeInfo mi; const bf16_t* src; void* dst; int dst_f32; const int* mtok;
    template <int SUB>
    __device__ __forceinline__ void init_sub(f32x4 (&acc)[2][2][4][2], const Unit& u, int wr, int wc, int fr, int fq) const {
        constexpr int NA = SUB ? 1 : 2, NB = SUB == 2 ? 1 : 2;
        int g, t0, n; mi.find(u.pm, g, t0, n);
#pragma unroll
        for (int ai = 0; ai < NA; ++ai)
#pragma unroll
            for (int m = 0; m < 4; ++m) {
                const int pos = (u.pm - t0) * 256 + (u.sa + ai) * 128 + wr * 64 + m * 16 + fr;
                const int tok = pos < n ? mtok[g * NTOK + pos] : -1;
#pragma unroll
                for (int bj = 0; bj < NB; ++bj) {
                    if (tok >= 0) { const u32x4 w = *(const u32x4*)(src + (size_t)tok * DM + u.pn * 256 + (u.sb + bj) * 128 + wc * 32 + 8 * fq); acc[ai][bj][m][0] = unpk4(w.x, w.y); acc[ai][bj][m][1] = unpk4(w.z, w.w); }
                    else { acc[ai][bj][m][0] = (f32x4){0.f, 0.f, 0.f, 0.f}; acc[ai][bj][m][1] = (f32x4){0.f, 0.f, 0.f, 0.f}; }
                }
            }
    }
    template <int SUB>
    __device__ __forceinline__ void run_sub(const f32x4 (&acc)[2][2][4][2], const Unit& u, int wr, int wc, int fr, int fq) const {
        constexpr int NA = SUB ? 1 : 2, NB = SUB == 2 ? 1 : 2;
        int g, t0, n; mi.find(u.pm, g, t0, n);
        int tk[NA][4];
#pragma unroll
        for (int ai = 0; ai < NA; ++ai)
#pragma unroll
            for (int m = 0; m < 4; ++m) { const int pos = (u.pm - t0) * 256 + (u.sa + ai) * 128 + wr * 64 + m * 16 + fr; tk[ai][m] = pos < n ? mtok[g * NTOK + pos] : -1; }
        if (dst_f32) {
            float* out = (float*)dst;
#pragma unroll
            for (int ai = 0; ai < NA; ++ai)
#pragma unroll
                for (int m = 0; m < 4; ++m) {
                    if (tk[ai][m] >= 0) {
#pragma unroll
                        for (int bj = 0; bj < NB; ++bj) {
                            const size_t o = (size_t)tk[ai][m] * DM + u.pn * 256 + (u.sb + bj) * 128 + wc * 32 + 8 * fq;
                            *(f32x4*)(out + o) = acc[ai][bj][m][0]; *(f32x4*)(out + o + 4) = acc[ai][bj][m][1];
                        }
                    }
                }
        } else {
            bf16_t* out = (bf16_t*)dst;
#pragma unroll
            for (int ai = 0; ai < NA; ++ai)
#pragma unroll
                for (int m = 0; m < 4; ++m) {
                    if (tk[ai][m] >= 0) {
#pragma unroll
                        for (int bj = 0; bj < NB; ++bj)
                            *(u32x4*)(out + (size_t)tk[ai][m] * DM + u.pn * 256 + (u.sb + bj) * 128 + wc * 32 + 8 * fq) = pack8(acc[ai][bj][m][0], acc[ai][bj][m][1]);
                    }
                }
        }
    }
    __device__ __forceinline__ void init(f32x4 (&acc)[2][2][4][2], const Unit& u, int wr, int wc, int fr, int fq) const { init_sub<0>(acc, u, wr, wc, fr, fq); }
    __device__ __forceinline__ void operator()(const f32x4 (&acc)[2][2][4][2], const Unit& u, int wr, int wc, int fr, int fq) const { run_sub<0>(acc, u, wr, wc, fr, fq); }
};
}

__device__ __forceinline__ void st16_bf16(bf16_t* p, const f32x16& v) {
    u32x4 a, b;
    a.x = pk2(v[0], v[1]); a.y = pk2(v[2], v[3]); a.z = pk2(v[4], v[5]); a.w = pk2(v[6], v[7]);
    b.x = pk2(v[8], v[9]); b.y = pk2(v[10], v[11]); b.z = pk2(v[12], v[13]); b.w = pk2(v[14], v[15]);
    *(u32x4*)p = a; *(u32x4*)(p + 8) = b;
}
__device__ __forceinline__ void merge_phase(const Params& p, const Ctx& c0, int l) {
    const Ctx c = launder(c0);
    unsigned char* const wsl = launder_ptr(p.ws);
    LAS unsigned char* lds = c.lds + LDS_STAGE;
    const int tid = c.tid, lane = c.lane, wid = c.wid, wr = wid >> 2, wc = wid & 3, fr = lane & 15, fq = lane >> 4;
    const float* bneg = (const float*)(wsl + WS_TAB) + 20 * 132 + 256 + l * 4096; bf16_t* Y = (bf16_t*)(wsl + WS_Y);
    constexpr int HTB = 16384, KTB = 3 * HTB;
    const int NU = 256 * 4;
    int R[2], C[2];
    unsigned vAg[2], vAb[2], vB1[2], vB2[2];
#pragma unroll
    for (int i = 0; i < 2; ++i) { pg8::stage_rc(tid * 16 + i * 8192, R[i], C[i]); const int Rb = (R[i] & ~31) + pg8::perm32(R[i] & 31);
        vAg[i] = (unsigned)(R[i] * (PW * 2) + C[i] * 2); vAb[i] = (unsigned)(R[i] * (AOW * 2) + C[i] * 2); vB1[i] = (unsigned)(Rb * 256 + C[i] * 2); vB2[i] = (unsigned)(Rb * 512 + C[i] * 2); }
    const char* pPG = (const char*)(wsl + WS_PROJ) + PC_GLOW * 2; const char* pAO = (const char*)(wsl + WS_AO);
    const char* pGB = (const char*)(wsl + WS_WGB) + (size_t)l * 4096 * 128 * 2; const char* pBR = (const char*)(wsl + WS_WBR) + (size_t)l * 1024 * 1024 * 2;
    const unsigned ldsw = (unsigned)wid * 1024u;
    const int aoff = pg8::lds_byte(wr * 64 + fr, fq * 8), boff = pg8::lds_byte(wc * 32 + fr, fq * 8);
#define UNIT_OF(i, pm, pn, ok) do { const int L_ = (i) * c.G + (int)blockIdx.x; ok = L_ < NU; if (ok) { const int gid_ = L_ / 32, wi_ = L_ % 32; pm = gid_ * 8 + wi_ % 8; pn = wi_ / 8; } } while (0)
    int pml = 0, pnl = 0, jl = 0, iul = 0, bl = 0; bool okl = false;
    UNIT_OF(0, pml, pnl, okl);
    if (!okl) return;
#define L_STAGE_ISSUE() do { const int i_ = jl < 18 ? jl / 6 : 3, jj_ = jl - 6 * i_, nkb_ = i_ < 3 ? 4 : 2; const bool isg_ = jj_ >= nkb_; const int kc_ = isg_ ? jj_ - nkb_ : jj_; \
        const size_t lda2_ = isg_ ? PW * 2 : AOW * 2, ldb2_ = isg_ ? 256 : (i_ < 3 ? 512 : 256); \
        const char* ua_ = (isg_ ? pPG : pAO + i_ * 512) + kc_ * 128 + (size_t)pml * 128 * lda2_; \
        const char* ub_ = (isg_ ? pGB + (size_t)i_ * (1024 * 128 * 2) : pBR + (size_t)i_ * (1024 * 256 * 2)) + kc_ * 128 + (size_t)pnl * 256 * ldb2_; \
        LAS unsigned char* d_ = lds + bl * KTB + ldsw; \
        _Pragma("unroll") for (int q_ = 0; q_ < 2; ++q_) { \
            __builtin_amdgcn_global_load_lds((const unsigned*)(ua_ + (isg_ ? vAg[q_] : vAb[q_])), (LAS unsigned*)(d_ + q_ * 8192), 16, 0, 0); \
            __builtin_amdgcn_global_load_lds((const unsigned*)(ub_ + (ldb2_ == 256 ? vB1[q_] : vB2[q_])), (LAS unsigned*)(d_ + HTB + q_ * 8192), 16, 0, 0); \
            __builtin_amdgcn_global_load_lds((const unsigned*)(ub_ + 128 * ldb2_ + (ldb2_ == 256 ? vB1[q_] : vB2[q_])), (LAS unsigned*)(d_ + 2 * HTB + q_ * 8192), 16, 0, 0); } \
        } while (0)
#define L_STAGE_ADV() do { bl = bl == 2 ? 0 : bl + 1; \
        if (jl + 1 < 22) ++jl; else { int pm2_ = 0, pn2_ = 0; bool ok2_; UNIT_OF(iul + 1, pm2_, pn2_, ok2_); if (ok2_) { ++iul; jl = 0; pml = pm2_; pnl = pn2_; } } } while (0)
#define L_STAGE() do { L_STAGE_ISSUE(); L_STAGE_ADV(); } while (0)
#define L_WAITV(n) asm volatile("s_waitcnt vmcnt(" #n ")" ::: "memory")
#define L_BAR __builtin_amdgcn_s_barrier()
    bf16x8 At[4][2], B0[2][2], B1[2][2];
    f32x4 acc[2][4][2];
#define L_STEP() do { const LAS unsigned char* b_ = lds + bc * KTB; \
        _Pragma("unroll") for (int n = 0; n < 2; ++n) _Pragma("unroll") for (int k = 0; k < 2; ++k) { B0[n][k] = *(const LAS bf16x8*)(b_ + HTB + boff + n * 2048 + k * 1024); B1[n][k] = *(const LAS bf16x8*)(b_ + 2 * HTB + boff + n * 2048 + k * 1024); } \
        __builtin_amdgcn_sched_barrier(0); \
        _Pragma("unroll") for (int m = 0; m < 4; ++m) _Pragma("unroll") for (int k = 0; k < 2; ++k) At[m][k] = *(const LAS bf16x8*)(b_ + aoff + m * 2048 + k * 1024); \
          \
        if (wr == 1) { L_STAGE_ISSUE(); L_WAITV(6); } \
        asm volatile("s_waitcnt lgkmcnt(0)" ::: "memory"); L_BAR; \
        __builtin_amdgcn_s_setprio(1); \
        _Pragma("unroll") for (int m = 0; m < 2; ++m) _Pragma("unroll") for (int n = 0; n < 2; ++n) _Pragma("unroll") for (int k = 0; k < 2; ++k) { \
            acc[0][m][n] = __builtin_amdgcn_mfma_f32_16x16x32_bf16(B0[n][k], At[m][k], acc[0][m][n], 0, 0, 0); \
            acc[1][m][n] = __builtin_amdgcn_mfma_f32_16x16x32_bf16(B1[n][k], At[m][k], acc[1][m][n], 0, 0, 0); } \
        __builtin_amdgcn_sched_barrier(0); \
        if (wr == 0) { L_STAGE_ISSUE(); }            \
        __builtin_amdgcn_sched_barrier(0); \
        _Pragma("unroll") for (int m = 2; m < 4; ++m) _Pragma("unroll") for (int n = 0; n < 2; ++n) _Pragma("unroll") for (int k = 0; k < 2; ++k) { \
            acc[0][m][n] = __builtin_amdgcn_mfma_f32_16x16x32_bf16(B0[n][k], At[m][k], acc[0][m][n], 0, 0, 0); \
            acc[1][m][n] = __builtin_amdgcn_mfma_f32_16x16x32_bf16(B1[n][k], At[m][k], acc[1][m][n], 0, 0, 0); } \
        __builtin_amdgcn_sched_barrier(0); \
        if (wr == 0) { L_WAITV(6); } \
        __builtin_amdgcn_s_setprio(0); \
        L_BAR; __builtin_amdgcn_sched_barrier(0); \
        L_STAGE_ADV(); \
        bc = bc == 2 ? 0 : bc + 1; } while (0)
    L_STAGE(); L_STAGE();
    L_WAITV(6); L_BAR;
    if (wr == 1) L_BAR;
    int bc = 0, pm = pml, pn = pnl; bool ok = true;
    pm = 0; pn = 0; UNIT_OF(0, pm, pn, ok);
#pragma unroll 1
    for (int iu = 0; ok; ++iu) {
        unsigned yy[2][4][2][2];
#pragma unroll
        for (int a = 0; a < 2; ++a)
#pragma unroll
            for (int m = 0; m < 4; ++m) { yy[a][m][0][0] = 0u; yy[a][m][0][1] = 0u; yy[a][m][1][0] = 0u; yy[a][m][1][1] = 0u; }
#pragma unroll 1
        for (int i = 0; i < 4; ++i) {
            const int nkb = i < 3 ? 4 : 2;
#pragma unroll
            for (int a = 0; a < 2; ++a)
#pragma unroll
                for (int m = 0; m < 4; ++m) { acc[a][m][0] = (f32x4){0.f, 0.f, 0.f, 0.f}; acc[a][m][1] = (f32x4){0.f, 0.f, 0.f, 0.f}; }
#pragma unroll 1
            for (int kc = 0; kc < nkb; ++kc) L_STEP();
            unsigned tpk[2][4][2][2];
            __builtin_amdgcn_sched_barrier(0);
#pragma unroll
            for (int bj = 0; bj < 2; ++bj) {
                int fqb = fq; asm volatile("" : "+v"(fqb));
                const float* bp = bneg + i * 1024 + pn * 256 + bj * 128 + wc * 32 + 8 * fqb;
                const f32x4 b0 = *(const f32x4*)bp, b1 = *(const f32x4*)(bp + 4);
#pragma unroll
                for (int m = 0; m < 4; ++m) {
#pragma unroll
                    for (int n = 0; n < 2; ++n) { tpk[bj][m][n][0] = pk2(acc[bj][m][n][0], acc[bj][m][n][1]); tpk[bj][m][n][1] = pk2(acc[bj][m][n][2], acc[bj][m][n][3]); }
                    acc[bj][m][0] = b0; acc[bj][m][1] = b1;
                }
            }
            __builtin_amdgcn_sched_barrier(0);
#pragma unroll 1
            for (int kc = 0; kc < 2; ++kc) L_STEP();
#pragma unroll
            for (int bj = 0; bj < 2; ++bj)
#pragma unroll
                for (int m = 0; m < 4; ++m)
#pragma unroll
                    for (int n = 0; n < 2; ++n) {
                        const float y0 = bflo(yy[bj][m][n][0]) + bflo(tpk[bj][m][n][0]) * rcpf(1.f + ex2(acc[bj][m][n][0]));
                        const float y1 = bfhi(yy[bj][m][n][0]) + bfhi(tpk[bj][m][n][0]) * rcpf(1.f + ex2(acc[bj][m][n][1]));
                        const float y2 = bflo(yy[bj][m][n][1]) + bflo(tpk[bj][m][n][1]) * rcpf(1.f + ex2(acc[bj][m][n][2]));
                        const float y3 = bfhi(yy[bj][m][n][1]) + bfhi(tpk[bj][m][n][1]) * rcpf(1.f + ex2(acc[bj][m][n][3]));
                        yy[bj][m][n][0] = pk2(y0, y1); yy[bj][m][n][1] = pk2(y2, y3);
                    }
        }
#pragma unroll
        for (int m = 0; m < 4; ++m) {
            int lb = lane; asm volatile("" : "+v"(lb));
            const int row = pm * 128 + wr * 64 + m * 16 + (lb & 15);
#pragma unroll
            for (int bj = 0; bj < 2; ++bj)
                *(u32x4*)(Y + (size_t)row * DM + pn * 256 + bj * 128 + wc * 32 + 8 * (lb >> 4)) = (u32x4){yy[bj][m][0][0], yy[bj][m][0][1], yy[bj][m][1][0], yy[bj][m][1][1]};
        }
        UNIT_OF(iu + 1, pm, pn, ok);
    }
    if (wr == 0) L_BAR;
    L_WAITV(0); L_BAR;
#undef UNIT_OF
#undef L_STAGE
#undef L_STAGE_ISSUE
#undef L_STAGE_ADV
#undef L_WAITV
#undef L_BAR
#undef L_STEP
}

__device__ __forceinline__ void mla_finalize(const Params& p, const Ctx& c0, int l) {
    const Ctx c = launder(c0);
    unsigned char* const wsl = launder_ptr(p.ws);
    const bf16_t* PROJ = (const bf16_t*)(wsl + WS_PROJ); const bf16_t* RAW = (const bf16_t*)(wsl + WS_H);
    bf16_t* QM = (bf16_t*)(wsl + WS_Y); bf16_t* KM = QM + (size_t)NTOK * 384; bf16_t* VM = KM + (size_t)NTOK * 384;
    const f32x2* rope = (const f32x2*)(wsl + WS_ROPE);
    const float* gq = p.in[I_GMLA] + l * 192; const float* gk = gq + 96;
    const int lane = c.lane, hd = lane >> 4, sub = lane & 15;
    const float SC = 0.10206207261596575f * LOG2E;
    f32x4 gqn = *(const f32x4*)(gq + 4 * sub), gkn = *(const f32x4*)(gk + 4 * sub);
    const float gq1 = gq[64 + sub], gq2 = gq[80 + sub], gk1 = gk[64 + sub], gk2 = gk[80 + sub];
    u32x2 n_cq, n_ck, n_qn, n_kn, n_vn; unsigned short n_x1, n_x2, n_p1, n_p2; f32x2 n_cs;
#define FIN_LOAD(m_) do { const bf16_t* pr_ = PROJ + (size_t)(m_) * PW; const bf16_t* rw_ = RAW + (size_t)(m_) * 1024; \
        n_cq = *(const u32x2*)(pr_ + PC_CQ + 4 * lane); n_ck = *(const u32x2*)(pr_ + PC_CKV + 4 * lane); n_cs = rope[(size_t)((m_) & (SEQ - 1)) * 16 + sub]; \
        n_qn = *(const u32x2*)(rw_ + hd * 96 + 4 * sub); n_x1 = rw_[hd * 96 + 64 + sub]; n_x2 = rw_[hd * 96 + 80 + sub]; \
        n_kn = *(const u32x2*)(rw_ + 512 + hd * 128 + 4 * sub); n_vn = *(const u32x2*)(rw_ + 512 + hd * 128 + 64 + 4 * sub); n_p1 = pr_[PC_KPE + sub]; n_p2 = pr_[PC_KPE + 16 + sub]; } while (0)
    if (c.gw < NTOK) FIN_LOAD(c.gw);
    for (int m = c.gw; m < NTOK; m += c.NGW) {
        const u32x2 cq = n_cq, ck = n_ck, qn = n_qn, kn = n_kn, vn = n_vn; const f32x2 cs = n_cs;
        const float x1r = bf2f(n_x1), x2r = bf2f(n_x2), p1 = bf2f(n_p1), p2 = bf2f(n_p2);
        if (m + c.NGW < NTOK) FIN_LOAD(m + c.NGW);
        float sq = bflo(cq.x) * bflo(cq.x) + bfhi(cq.x) * bfhi(cq.x) + bflo(cq.y) * bflo(cq.y) + bfhi(cq.y) * bfhi(cq.y);
        float sk = bflo(ck.x) * bflo(ck.x) + bfhi(ck.x) * bfhi(ck.x) + bflo(ck.y) * bflo(ck.y) + bfhi(ck.y) * bfhi(ck.y);
        const float rsq = __builtin_amdgcn_rsqf(wave_sum(sq) * (1.f / 256.f) + EPS), rsk = __builtin_amdgcn_rsqf(wave_sum(sk) * (1.f / 256.f) + EPS);
        float q0 = bflo(qn.x) * rsq, q1 = bfhi(qn.x) * rsq, q2 = bflo(qn.y) * rsq, q3 = bfhi(qn.y) * rsq;
        const float x1 = x1r * rsq, x2 = x2r * rsq;
        const float y1 = x1 * cs.x - x2 * cs.y, y2 = x2 * cs.x + x1 * cs.y;
        float ss = q0 * q0 + q1 * q1 + q2 * q2 + q3 * q3 + y1 * y1 + y2 * y2;
        ss = row16_sum(ss);
        float rr = __builtin_amdgcn_rsqf(ss * (1.f / 96.f) + EPS) * SC;
        bf16_t* qo = QM + (size_t)m * 384 + hd * 96;
        *(u32x2*)(qo + 4 * sub) = (u32x2){pk2(q0 * rr * gqn.x, q1 * rr * gqn.y), pk2(q2 * rr * gqn.z, q3 * rr * gqn.w)};
        qo[64 + sub] = (bf16_t)(pk2(y1 * rr * gq1, 0.f) & 0xffffu); qo[80 + sub] = (bf16_t)(pk2(y2 * rr * gq2, 0.f) & 0xffffu);
        float k0 = bflo(kn.x) * rsk, k1 = bfhi(kn.x) * rsk, k2 = bflo(kn.y) * rsk, k3 = bfhi(kn.y) * rsk;
        const float z1 = p1 * cs.x - p2 * cs.y, z2 = p2 * cs.x + p1 * cs.y;
        float sk2 = k0 * k0 + k1 * k1 + k2 * k2 + k3 * k3 + z1 * z1 + z2 * z2;
        sk2 = row16_sum(sk2);
        const float rk = __builtin_amdgcn_rsqf(sk2 * (1.f / 96.f) + EPS);
        const int bb = m >> 14, pos = m & (SEQ - 1), T = pos >> 6, kk = pos & 63;
        bf16_t* kt = KM + ((size_t)((bb * 4 + hd) * 256 + T)) * (12 * 64 * 8) + kk * 8;
        *(u32x2*)(kt + (sub >> 1) * 512 + 4 * (sub & 1)) = (u32x2){pk2(k0 * rk * gkn.x, k1 * rk * gkn.y), pk2(k2 * rk * gkn.z, k3 * rk * gkn.w)};
        kt[(8 + (sub >> 3)) * 512 + (sub & 7)] = (bf16_t)(pk2(z1 * rk * gk1, 0.f) & 0xffffu); kt[(10 + (sub >> 3)) * 512 + (sub & 7)] = (bf16_t)(pk2(z2 * rk * gk2, 0.f) & 0xffffu);
        bf16_t* vt_ = VM + ((size_t)((bb * 4 + hd) * 256 + T)) * (8 * 16 * 32) + ((sub >> 3) * 4 + (kk >> 4)) * 512 + (kk & 15) * 32 + (4 * sub & 31);
        *(u32x2*)vt_ = (u32x2){pk2(bflo(vn.x) * rsk, bfhi(vn.x) * rsk), pk2(bflo(vn.y) * rsk, bfhi(vn.y) * rsk)};
    }
#undef FIN_LOAD
}

__device__ __forceinline__ s16x4 tr16(const LAS unsigned char* p) { return __builtin_bit_cast(s16x4, __builtin_amdgcn_ds_read_tr16_b64_v4i16((LAS s16x4*)p)); }
__device__ __forceinline__ bf16x8 vfrag(const LAS unsigned char* vt, int VP, int s, int db, int lane) {
    const int hi = lane >> 5, q4 = (lane & 15) >> 2, pp = lane & 3, g1 = (lane >> 4) & 1;
    const LAS unsigned char* a = vt + (16 * s + 8 * hi + q4) * VP + (32 * db + 16 * g1 + 4 * pp) * 2;
    const s16x4 lo = tr16(a), hh = tr16(a + 4 * VP);
    return (bf16x8){lo[0], lo[1], lo[2], lo[3], hh[0], hh[1], hh[2], hh[3]};
}
__device__ __forceinline__ bf16x8 pfrag(const f32x16& pv, int s) {
    u32x4 w; w.x = pk2(pv[8 * s], pv[8 * s + 1]); w.y = pk2(pv[8 * s + 2], pv[8 * s + 3]); w.z = pk2(pv[8 * s + 4], pv[8 * s + 5]); w.w = pk2(pv[8 * s + 6], pv[8 * s + 7]);
    return mk8(w);
}
__device__ __forceinline__ float dot2_ones(unsigned pk, float c) { return __builtin_amdgcn_fdot2_f32_bf16(__builtin_bit_cast(bf16x2_t, pk), __builtin_bit_cast(bf16x2_t, 0x3F803F80u), c, false); }
__device__ __forceinline__ int keyof(int r, int hi) { return 16 * (r >> 3) + 8 * hi + (r & 7); }
__device__ __forceinline__ void store_ot(bf16_t* rowp, const f32x16& o, float sc, int hi) {
#pragma unroll
    for (int g = 0; g < 4; ++g) *(u32x2*)(rowp + 8 * g + 4 * hi) = (u32x2){pk2(o[4 * g] * sc, o[4 * g + 1] * sc), pk2(o[4 * g + 2] * sc, o[4 * g + 3] * sc)};
}

__device__ __forceinline__ void sb_unit(const Params& p, const Ctx& c0, int b, int h, int qt) {
    const Ctx c = launder(c0);
    unsigned char* const wsl = launder_ptr(p.ws);
    const bf16_t* PROJ = (const bf16_t*)(wsl + WS_PROJ); bf16_t* AO = (bf16_t*)(wsl + WS_AO);
    LAS unsigned char* vt = c.lds + LDS_VSCR + c.wid * 4608;
    const int lane = c.lane, r32 = lane & 31, hi = lane >> 5;
    const size_t tb = (size_t)b * SEQ;
    const bf16_t* qp = PROJ + (tb + qt * 32 + r32) * PW + PC_AQ + h * 64 + 8 * hi;
    bf16x8 qr[4];
#pragma unroll
    for (int d0 = 0; d0 < 4; ++d0) qr[d0] = *(const bf16x8*)(qp + 16 * d0);
    f32x16 o0 = (f32x16){}, o1 = (f32x16){};
    float R = 0.f;
    const int prow = pi32(r32);
    bf16x8 kf[4], nkf[4]; u32x4 vr[4], nvr[4];
#define SB_LOAD(KF, VR, kt_) do { const bf16_t* kp_ = PROJ + (tb + (kt_) * 32 + prow) * PW + PC_AK + h * 64 + 8 * hi; \
        _Pragma("unroll") for (int d0 = 0; d0 < 4; ++d0) KF[d0] = *(const bf16x8*)(kp_ + 16 * d0); \
        _Pragma("unroll") for (int i = 0; i < 4; ++i) { const int id = lane + 64 * i; VR[i] = *(const u32x4*)(PROJ + (tb + (kt_) * 32 + (id >> 3)) * PW + PC_AV + h * 64 + (id & 7) * 8); } } while (0)
    SB_LOAD(kf, vr, qt);
    for (int kt = qt; kt >= 0; --kt) {
        if (kt > 0) SB_LOAD(nkf, nvr, kt - 1);
        f32x16 z = (f32x16){};
#pragma unroll
        for (int d0 = 0; d0 < 4; ++d0) z = __builtin_amdgcn_mfma_f32_32x32x16_bf16(kf[d0], qr[d0], z, 0, 0, 0);
#pragma unroll
        for (int i = 0; i < 4; ++i) { const int id = lane + 64 * i; *(LAS u32x4*)(vt + (id >> 3) * 144 + (id & 7) * 16) = vr[i]; }
        f32x16 L; const bool diag = kt == qt;
#pragma unroll
        for (int r = 0; r < 16; ++r) {
            const float zz = z[r];
            float lv = -(fmaxf(zz, 0.f) + lg2(1.f + ex2(-fabsf(zz))));
            if (diag && keyof(r, hi) >= r32) lv = 0.f;
            L[r] = lv;
        }
        float ta = 0.f, tb2 = 0.f;
#pragma unroll
        for (int r = 0; r < 8; ++r) { ta += L[r]; tb2 += L[8 + r]; }
        const float pa = x32_other(ta, hi), pb = x32_other(tb2, hi);
        const float afterA = hi ? (pb + tb2) : (pa + tb2 + pb);
        const float afterB = hi ? 0.f : pb;
        f32x16 a;
        {
            float run = R + afterA;
#pragma unroll
            for (int r = 7; r >= 0; --r) { a[r] = ex2(z[r] + L[r] + run); run += L[r]; }
            run = R + afterB;
#pragma unroll
            for (int r = 15; r >= 8; --r) { a[r] = ex2(z[r] + L[r] + run); run += L[r]; }
        }
        if (diag) {
#pragma unroll
            for (int r = 0; r < 16; ++r) if (keyof(r, hi) >= r32) a[r] = 0.f;
        }
        R += (ta + pa) + (tb2 + pb);
#pragma unroll
        for (int s = 0; s < 2; ++s) {
            const bf16x8 pf = pfrag(a, s);
            o0 = __builtin_amdgcn_mfma_f32_32x32x16_bf16(vfrag(vt, 144, s, 0, lane), pf, o0, 0, 0, 0);
            o1 = __builtin_amdgcn_mfma_f32_32x32x16_bf16(vfrag(vt, 144, s, 1, lane), pf, o1, 0, 0, 0);
        }
        if (__all(R < -160.f)) break;
#pragma unroll
        for (int i = 0; i < 4; ++i) { kf[i] = nkf[i]; vr[i] = nvr[i]; }
    }
#undef SB_LOAD
    bf16_t* op = AO + (tb + qt * 32 + r32) * AOW + h * 64;
    store_ot(op, o0, 1.f, hi); store_ot(op + 32, o1, 1.f, hi);
}

__device__ __forceinline__ void local_attn(const bf16_t* PROJ, LAS unsigned char* vt, const LAS float* btab, int qcol, int kcol, int vcol,
                                           size_t tb, int dil, int rr, int m0, int W, int lane, f32x16& o, float& m, float& lsum) {
    const int r32 = lane & 31, hi = lane >> 5, prow = pi32(r32);
    const bf16_t* qp = PROJ + (tb + (size_t)(m0 + r32) * dil + rr) * PW + qcol + 8 * hi;
    const bf16x8 q0 = *(const bf16x8*)qp, q1 = *(const bf16x8*)(qp + 16);
    bf16x8 kf[5][2]; u32x4 vr[5][2];
#pragma unroll
    for (int ti = 0; ti < 5; ++ti) {
        const int k0 = m0 - 128 + 32 * ti;
        if (k0 >= 0) {
            const bf16_t* kp = PROJ + (tb + (size_t)(k0 + prow) * dil + rr) * PW + kcol + 8 * hi;
            kf[ti][0] = *(const bf16x8*)kp; kf[ti][1] = *(const bf16x8*)(kp + 16);
#pragma unroll
            for (int i = 0; i < 2; ++i) { const int id = lane + 64 * i; vr[ti][i] = *(const u32x4*)(PROJ + (tb + (size_t)(k0 + (id >> 2)) * dil + rr) * PW + vcol + (id & 3) * 8); }
        } else { kf[ti][0] = kf[ti][1] = (bf16x8){}; vr[ti][0] = vr[ti][1] = (u32x4){0u, 0u, 0u, 0u}; }
    }
    o = (f32x16){}; m = -1e30f; lsum = 0.f;
#pragma unroll
    for (int ti = 0; ti < 5; ++ti) {
        const int dl = 128 - 32 * ti, k0 = m0 - dl;
        if (k0 < 0) continue;
        f32x16 s = (f32x16){};
        s = __builtin_amdgcn_mfma_f32_32x32x16_bf16(kf[ti][0], q0, s, 0, 0, 0);
        s = __builtin_amdgcn_mfma_f32_32x32x16_bf16(kf[ti][1], q1, s, 0, 0, 0);
#pragma unroll
        for (int i = 0; i < 2; ++i) { const int id = lane + 64 * i; *(LAS u32x4*)(vt + (id >> 2) * 80 + (id & 3) * 16) = vr[ti][i]; }
        float mx = -INFINITY;
#pragma unroll
        for (int r = 0; r < 16; ++r) {
            const int dist = dl + r32 - keyof(r, hi);
            const int di = dist < 0 ? 0 : (dist > 131 ? 131 : dist);
            float v = s[r] + btab[di];
            if (dl == 0) { if (dist < 0) v = -INFINITY; }
            if (dl == 128) { if (dist > W) v = -INFINITY; }
            s[r] = v; mx = fmaxf(mx, v);
        }
        mx = x32_max(mx);
        const float mn = fmaxf(m, mx), f = ex2(m - mn);
        m = mn;
        float ps = 0.f;
#pragma unroll
        for (int r = 0; r < 16; ++r) { s[r] = ex2(s[r] - mn); ps += s[r]; }
        lsum = lsum * f + ps;
#pragma unroll
        for (int r = 0; r < 16; ++r) o[r] *= f;
#pragma unroll
        for (int st = 0; st < 2; ++st) o = __builtin_amdgcn_mfma_f32_32x32x16_bf16(vfrag(vt, 80, st, 0, lane), pfrag(s, st), o, 0, 0, 0);
    }
}

__device__ __forceinline__ void sw_unit(const Params& p, const Ctx& c0, int l, int b, int hq, int qt) {
    const Ctx c = launder(c0);
    unsigned char* const wsl = launder_ptr(p.ws);
    const bf16_t* PROJ = (const bf16_t*)(wsl + WS_PROJ); bf16_t* AO = (bf16_t*)(wsl + WS_AO);
    LAS unsigned char* vt = c.lds + LDS_VSCR + c.wid * 4608;
    const LAS float* btab = (const LAS float*)(c.lds + LDS_BTAB) + hq * 132;
    const int lane = c.lane, r32 = lane & 31, hi = lane >> 5, kv = hq >> 2;
    f32x16 o; float m, ls;
    local_attn(PROJ, vt, btab, PC_SWQ + hq * 32, PC_SWK + kv * 32, PC_SWV + kv * 32, (size_t)b * SEQ, 1, 0, qt * 32, 127, lane, o, m, ls);
    ls = x32_add(ls);
    const float sk = p.in[I_SINKS][l * 8 + hq] * LOG2E;
    const float mf = fmaxf(m, sk), f = ex2(m - mf);
    const float den = ls * f + ex2(sk - mf);
    store_ot(AO + ((size_t)b * SEQ + qt * 32 + r32) * AOW + 512 + hq * 32, o, f * rcpf(den), hi);
}

__device__ __forceinline__ void dil_unit(const Params& p, const Ctx& c0, int b, int tblk, int h) {
    const Ctx c = launder(c0);
    unsigned char* const wsl = launder_ptr(p.ws);
    const bf16_t* PROJ = (const bf16_t*)(wsl + WS_PROJ); bf16_t* AO = (bf16_t*)(wsl + WS_AO);
    LAS unsigned char* vt = c.lds + LDS_VSCR + c.wid * 4608;
    LAS bf16_t* obuf = (LAS bf16_t*)(c.lds + LDS_DOBUF); LAS float* lse = (LAS float*)(c.lds + LDS_DLSE);
    const int lane = c.lane, r32 = lane & 31, hi = lane >> 5;
    const int T0 = tblk * 512;
#pragma unroll 1
    for (int g = 0; g < 3; ++g) {
        const int dil = g == 0 ? 1 : (g == 1 ? 4 : 16), sh = g == 0 ? 0 : (g == 1 ? 2 : 4);
        const LAS float* btab = (const LAS float*)(c.lds + LDS_BTAB) + (8 + 4 * g + h) * 132;
#pragma unroll 1
        for (int jj = 0; jj < 2; ++jj) {
            const int j = 2 * c.wid + jj;
            const int ntr = 16 >> sh;
            const int rr = j / ntr, sub = j % ntr;
            const int m0 = (T0 >> sh) + 32 * sub;
            f32x16 o; float m, ls;
            local_attn(PROJ, vt, btab, PC_DQ + g * 128 + h * 32, PC_DK + g * 128 + h * 32, PC_DV + g * 128 + h * 32, (size_t)b * SEQ + (size_t)rr * (SEQ >> sh), 1, 0, m0, 128, lane, o, m, ls);
            ls = x32_add(ls);
            const float inv = rcpf(ls);
            const int tl = ((m0 + r32) << sh) + rr - T0;
            LAS bf16_t* ob = obuf + (tl * 3 + g) * 32;
#pragma unroll
            for (int q = 0; q < 4; ++q) *(LAS u32x2*)(ob + 8 * q + 4 * hi) = (u32x2){pk2(o[4 * q] * inv, o[4 * q + 1] * inv), pk2(o[4 * q + 2] * inv, o[4 * q + 3] * inv)};
            if (hi == 0) lse[tl * 3 + g] = m + lg2(ls);
        }
    }
    __syncthreads();
    {
        const int tl = c.tid;
        const float l0 = lse[tl * 3], l1 = lse[tl * 3 + 1], l2 = lse[tl * 3 + 2];
        const float mx = fmaxf(l0, fmaxf(l1, l2));
        float w0 = ex2(l0 - mx), w1 = ex2(l1 - mx), w2 = ex2(l2 - mx); const float iv = rcpf(w0 + w1 + w2); w0 *= iv; w1 *= iv; w2 *= iv;
        const LAS u32x4* ob = (const LAS u32x4*)(obuf + tl * 96);
        u32x4* dst = (u32x4*)(AO + ((size_t)b * SEQ + T0 + tl) * AOW + 768 + h * 32);
#pragma unroll
        for (int q = 0; q < 4; ++q) {
            const u32x4 a = ob[q], bq = ob[4 + q], cq = ob[8 + q];
            u32x4 r;
            r.x = pk2(w0 * bflo(a.x) + w1 * bflo(bq.x) + w2 * bflo(cq.x), w0 * bfhi(a.x) + w1 * bfhi(bq.x) + w2 * bfhi(cq.x));
            r.y = pk2(w0 * bflo(a.y) + w1 * bflo(bq.y) + w2 * bflo(cq.y), w0 * bfhi(a.y) + w1 * bfhi(bq.y) + w2 * bfhi(cq.y));
            r.z = pk2(w0 * bflo(a.z) + w1 * bflo(bq.z) + w2 * bflo(cq.z), w0 * bfhi(a.z) + w1 * bfhi(bq.z) + w2 * bfhi(cq.z));
            r.w = pk2(w0 * bflo(a.w) + w1 * bflo(bq.w) + w2 * bflo(cq.w), w0 * bfhi(a.w) + w1 * bfhi(bq.w) + w2 * bfhi(cq.w));
            dst[q] = r;
        }
    }
    __syncthreads();
}

#ifndef MLA_BIG
#define MLA_BIG 1.0995116e12f
#endif
constexpr int MK_SLOT = 12288, MV_SLOT = 8192, MLA_VOFF = 5 * MK_SLOT;
__device__ __forceinline__ void mla_qk(const LAS unsigned char* ks, const bf16x8 (&qr)[6], const f32x16& negm, int prow, int hi, f32x16& s0, f32x16& s1) {
    bf16x8 kf[12];
    const LAS unsigned char* kp = ks + hi * 1024 + prow * 16;
#pragma unroll
    for (int d0 = 0; d0 < 6; ++d0) { kf[2 * d0] = *(const LAS bf16x8*)(kp + d0 * 2048); kf[2 * d0 + 1] = *(const LAS bf16x8*)(kp + d0 * 2048 + 512); }
    __builtin_amdgcn_sched_barrier(0);
    s0 = __builtin_amdgcn_mfma_f32_32x32x16_bf16(kf[0], qr[0], negm, 0, 0, 0);
    s1 = __builtin_amdgcn_mfma_f32_32x32x16_bf16(kf[1], qr[0], negm, 0, 0, 0);
#pragma unroll
    for (int d0 = 1; d0 < 6; ++d0) {
        s0 = __builtin_amdgcn_mfma_f32_32x32x16_bf16(kf[2 * d0], qr[d0], s0, 0, 0, 0);
        s1 = __builtin_amdgcn_mfma_f32_32x32x16_bf16(kf[2 * d0 + 1], qr[d0], s1, 0, 0, 0);
    }
    __builtin_amdgcn_sched_barrier(0);
}
__device__ __forceinline__ bf16x8 mla_vfrag(const LAS unsigned char* vs, int s, int db, int lane) {
    const int hi = lane >> 5, q4 = (lane & 15) >> 2, pp = lane & 3, g1 = (lane >> 4) & 1;
    const LAS unsigned char* a = vs + (db * 4 + s) * 1024 + (8 * hi + q4) * 64 + (16 * g1 + 4 * pp) * 2;
    const s16x4 lo = tr16(a), hh = tr16(a + 256);
    return (bf16x8){lo[0], lo[1], lo[2], lo[3], hh[0], hh[1], hh[2], hh[3]};
}
__device__ __forceinline__ float max3f(float a, float b, float c) { return fmaxf(fmaxf(a, b), c); }
__device__ __forceinline__ float rowmax32(const f32x16& a, const f32x16& b) {
    float x = max3f(a[0], a[1], a[2]), y = max3f(b[0], b[1], b[2]);
    x = max3f(x, a[3], a[4]); y = max3f(y, b[3], b[4]); x = max3f(x, a[5], a[6]); y = max3f(y, b[5], b[6]);
    x = max3f(x, a[7], a[8]); y = max3f(y, b[7], b[8]); x = max3f(x, a[9], a[10]); y = max3f(y, b[9], b[10]);
    x = max3f(x, a[11], a[12]); y = max3f(y, b[11], b[12]); x = max3f(x, a[13], a[14]); y = max3f(y, b[13], b[14]);
    return max3f(x, y, fmaxf(a[15], b[15]));
}
__device__ __forceinline__ void mla_unit(const Params& p, const Ctx& c0, int b, int h, int qb) {
    const Ctx c = launder(c0);
    unsigned char* const wsl = launder_ptr(p.ws);
    const bf16_t* QM = (const bf16_t*)(wsl + WS_Y);
    bf16_t* AO = (bf16_t*)(wsl + WS_AO);
    LAS unsigned char* buf = c.lds + LDS_MLA;
    const int lane = c.lane, wid = c.wid, r32 = lane & 31, hi = lane >> 5, prow = pi32(r32);
    const size_t tb = (size_t)b * SEQ; const int q0 = qb * 256, qw0 = q0 + wid * 32;
    const bf16_t* qp = QM + (tb + qw0 + r32) * 384 + h * 96 + 8 * hi;
    bf16x8 qr[6];
#pragma unroll
    for (int d0 = 0; d0 < 6; ++d0) qr[d0] = *(const bf16x8*)(qp + 16 * d0);
    const int NT = (q0 + 256) / 64;
    const __amdgpu_buffer_rsrc_t rs = __builtin_amdgcn_make_buffer_rsrc((void*)wsl, (short)0, 0x7fffffff, 0x00020000);
    const unsigned ldsb = (unsigned)(__SIZE_TYPE__)buf;
    const unsigned kvo = (unsigned)lane * 16u;
    const unsigned kso = (unsigned)(WS_Y + (size_t)NTOK * 384 * 2) + (unsigned)(((size_t)(b * 4 + h) * 256) * (12 * 1024)), vso = (unsigned)(WS_Y + (size_t)NTOK * 768 * 2) + (unsigned)(((size_t)(b * 4 + h) * 256) * (8 * 1024));
#define MLA_DMA_K(t) do { if (wid < 4) { const unsigned m0_ = ldsb + (unsigned)((t) % 5) * MK_SLOT + (unsigned)wid * 1024u, so_ = kso + (unsigned)(t) * 12288u + (unsigned)wid * 1024u; \
        DMA16(m0_, kvo, rs, so_); DMA16(m0_ + 4096u, kvo, rs, so_ + 4096u); DMA16(m0_ + 8192u, kvo, rs, so_ + 8192u); } } while (0)
#define MLA_DMA_V(t) do { if (wid < 4) { const unsigned m0_ = ldsb + MLA_VOFF + (unsigned)((t) & 3) * MV_SLOT + (unsigned)wid * 1024u, so_ = vso + (unsigned)(t) * 8192u + (unsigned)wid * 1024u; \
        DMA16(m0_, kvo, rs, so_); DMA16(m0_ + 4096u, kvo, rs, so_ + 4096u); } } while (0)
#define MLA_SYNC() asm volatile("s_waitcnt vmcnt(0)\n\ts_barrier" ::: "memory")
    MLA_DMA_K(0); MLA_DMA_V(0); MLA_DMA_K(1); MLA_DMA_V(1); MLA_DMA_K(2); MLA_DMA_K(3);
    MLA_SYNC();
    f32x16 o0 = (f32x16){}, o1 = (f32x16){}, sA0, sA1, sB0, sB1, negm = (f32x16){};
    unsigned pkA[16], pkB[16];
    float m, ls = 0.f;
    {
        mla_qk(buf, qr, negm, prow, hi, sA0, sA1);
        if (qw0 < 63) {
            const int q8 = qw0 + r32 - 8 * hi;
#pragma unroll
            for (int r = 0; r < 16; ++r) { if (16 * (r >> 3) + (r & 7) > q8) sA0[r] = -INFINITY; if (32 + 16 * (r >> 3) + (r & 7) > q8) sA1[r] = -INFINITY; }
        }
        float mx = rowmax32(sA0, sA1);
        mx = x32_max(mx);
        m = mx;
#pragma unroll
        for (int r = 0; r < 16; ++r) { sA0[r] -= m; sA1[r] -= m; negm[r] = -m; }
    }
#define MLA_PV_HALF(PKP, vs_, sh) do { \
          const bf16x8 pa_ = mk8((u32x4){PKP[8 * (sh)], PKP[8 * (sh) + 1], PKP[8 * (sh) + 2], PKP[8 * (sh) + 3]}), pb_ = mk8((u32x4){PKP[8 * (sh) + 4], PKP[8 * (sh) + 5], PKP[8 * (sh) + 6], PKP[8 * (sh) + 7]}); \
          o0 = __builtin_amdgcn_mfma_f32_32x32x16_bf16(vf_[0], pa_, o0, 0, 0, 0); o1 = __builtin_amdgcn_mfma_f32_32x32x16_bf16(vf_[1], pa_, o1, 0, 0, 0); \
          o0 = __builtin_amdgcn_mfma_f32_32x32x16_bf16(vf_[2], pb_, o0, 0, 0, 0); o1 = __builtin_amdgcn_mfma_f32_32x32x16_bf16(vf_[3], pb_, o1, 0, 0, 0); } while (0)
#define MLA_VLOAD(vs_, sh) do { vf_[0] = mla_vfrag(vs_, 2 * (sh), 0, lane); vf_[1] = mla_vfrag(vs_, 2 * (sh), 1, lane); vf_[2] = mla_vfrag(vs_, 2 * (sh) + 1, 0, lane); vf_[3] = mla_vfrag(vs_, 2 * (sh) + 1, 1, lane); } while (0)
#define MLA_STEP(C0, C1, N0, N1, PKP, PKC, t, PVON) do { \
        const bool deep_ = (t) + 4 < NT; \
        if (64 * ((t) - 1) <= qw0 + 31) {            \
        if ((t) > 0 && 64 * (t) + 63 > qw0) { const int q8_ = qw0 + r32 - 64 * (t) - 8 * hi; \
            _Pragma("unroll") for (int r = 0; r < 16; ++r) { if (16 * (r >> 3) + (r & 7) > q8_) C0[r] = -INFINITY; if (32 + 16 * (r >> 3) + (r & 7) > q8_) C1[r] = -INFINITY; } } \
        float ps_ = 0.f, pt_ = 0.f; \
        { const LAS unsigned char* kp_ = buf + (((t) + 1) % 5) * MK_SLOT + hi * 1024 + prow * 16; \
          const LAS unsigned char* vs_ = buf + MLA_VOFF + (((t) + 3) & 3) * MV_SLOT;        \
          bf16x8 kf_[6], vf_[4]; \
          _Pragma("unroll") for (int d0 = 0; d0 < 3; ++d0) { kf_[2 * d0] = *(const LAS bf16x8*)(kp_ + d0 * 2048); kf_[2 * d0 + 1] = *(const LAS bf16x8*)(kp_ + d0 * 2048 + 512); } \
          if (PVON) MLA_VLOAD(vs_, 0); \
          __builtin_amdgcn_sched_barrier(0); \
          N0 = __builtin_amdgcn_mfma_f32_32x32x16_bf16(kf_[0], qr[0], negm, 0, 0, 0); \
          N1 = __builtin_amdgcn_mfma_f32_32x32x16_bf16(kf_[1], qr[0], negm, 0, 0, 0); \
          _Pragma("unroll") for (int d0 = 1; d0 < 3; ++d0) { \
              N0 = __builtin_amdgcn_mfma_f32_32x32x16_bf16(kf_[2 * d0], qr[d0], N0, 0, 0, 0); \
              N1 = __builtin_amdgcn_mfma_f32_32x32x16_bf16(kf_[2 * d0 + 1], qr[d0], N1, 0, 0, 0); } \
          if (PVON) MLA_PV_HALF(PKP, vs_, 0); \
          _Pragma("unroll") for (int r = 0; r < 8; ++r) { PKC[r] = pk2(ex2(C0[2 * r]), ex2(C0[2 * r + 1])); ps_ = dot2_ones(PKC[r], ps_); } \
          _Pragma("unroll") for (int g_ = 0; g_ < (PVON ? 10 : 6); ++g_) { __builtin_amdgcn_sched_group_barrier(0x008, 1, 0); __builtin_amdgcn_sched_group_barrier(0x002, (PVON ? 3 : 4), 0); } \
          __builtin_amdgcn_sched_barrier(0); \
          _Pragma("unroll") for (int d0 = 3; d0 < 6; ++d0) { kf_[2 * d0 - 6] = *(const LAS bf16x8*)(kp_ + d0 * 2048); kf_[2 * d0 - 5] = *(const LAS bf16x8*)(kp_ + d0 * 2048 + 512); } \
          if (PVON) MLA_VLOAD(vs_, 1); \
          __builtin_amdgcn_sched_barrier(0); \
          _Pragma("unroll") for (int d0 = 3; d0 < 6; ++d0) { \
              N0 = __builtin_amdgcn_mfma_f32_32x32x16_bf16(kf_[2 * d0 - 6], qr[d0], N0, 0, 0, 0); \
              N1 = __builtin_amdgcn_mfma_f32_32x32x16_bf16(kf_[2 * d0 - 5], qr[d0], N1, 0, 0, 0); } \
          if (PVON) MLA_PV_HALF(PKP, vs_, 1); \
          _Pragma("unroll") for (int r = 0; r < 8; ++r) { PKC[8 + r] = pk2(ex2(C1[2 * r]), ex2(C1[2 * r + 1])); pt_ = dot2_ones(PKC[8 + r], pt_); } \
          _Pragma("unroll") for (int g_ = 0; g_ < (PVON ? 10 : 6); ++g_) { __builtin_amdgcn_sched_group_barrier(0x008, 1, 0); __builtin_amdgcn_sched_group_barrier(0x002, (PVON ? 3 : 4), 0); } \
          __builtin_amdgcn_sched_barrier(0); } \
          \
        if (__any(!(ps_ + pt_ < MLA_BIG))) { \
            mla_qk(buf + ((t) % 5) * MK_SLOT, qr, negm, prow, hi, C0, C1); \
            if (64 * (t) + 63 > qw0) { const int q8_ = qw0 + r32 - 64 * (t) - 8 * hi; \
                _Pragma("unroll") for (int r = 0; r < 16; ++r) { if (16 * (r >> 3) + (r & 7) > q8_) C0[r] = -INFINITY; if (32 + 16 * (r >> 3) + (r & 7) > q8_) C1[r] = -INFINITY; } } \
            float mx_ = rowmax32(C0, C1); \
            mx_ = x32_max(mx_); \
            const float d_ = fmaxf(mx_, 0.f), f_ = ex2(-d_); m += d_; ls *= f_; \
            ps_ = 0.f; pt_ = 0.f; \
            _Pragma("unroll") for (int r = 0; r < 16; ++r) { o0[r] *= f_; o1[r] *= f_; negm[r] = -m; N0[r] -= d_; N1[r] -= d_; } \
            _Pragma("unroll") for (int r = 0; r < 8; ++r) { PKC[r] = pk2(ex2(C0[2 * r] - d_), ex2(C0[2 * r + 1] - d_)); PKC[8 + r] = pk2(ex2(C1[2 * r] - d_), ex2(C1[2 * r + 1] - d_)); ps_ = dot2_ones(PKC[r], ps_); pt_ = dot2_ones(PKC[8 + r], pt_); } \
        } \
        ls += ps_ + pt_; \
        } \
          \
        if (deep_) { MLA_DMA_K((t) + 4); MLA_DMA_V((t) + 2); } else if ((t) + 2 < NT) MLA_DMA_V((t) + 2); \
        if (deep_) asm volatile("s_waitcnt vmcnt(10)\n\ts_barrier" ::: "memory"); \
        else MLA_SYNC(); \
    } while (0)
    MLA_STEP(sA0, sA1, sB0, sB1, pkB, pkA, 0, false);
#pragma unroll 1
    for (int t = 1; t < NT; t += 2) {
        MLA_STEP(sB0, sB1, sA0, sA1, pkA, pkB, t, true);
        MLA_STEP(sA0, sA1, sB0, sB1, pkB, pkA, t + 1, true);
    }
    ls = x32_add(ls);
    const float inv = rcpf(ls);
    bf16_t* op = AO + (tb + qw0 + r32) * AOW + 256 + h * 64;
    store_ot(op, o0, inv, hi); store_ot(op + 32, o1, inv, hi);
#undef MLA_STEP
#undef MLA_VLOAD
#undef MLA_PV_HALF
#undef MLA_DMA_K
#undef MLA_DMA_V
#undef MLA_SYNC
}

__device__ __forceinline__ void attention_phase(const Params& p, const Ctx& c0, int l) {
    const Ctx c = launder(c0);
    unsigned char* const wsl = launder_ptr(p.ws);
    { const float* bt = (const float*)(wsl + WS_TAB); LAS float* lb = (LAS float*)(c.lds + LDS_BTAB); for (int i = c.tid; i < 20 * 132; i += NWG_THREADS) lb[i] = bt[i]; }
    __syncthreads();
    for (int rep = 0; rep < REPS(16); ++rep) for (int u = c.gw; u < 4096; u += c.NGW) { const int qt = u & 511, h = (u >> 9) & 3, b = u >> 11; sb_unit(p, c, b, h, qt); }
    for (int rep = 0; rep < REPS(16); ++rep) for (int u = c.gw; u < 8192; u += c.NGW) { const int qt = u & 511, hq = (u >> 9) & 7, b = u >> 12; sw_unit(p, c, l, b, hq, qt); }
    for (int rep = 0; rep < REPS(18); ++rep) for (int u = c.vcu; u < 256; u += c.G) { const int h = u & 3, tblk = (u >> 2) & 31, b = u >> 7; dil_unit(p, c, b, tblk, h); }
    for (int rep = 0; rep < REPS(19); ++rep) for (int v = c.vcu; v < 256; v += c.G) {
        const int bh = v >> 5, s = v & 31;
#pragma unroll 1
        for (int i = 0; i < 2; ++i) mla_unit(p, c, bh >> 2, bh & 3, i ? s : 63 - s);
    }
}

__global__ void __launch_bounds__(NWG_THREADS, 2) fwd_kernel(Params p) {
    extern __shared__ __attribute__((aligned(16))) unsigned char lds_raw[];
    Ctx c;
    c.lds = (LAS unsigned char*)lds_raw;
    c.tid = threadIdx.x; c.lane = c.tid & 63; c.wid = __builtin_amdgcn_readfirstlane(c.tid >> 6);
    c.G = gridDim.x; { const int bx = blockIdx.x; c.vcu = (c.G % 8 == 0) ? (bx % 8) * (c.G / 8) + bx / 8 : bx; }
    c.gw = blockIdx.x * 8 + c.wid; c.NGW = c.G * 8;
    volatile LAS unsigned* lctl = (volatile LAS unsigned*)(c.lds + LDS_CTL);
    if (c.tid < 64) lctl[c.tid] = 0u;
    __syncthreads();
    unsigned* ctl = (unsigned*)(p.ws + WS_CTL);
    XcdBarrier bar = xcd_barrier_post(ctl + CW_BAR, lctl + 8);
    bar.x = (unsigned)__builtin_amdgcn_readfirstlane((int)bar.x);
    const int bx = blockIdx.x;

    for (int rep = 0; rep < REPS(0); ++rep) prologue(p, c);
#pragma unroll 1
    for (int l = 0; l < 2; ++l) {
        unsigned char* ws = launder_ptr(p.ws);
        bf16_t* H = (bf16_t*)(ws + WS_H); bf16_t* PROJ = (bf16_t*)(ws + WS_PROJ); bf16_t* Y = (bf16_t*)(ws + WS_Y);
        bf16_t* const RS = (bf16_t*)p.out;
        const void* xin = l == 0 ? (const void*)p.in[I_X] : (const void*)RS;
        for (int rep = 0; rep < REPS(1); ++rep) rmsnorm_phase<false>(p, c, xin, l == 0, p.in[I_N1G] + l * DM, H, nullptr, nullptr);
        xcd_barrier(bar);
        if (PH(2)) for (int rep = 0; rep < REPS(2); ++rep) {
            if (rep) xcd_barrier(bar);
            pg8::SchedPlain S{(const char*)(ws + WS_WIN) + (size_t)l * PW * 1024 * 2, DM * 2, 1024 * 2, 128, 12, c.G, bx};
            pg8::EpiInProj E{PROJ, (const float*)(ws + WS_TAB) + 20 * 132 + l * 128};
            pg8::gemm_phase<pg8::EpiInProj, pg8::SchedPlain, true>(c, (const char*)H, 1024, S, E);
        }
        xcd_barrier(bar);
        for (int rep = 0; rep < REPS(3); ++rep) {
#pragma unroll 1
            for (int q = 0; q < 2; ++q) {
                pg8::SchedPlain S{(const char*)(ws + (q ? WS_WKV : WS_WQ)) + (size_t)l * 512 * 256 * 2, PW * 2, 256 * 2, 128, 2, c.G, bx};
                pg8::EpiBf16 E{H, 1024, q * 512};
                pg8::gemm_phase<pg8::EpiBf16, pg8::SchedPlain, true>(c, (const char*)(PROJ + (q ? PC_CKV : PC_CQ)), 256, S, E);
            }
        }
        xcd_barrier(bar);
        for (int rep = 0; rep < REPS(4); ++rep) mla_finalize(p, c, l);
        xcd_barrier(bar);
        if (PH(5)) for (int rep = 0; rep < REPS(5); ++rep) { if (rep) xcd_barrier(bar); attention_phase(p, c, l); }
        xcd_barrier(bar);
        if (PH(6)) for (int rep = 0; rep < REPS(6); ++rep) { if (rep) xcd_barrier(bar); merge_phase(p, c, l); }
        xcd_barrier(bar);
        if (PH(7)) {
            pg8::SchedPlain S{(const char*)(ws + WS_WOUT) + (size_t)l * 1024 * 1024 * 2, DM * 2, 1024 * 2, 128, 4, c.G, bx};
            pg8::EpiResid E{xin, l == 0, RS};
            pg8::gemm_phase<pg8::EpiResid, pg8::SchedPlain, true>(c, (const char*)Y, 1024, S, E);
        }
        xcd_barrier(bar);
        if (l == 0) {
            if (PH(8)) rmsnorm_phase<false>(p, c, RS, 0, p.in[I_N2G], H, nullptr, nullptr);
            xcd_barrier(bar);
            if (PH(9)) for (int rep = 0; rep < REPS(9); ++rep) {
                if (rep) xcd_barrier(bar);
                pg8::SchedPlain S{(const char*)(ws + WS_WGUD), DM * 2, 1024 * 2, 128, 16, c.G, bx};
                pg8::EpiSwiglu E{PROJ, 2048};
                pg8::gemm_phase<pg8::EpiSwiglu, pg8::SchedPlain, true>(c, (const char*)H, 1024, S, E);
            }
            xcd_barrier(bar);
            if (PH(10)) {
                pg8::SchedPlain S{(const char*)(ws + WS_WDD), 2048 * 2, 2048 * 2, 128, 4, c.G, bx};
                pg8::EpiResid E{RS, 0, RS};
                pg8::gemm_phase<pg8::EpiResid, pg8::SchedPlain, true>(c, (const char*)PROJ, 2048, S, E);
            }
            xcd_barrier(bar);
        } else {
            if (PH(11)) rmsnorm_phase<true>(p, c, RS, 0, p.in[I_N2G] + DM, H, p.in[I_WR], p.in[I_BR]);
            xcd_barrier(bar);
            pg8::MoeInfo mi; mi.load((const unsigned*)(ws + WS_CTL));
            if (PH(12)) {
                const int U = mi.ts[16] * 6, T0 = __builtin_amdgcn_readfirstlane(U % c.G), hv = (T0 > 0 && 2 * T0 <= c.G) ? 1 : 0, Uf = hv ? U - T0 : U;
                pg8::EpiSwigluMoe E{mi, PROJ, (const float*)(ws + WS_MW)};
                if (Uf > 0) {
                    pg8::SchedMoeUp S{mi, (const char*)(ws + WS_WGUE), (const int*)(ws + WS_MTOK), 2048, c.G, bx, 0, Uf, 0};
                    pg8::gemm_phase<pg8::EpiSwigluMoe, pg8::SchedMoeUp, true>(c, (const char*)H, 1024, S, E);
                }
                if (hv) {
                    pg8::SchedMoeUp S{mi, (const char*)(ws + WS_WGUE), (const int*)(ws + WS_MTOK), 2048, c.G, bx, Uf, T0, 1};
                    pg8::gemm_phase<pg8::EpiSwigluMoe, pg8::SchedMoeUp, true, 1>(c, (const char*)H, 1024, S, E);
                }
            }
            xcd_barrier(bar);
#pragma unroll 1
            for (int k = 0; k < 2; ++k) {
                if (k) xcd_barrier(bar);
                const int r0 = k ? mi.ts[8] : mi.ts[0], nMk = (k ? mi.ts[16] : mi.ts[8]) - r0, U = nMk * 4;
                const int T0 = __builtin_amdgcn_readfirstlane(U % c.G), nsub = T0 == 0 ? 1 : (4 * T0 <= c.G ? 4 : (2 * T0 <= c.G ? 2 : 1)), Uf = nsub == 1 ? U : U - T0;
                pg8::EpiMoeDown E{mi, k ? (const bf16_t*)H : (const bf16_t*)RS, k ? (void*)p.out : (void*)H, k, (const int*)(ws + WS_MTOK)};
                if (Uf > 0) {
                    pg8::SchedMoeDown S{mi, (const char*)(ws + WS_WDE), 1536, r0, nMk, c.G, bx, 0, Uf, 0};
                    pg8::gemm_phase<pg8::EpiMoeDown, pg8::SchedMoeDown, true>(c, (const char*)PROJ, 768, S, E);
                }
                if (nsub == 4) {
                    pg8::SchedMoeDown S{mi, (const char*)(ws + WS_WDE), 1536, r0, nMk, c.G, bx, Uf, T0, 2};
                    pg8::gemm_phase<pg8::EpiMoeDown, pg8::SchedMoeDown, true, 2>(c, (const char*)PROJ, 768, S, E);
                } else if (nsub == 2) {
                    pg8::SchedMoeDown S{mi, (const char*)(ws + WS_WDE), 1536, r0, nMk, c.G, bx, Uf, T0, 1};
                    pg8::gemm_phase<pg8::EpiMoeDown, pg8::SchedMoeDown, true, 1>(c, (const char*)PROJ, 768, S, E);
                }
            }
        }
    }
}

extern "C" void kernel_launch(void* const* d_in, const int* in_sizes, int n_in, void* d_out, int out_size, void* d_ws, size_t ws_size, hipStream_t stream) {
    static int grid = 0;
    if (grid == 0) {
        if (n_in != 24 || ws_size < WS_END) { fprintf(stderr, "kernel_launch: unexpected inputs (n_in %d, ws %zu)\n", n_in, ws_size); grid = -1; return; }
        int dev = 0, cus = 0, per_cu = 0;
        hipGetDevice(&dev); hipDeviceGetAttribute(&cus, hipDeviceAttributeMultiprocessorCount, dev);
        hipFuncSetAttribute((const void*)fwd_kernel, hipFuncAttributeMaxDynamicSharedMemorySize, LDS_BYTES);
        hipOccupancyMaxActiveBlocksPerMultiprocessor(&per_cu, (const void*)fwd_kernel, NWG_THREADS, LDS_BYTES);
        (void)hipGetLastError();
        grid = cus;
    }
    if (grid < 0) return;
    hipMemsetAsync((char*)d_ws + WS_CTL, 0, CTL_BYTES, stream);
    Params p{};
    for (int i = 0; i < 24; ++i) p.in[i] = (const float*)d_in[i];
    p.out = (float*)d_out; p.ws = (unsigned char*)d_ws;
    hipLaunchKernelGGL(fwd_kernel, dim3(grid), dim3(NWG_THREADS), LDS_BYTES, stream, p);
}
```

```cpp
#include <hip/hip_runtime.h>
#include <stdint.h>
#include <stdio.h>

#define LAS __attribute__((address_space(3)))
#ifndef PROBE_REP
#define PROBE_REP -1
#endif
#define REPS(n) ((PROBE_REP == (n)) ? 2 : 1)
#ifndef PHM
#define PHM 0xFFFFFFFFu
#endif
#define PH(n) ((PHM >> (n)) & 1u)
typedef unsigned short bf16_t;
typedef short bf16x8 __attribute__((ext_vector_type(8)));
typedef short s16x4 __attribute__((ext_vector_type(4)));
typedef float f32x2 __attribute__((ext_vector_type(2)));
typedef float f32x4 __attribute__((ext_vector_type(4)));
typedef float f32x16 __attribute__((ext_vector_type(16)));
typedef unsigned u32x2 __attribute__((ext_vector_type(2)));
typedef unsigned u32x4 __attribute__((ext_vector_type(4)));
typedef __bf16 bf16x2_t __attribute__((ext_vector_type(2)));

constexpr int NTOK = 32768, SEQ = 16384, DM = 1024;
constexpr int PW = 3072;
constexpr int PC_AQ = 0, PC_AK = 256, PC_AV = 512, PC_CQ = 768, PC_CKV = 1024, PC_SWQ = 1280, PC_SWK = 1536, PC_SWV = 1600,
              PC_GLOW = 1664, PC_DQ = 1792, PC_DK = 2176, PC_DV = 2560, PC_KPE = 2944;
constexpr int AOW = 896;
constexpr float LOG2E = 1.4426950408889634f;
constexpr float EPS = 1e-6f;
constexpr int NWG_THREADS = 512;

constexpr size_t MiB = 1u << 20;
constexpr size_t WS_CTL = 0, CTL_BYTES = 1 * MiB;
constexpr size_t WS_MTOK = 1 * MiB;
constexpr size_t WS_MW = 3 * MiB;
constexpr size_t WS_ROPE = 5 * MiB;
constexpr size_t WS_TAB = 7 * MiB;
constexpr size_t WS_WIN = 8 * MiB;
constexpr size_t WS_WQ = 20 * MiB;
constexpr size_t WS_WKV = 20 * MiB + 512 * 1024;
constexpr size_t WS_WGB = 21 * MiB;
constexpr size_t WS_WBR = 23 * MiB;
constexpr size_t WS_WOUT = 27 * MiB;
constexpr size_t WS_WGUD = 31 * MiB;
constexpr size_t WS_WDD = 39 * MiB;
constexpr size_t WS_WGUE = 43 * MiB;
constexpr size_t WS_WDE = 67 * MiB;
constexpr size_t WS_H = 80 * MiB;
constexpr size_t WS_PROJ = 144 * MiB;
constexpr size_t WS_AO = 336 * MiB;
constexpr size_t WS_Y = 392 * MiB;
constexpr size_t WS_END = 456 * MiB;
constexpr int CW_BAR = 4096;
constexpr int CW_MOE = 16384;

constexpr int LDS_STAGE = 0;
constexpr int LDS_VSCR = 0;
constexpr int LDS_DOBUF = 36864;
constexpr int LDS_MLA = 36864;
constexpr int LDS_DLSE = 135168;
constexpr int LDS_BTAB = 141312;
constexpr int LDS_CTL = 151872;
constexpr int LDS_BYTES = 152 * 1024;

__device__ __forceinline__ unsigned pk2(float lo, float hi) { f32x2 v = {lo, hi}; bf16x2_t b = __builtin_convertvector(v, bf16x2_t); return __builtin_bit_cast(unsigned, b); }
__device__ __forceinline__ float bf2f(unsigned short b) { return __uint_as_float(((unsigned)b) << 16); }
__device__ __forceinline__ float bflo(unsigned w) { return __uint_as_float(w << 16); }
__device__ __forceinline__ float bfhi(unsigned w) { return __uint_as_float(w & 0xffff0000u); }
__device__ __forceinline__ float ex2(float x) { return __builtin_amdgcn_exp2f(x); }
__device__ __forceinline__ float lg2(float x) { return __builtin_amdgcn_logf(x); }
__device__ __forceinline__ float rcpf(float x) { return __builtin_amdgcn_rcpf(x); }
template <int CTRL> __device__ __forceinline__ float dppx(float v) { return __uint_as_float((unsigned)__builtin_amdgcn_update_dpp(0, (int)__float_as_uint(v), CTRL, 0xf, 0xf, false)); }
__device__ __forceinline__ float row16_sum(float v) {
    v += dppx<0xB1>(v); v += dppx<0x4E>(v); v += dppx<0x141>(v); v += dppx<0x140>(v); return v;
}
__device__ __forceinline__ float x16_add(float v) { auto r = __builtin_amdgcn_permlane16_swap(__float_as_uint(v), __float_as_uint(v), false, false); return __uint_as_float(r[0]) + __uint_as_float(r[1]); }
__device__ __forceinline__ float x32_add(float v) { auto r = __builtin_amdgcn_permlane32_swap(__float_as_uint(v), __float_as_uint(v), false, false); return __uint_as_float(r[0]) + __uint_as_float(r[1]); }
__device__ __forceinline__ float x32_max(float v) { auto r = __builtin_amdgcn_permlane32_swap(__float_as_uint(v), __float_as_uint(v), false, false); return fmaxf(__uint_as_float(r[0]), __uint_as_float(r[1])); }
__device__ __forceinline__ float x32_other(float v, int hi) { auto r = __builtin_amdgcn_permlane32_swap(__float_as_uint(v), __float_as_uint(v), false, false); return __uint_as_float(hi ? r[0] : r[1]); }
__device__ __forceinline__ f32x4 unpk4(unsigned a, unsigned b) { return (f32x4){__builtin_bit_cast(float, a << 16), __builtin_bit_cast(float, a & 0xffff0000u), __builtin_bit_cast(float, b << 16), __builtin_bit_cast(float, b & 0xffff0000u)}; }
__device__ __forceinline__ float wave_sum(float v) { return x32_add(x16_add(row16_sum(v))); }
__device__ __forceinline__ int sigma32(int i) { return 16 * ((i >> 2) & 1) + (i & 3) + 4 * (i >> 3); }
__device__ __forceinline__ int pi32(int i) { const int h = (i >> 2) & 1, r = (i & 3) + 4 * (i >> 3); return 16 * (r >> 3) + 8 * h + (r & 7); }
__device__ __forceinline__ bf16x8 mk8(u32x4 v) { return __builtin_bit_cast(bf16x8, v); }

#define XB_TMO      128
#define XB_XCNT(j)  (256  + 64 * (j))
#define XB_XSUB(j)  (1280 + 64 * (j))
#define XB_XGEN(j)  (2304 + 64 * (j))
#define XB_TOP      3328
#define XB_TOPGEN   3392
#define XCD_BAR_WORDS 3456
#define XB_SPIN_CAP (1u << 20)
__device__ __forceinline__ unsigned xb_ld(unsigned* p)              { return __hip_atomic_load(p, __ATOMIC_RELAXED, __HIP_MEMORY_SCOPE_AGENT); }
__device__ __forceinline__ unsigned xb_add(unsigned* p, unsigned v) { return __hip_atomic_fetch_add(p, v, __ATOMIC_RELAXED, __HIP_MEMORY_SCOPE_AGENT); }
__device__ __forceinline__ unsigned xb_xcc_id() { return (unsigned)__builtin_amdgcn_s_getreg((3 << 11) | 20) & 0xFu; }
#define XB_SPIN(cond, bar) do { unsigned _sp = 0; while (cond) { __builtin_amdgcn_s_sleep(1); \
    if ((++_sp & 255u) == 0u) { if (xb_ld(&(bar)[XB_TMO])) break; if (_sp > XB_SPIN_CAP) { atomicAdd(&(bar)[XB_TMO], 1u); break; } } } } while (0)
struct XcdBarrier { unsigned* bar; unsigned x; volatile LAS unsigned* st; };
__device__ __forceinline__ XcdBarrier xcd_barrier_post(unsigned* bar, volatile LAS unsigned* st) {
    XcdBarrier b; b.bar = bar; b.x = xb_xcc_id(); b.st = st;
    if (threadIdx.x == 0) (void)xb_add(&bar[XB_XCNT(b.x)], 1u);
    return b;
}
__device__ __forceinline__ void xcd_barrier_complete(unsigned* bar, unsigned x, unsigned& nloc, unsigned& nx) {
    const unsigned G = gridDim.x * gridDim.y * gridDim.z;
    unsigned sum, cnt, mine, sp = 0u;
    for (;;) {
        sum = 0u; cnt = 0u; mine = 0u;
#pragma unroll
        for (unsigned j = 0; j < 16; ++j) { const unsigned c = xb_ld(&bar[XB_XCNT(j)]); sum += c; cnt += (c > 0u) ? 1u : 0u; mine = (j == x) ? c : mine; }
        if (sum == G) break;
        __builtin_amdgcn_s_sleep(1);
        if ((++sp & 255u) == 0u) { if (xb_ld(&bar[XB_TMO])) break; if (sp > XB_SPIN_CAP) { atomicAdd(&bar[XB_TMO], 1u); break; } }
    }
    nloc = mine > 0u ? mine : 1u; nx = cnt > 0u ? cnt : 1u;
}
__device__ __noinline__ void xcd_barrier(const XcdBarrier b) {
    asm volatile("s_waitcnt vmcnt(0)" ::: "memory");
    __syncthreads();
    if (threadIdx.x == 0) {
        unsigned* bar = b.bar;
        __builtin_amdgcn_s_waitcnt(0);
        unsigned nloc = b.st[0], nx = b.st[1];
        if (nloc == 0u) { xcd_barrier_complete(bar, b.x, nloc, nx); b.st[0] = nloc; b.st[1] = nx; }
        const unsigned old = xb_add(&bar[XB_XSUB(b.x)], 1u);
        const unsigned gen = old / nloc;
        if (old + 1u == (gen + 1u) * nloc) {
            __builtin_amdgcn_fence(__ATOMIC_RELEASE, "agent");
            asm volatile("s_waitcnt vmcnt(0)" ::: "memory");
            const unsigned og = xb_add(&bar[XB_TOP], 1u);
            const unsigned tg = og / nx;
            if (og + 1u == (tg + 1u) * nx) xb_add(&bar[XB_TOPGEN], 1u);
            else XB_SPIN(xb_ld(&bar[XB_TOPGEN]) == tg, bar);
            __builtin_amdgcn_fence(__ATOMIC_ACQUIRE, "agent");
            xb_add(&bar[XB_XGEN(b.x)], 1u);
            asm volatile("s_waitcnt vmcnt(0)" ::: "memory");
        } else {
            XB_SPIN(xb_ld(&bar[XB_XGEN(b.x)]) == gen, bar);
            __builtin_amdgcn_fence(__ATOMIC_ACQUIRE, "agent");
            asm volatile("s_waitcnt vmcnt(0)" ::: "memory");
        }
    }
    __syncthreads();
}

struct Params { const float* in[24]; float* out; unsigned char* ws; };
enum { I_X = 0, I_N1G, I_WIN, I_GQA, I_WQB, I_GKVA, I_WKVB, I_GMLA, I_GSW, I_GDIL, I_SINKS, I_RELB, I_WGA, I_WGB, I_BG, I_WBR, I_WOUT, I_N2G,
       I_WGUD, I_WDD, I_WR, I_BR, I_WGUE, I_WDE };

struct Ctx {
    LAS unsigned char* lds;
    int tid, lane, wid, G, vcu, gw, NGW;
};
__device__ __forceinline__ unsigned char* launder_ptr(unsigned char* q) { size_t z = 0; asm volatile("" : "+s"(z)); return q + z; }
__device__ __forceinline__ Ctx launder(const Ctx& c0) {
    Ctx c = c0; int t, w = c0.wid;
    asm volatile("" : "+s"(w));
    asm volatile("v_mbcnt_lo_u32_b32 %0, -1, 0\n\tv_mbcnt_hi_u32_b32 %0, -1, %0" : "=v"(t));
    __builtin_assume(t >= 0 && t < 64); __builtin_assume(w >= 0 && w < 8);
    c.lane = t; c.tid = (w << 6) | t; c.wid = w; c.gw = (int)blockIdx.x * 8 + w;
    return c;
}

__device__ __forceinline__ int inproj_map(int c) {
    if (c < 1280) return c;
    if (c < 1312) return PC_KPE + (c - 1280);
    if (c < 1568) return PC_SWQ + (c - 1312);
    if (c < 1632) return PC_SWK + (c - 1568);
    if (c < 1696) return PC_SWV + (c - 1632);
    return PC_DQ + (c - 1696);
}
struct ItemRegs { f32x4 v[8]; float ks[8]; };
struct ItemInfo { bf16_t* WT; int ldt, dst, k0; float scale; };
__device__ __forceinline__ void item_load(const LAS unsigned* JT, int id, int& j, int lane, ItemRegs& r, ItemInfo& inf) {
    while (id >= (int)JT[(j + 1) * 12 + 11]) ++j;
    const LAS unsigned* e = JT + j * 12;
    const float* W = (const float*)(((unsigned long long)e[1] << 32) | e[0]);
    inf.WT = (bf16_t*)(((unsigned long long)e[3] << 32) | e[2]);
    const float* ks = (const float*)(((unsigned long long)e[5] << 32) | e[4]);
    const int ldw = (int)e[6], N = (int)e[8], mode = (int)(e[10] & 255u), add = (int)(e[10] >> 8);
    inf.ldt = (int)e[9];
    const int it = id - (int)e[11], nblk = N / 32, kb = it / nblk, nb = it % nblk, cc0 = nb * 32;
    float scale = 1.f; int dst;
    if (mode == 0) dst = cc0 + add;
    else if (mode == 3) { dst = cc0 + add; scale = -LOG2E; }
    else if (mode == 1) { dst = inproj_map(cc0); if (cc0 < 256) scale = 0.125f * LOG2E; }
    else { const int half = N / 2; const int isu = cc0 >= half ? 1 : 0; const int cc = cc0 - isu * half; dst = 256 * (cc / 128) + 128 * isu + (cc % 128); }
    inf.dst = dst; inf.k0 = kb * 64; inf.scale = scale;
#pragma unroll
    for (int i = 0; i < 8; ++i) { const int kk = kb * 64 + (lane >> 3) + 8 * i; r.v[i] = *(const f32x4*)(W + (size_t)kk * ldw + cc0 + 4 * (lane & 7)); r.ks[i] = ks ? ks[kk] : 1.f; }
}
__device__ __forceinline__ void item_finish(const ItemRegs& r, const ItemInfo& inf, LAS float* scr, int lane) {
#pragma unroll
    for (int i = 0; i < 8; ++i) { const int kk = (lane >> 3) + 8 * i; const float sc = inf.scale * r.ks[i];
        LAS float* d = scr + kk * 33 + 4 * (lane & 7); d[0] = r.v[i].x * sc; d[1] = r.v[i].y * sc; d[2] = r.v[i].z * sc; d[3] = r.v[i].w * sc; }
    asm volatile("s_waitcnt lgkmcnt(0)" ::: "memory");
    const int c = lane & 7;
#pragma unroll
    for (int j = 0; j < 4; ++j) { const int n = (lane >> 3) + 8 * j; const LAS float* sp = scr + (8 * c) * 33 + n;
        u32x4 o; o.x = pk2(sp[0 * 33], sp[1 * 33]); o.y = pk2(sp[2 * 33], sp[3 * 33]); o.z = pk2(sp[4 * 33], sp[5 * 33]); o.w = pk2(sp[6 * 33], sp[7 * 33]);
        *(u32x4*)(inf.WT + (size_t)(inf.dst + n) * inf.ldt + inf.k0 + 8 * c) = o; }
    asm volatile("s_waitcnt lgkmcnt(0)" ::: "memory");
}
__device__ __forceinline__ int t5_bucket(int d) {
    if (d < 16) return d;
    int b = 16 + (int)(__log2f((float)d * (1.f / 16.f)) * (16.f / 7.f));
    return b > 31 ? 31 : b;
}
__device__ __forceinline__ void prologue(const Params& p, const Ctx& c0) {
    const Ctx c = launder(c0);
    unsigned char* ws = launder_ptr(p.ws);
    LAS float* scr = (LAS float*)(c.lds + c.wid * 16384);
    LAS unsigned* JT = (LAS unsigned*)(c.lds + 131072);
    if (c.tid == 0) {
        int nj = 0, first = 0;
#define JOB(W, ldw, K, N, WT, ldt, mode, add, ks) do { LAS unsigned* e_ = JT + nj * 12; const unsigned long long w_ = (unsigned long long)(W), t_ = (unsigned long long)(WT), k_ = (unsigned long long)(ks); \
        e_[0] = (unsigned)w_; e_[1] = (unsigned)(w_ >> 32); e_[2] = (unsigned)t_; e_[3] = (unsigned)(t_ >> 32); e_[4] = (unsigned)k_; e_[5] = (unsigned)(k_ >> 32); \
        e_[6] = (unsigned)(ldw); e_[7] = (unsigned)(K); e_[8] = (unsigned)(N); e_[9] = (unsigned)(ldt); e_[10] = (unsigned)(mode) | ((unsigned)(add) << 8); e_[11] = (unsigned)first; \
        first += ((K) / 64) * ((N) / 32); ++nj; } while (0)
        for (int l = 0; l < 2; ++l) {
            bf16_t* win = (bf16_t*)(ws + WS_WIN) + (size_t)l * PW * 1024;
            JOB(p.in[I_WIN] + (size_t)l * 1024 * 2848, 2848, 1024, 2848, win, 1024, 1, 0, (const float*)nullptr);
            JOB(p.in[I_WGA] + (size_t)l * 1024 * 128, 128, 1024, 128, win, 1024, 0, PC_GLOW, (const float*)nullptr);
            JOB(p.in[I_WQB] + (size_t)l * 256 * 384, 384, 256, 384, (bf16_t*)(ws + WS_WQ) + (size_t)l * 512 * 256, 256, 0, 0, p.in[I_GQA] + l * 256);
            JOB(p.in[I_WKVB] + (size_t)l * 256 * 512, 512, 256, 512, (bf16_t*)(ws + WS_WKV) + (size_t)l * 512 * 256, 256, 0, 0, p.in[I_GKVA] + l * 256);
            JOB(p.in[I_WGB] + (size_t)l * 128 * 4096, 4096, 128, 4096, (bf16_t*)(ws + WS_WGB) + (size_t)l * 4096 * 128, 128, 3, 0, (const float*)nullptr);
            bf16_t* wbr = (bf16_t*)(ws + WS_WBR) + (size_t)l * 1024 * 1024;
            const float* wb = p.in[I_WBR] + (size_t)l * 896 * 1024;
            JOB(wb, 1024, 256, 1024, wbr, 256, 0, 0, (const float*)nullptr);
            JOB(wb + (size_t)256 * 1024, 1024, 256, 1024, wbr + 1024 * 256, 256, 0, 0, (const float*)nullptr);
            JOB(wb + (size_t)512 * 1024, 1024, 256, 1024, wbr + 2 * 1024 * 256, 256, 0, 0, (const float*)nullptr);
            JOB(wb + (size_t)768 * 1024, 1024, 128, 1024, wbr + 3 * 1024 * 256, 128, 0, 0, (const float*)nullptr);
            JOB(p.in[I_WOUT] + (size_t)l * 1024 * 1024, 1024, 1024, 1024, (bf16_t*)(ws + WS_WOUT) + (size_t)l * 1024 * 1024, 1024, 0, 0, (const float*)nullptr);
        }
        JOB(p.in[I_WGUD], 4096, 1024, 4096, (bf16_t*)(ws + WS_WGUD), 1024, 2, 0, (const float*)nullptr);
        JOB(p.in[I_WDD], 1024, 2048, 1024, (bf16_t*)(ws + WS_WDD), 2048, 0, 0, (const float*)nullptr);
        for (int e = 0; e < 8; ++e) {
            JOB(p.in[I_WGUE] + (size_t)e * 1024 * 1536, 1536, 1024, 1536, (bf16_t*)(ws + WS_WGUE) + (size_t)e * 1536 * 1024, 1024, 2, 0, (const float*)nullptr);
            JOB(p.in[I_WDE] + (size_t)e * 768 * 1024, 1024, 768, 1024, (bf16_t*)(ws + WS_WDE) + (size_t)e * 1024 * 768, 768, 0, 0, (const float*)nullptr);
        }
#undef JOB
        JT[nj * 12 + 11] = (unsigned)first;
        JT[1023] = (unsigned)nj;
    }
    __syncthreads();
    {
        const int nj = (int)JT[1023], total = (int)JT[nj * 12 + 11];
        const int lo = (int)(((long long)c.gw * total) / c.NGW), hi = (int)(((long long)(c.gw + 1) * total) / c.NGW);
        int j = 0; ItemRegs ra, rb; ItemInfo ia, ib;
        if (lo < hi) item_load(JT, lo, j, c.lane, ra, ia);
        for (int id = lo; id < hi; ++id) {
            if (id + 1 < hi) item_load(JT, id + 1, j, c.lane, rb, ib);
            item_finish(ra, ia, scr, c.lane);
            ra = rb; ia = ib;
        }
    }
    __syncthreads();
    const int gt = c.gw * 64 + c.lane, NGT = c.NGW * 64;
    for (int l = 0; l < 2; ++l) {
        u32x4* z = (u32x4*)((bf16_t*)(ws + WS_WIN) + (size_t)l * PW * 1024 + (size_t)2976 * 1024);
        for (int i = gt; i < 96 * 1024 / 8; i += NGT) z[i] = (u32x4){0u, 0u, 0u, 0u};
        u32x4* z2 = (u32x4*)((bf16_t*)(ws + WS_WQ) + (size_t)l * 512 * 256 + (size_t)384 * 256);
        for (int i = gt; i < 128 * 256 / 8; i += NGT) z2[i] = (u32x4){0u, 0u, 0u, 0u};
    }
    {
        f32x2* rt = (f32x2*)(ws + WS_ROPE);
        for (int i = gt; i < SEQ * 16; i += NGT) {
            const int pos = i >> 4, j = i & 15;
            const double c4 = (j & 3) == 0 ? 1.0 : ((j & 3) == 1 ? 0.56234132519034908 : ((j & 3) == 2 ? 0.31622776601683794 : 0.17782794100389228));
            const double d4 = (j >> 2) == 0 ? 1.0 : ((j >> 2) == 1 ? 0.1 : ((j >> 2) == 2 ? 0.01 : 0.001));
            const float inv = (float)(c4 * d4);
            const float ang = (float)pos * inv;
            const double rev = (double)ang * 0.15915494309189535;
            const float fr = (float)(rev - rint(rev));
            rt[i] = (f32x2){__builtin_amdgcn_cosf(fr), __builtin_amdgcn_sinf(fr)};
        }
    }
    {
        float* bt = (float*)(ws + WS_TAB);
        for (int i = gt; i < 20 * 132; i += NGT) {
            const int hd = i / 132, d = i % 132;
            const int dil = hd < 8 ? 1 : (hd < 12 ? 1 : (hd < 16 ? 4 : 16));
            bt[i] = p.in[I_RELB][t5_bucket(d * dil) * 20 + hd] * LOG2E;
        }
        float* bn = bt + 20 * 132 + 256;
        for (int i = gt; i < 2 * 4096; i += NGT) bn[i] = -p.in[I_BG][i] * LOG2E;
        float* gt_ = bt + 20 * 132;
        for (int i = gt; i < 2 * 4 * 32; i += NGT) {
            const int l = i >> 7, t = (i >> 5) & 3, j = i & 31;
            const float sc = 0.17677669529663687f * LOG2E;
            float v;
            if (t == 0) v = p.in[I_GSW][l * 64 + j] * sc; else if (t == 1) v = p.in[I_GSW][l * 64 + 32 + j];
            else if (t == 2) v = p.in[I_GDIL][l * 64 + j] * sc; else v = p.in[I_GDIL][l * 64 + 32 + j];
            gt_[i] = v;
        }
    }
}

template <bool ROUTE>
__device__ __forceinline__ void rmsnorm_phase(const Params& p, const Ctx& c0, const void* xv, int x_f32, const float* g, bf16_t* h, const float* wr, const float* br) {
    const Ctx c = launder(c0);
    unsigned char* const wsl = launder_ptr(p.ws);
    const int lane = c.lane;
    f32x4 gv[4];
#pragma unroll
    for (int j = 0; j < 4; ++j) gv[j] = *(const f32x4*)(g + 4 * lane + 256 * j);
    f32x4 wv[ROUTE ? 32 : 1];
    if (ROUTE) {
#pragma unroll
        for (int j = 0; j < 4; ++j)
#pragma unroll
            for (int cc = 0; cc < 4; ++cc) { const float* w = wr + (size_t)(4 * lane + 256 * j + cc) * 8; wv[(j * 4 + cc) * 2] = *(const f32x4*)w; wv[(j * 4 + cc) * 2 + 1] = *(const f32x4*)(w + 4); }
    }
    int* mtok = (int*)(wsl + WS_MTOK); float* mw = (float*)(wsl + WS_MW); unsigned* ctl = (unsigned*)(wsl + WS_CTL);
    int my_tok = 0, my_e0 = 0, my_e1 = 0; float my_w0 = 0.f, my_w1 = 0.f; int nmine = 0;
    const bool wg_agg = ROUTE && (NTOK % c.NGW) == 0 && (NTOK / c.NGW) <= 64;
    LAS unsigned* rcnt = (LAS unsigned*)c.lds;
#define ROUTE_FLUSH(WG) do { \
        const bool act = lane < nmine; \
        unsigned cntv = 0; int pos0 = 0, pos1 = 0; \
        _Pragma("unroll") for (int k = 0; k < 2; ++k) { \
            const int me = k == 0 ? my_e0 : my_e1; \
            _Pragma("unroll") for (int e = 0; e < 8; ++e) { \
                const unsigned long long mask = __ballot(act && me == e); \
                if (lane == k * 8 + e) cntv = (unsigned)__popcll(mask); \
                if (me == e) { const int r = __popcll(mask & ((1ull << lane) - 1ull)); if (k == 0) pos0 = r; else pos1 = r; } } } \
        unsigned base = 0; \
        if (WG) { \
            if (lane < 16) rcnt[c.wid * 16 + lane] = cntv; \
            __syncthreads(); \
            if (c.wid == 0 && lane < 16) { \
                unsigned tot = 0; \
                _Pragma("unroll") for (int w = 0; w < 8; ++w) tot += rcnt[w * 16 + lane]; \
                unsigned wb = 0; \
                if (tot) wb = __hip_atomic_fetch_add(ctl + CW_MOE + 64 * lane, tot, __ATOMIC_RELAXED, __HIP_MEMORY_SCOPE_AGENT); \
                rcnt[128 + lane] = wb; } \
            __syncthreads(); \
            if (lane < 16) { base = rcnt[128 + lane]; for (int w = 0; w < c.wid; ++w) base += rcnt[w * 16 + lane]; } \
        } else { \
            if (lane < 16 && cntv) base = __hip_atomic_fetch_add(ctl + CW_MOE + 64 * lane, cntv, __ATOMIC_RELAXED, __HIP_MEMORY_SCOPE_AGENT); \
        } \
        const unsigned b0 = (unsigned)__builtin_amdgcn_ds_bpermute(my_e0 * 4, (int)base), b1 = (unsigned)__builtin_amdgcn_ds_bpermute((8 + my_e1) * 4, (int)base); \
        if (act) { \
            mtok[my_e0 * NTOK + b0 + pos0] = my_tok; mw[my_e0 * NTOK + b0 + pos0] = my_w0; \
            mtok[(8 + my_e1) * NTOK + b1 + pos1] = my_tok; mw[(8 + my_e1) * NTOK + b1 + pos1] = my_w1; } \
    } while (0)
    const float* x = (const float*)xv; const bf16_t* xb = (const bf16_t*)xv;
#define RMS_LOAD(dst, row) do { if (x_f32) { _Pragma("unroll") for (int j = 0; j < 4; ++j) dst[j] = ((const f32x4*)(x + (size_t)(row) * DM) + lane)[64 * j]; } \
        else { _Pragma("unroll") for (int j = 0; j < 4; ++j) { const u32x2 w_ = ((const u32x2*)(xb + (size_t)(row) * DM) + lane)[64 * j]; dst[j] = unpk4(w_.x, w_.y); } } } while (0)
    f32x4 nv[4];
    if (c.gw < NTOK) RMS_LOAD(nv, c.gw);
    for (int m = c.gw; m < NTOK; m += c.NGW) {
        f32x4 v[4]; float s = 0.f;
#pragma unroll
        for (int j = 0; j < 4; ++j) v[j] = nv[j];
        if (m + c.NGW < NTOK) RMS_LOAD(nv, m + c.NGW);
#pragma unroll
        for (int j = 0; j < 4; ++j) s += (v[j].x * v[j].x + v[j].y * v[j].y) + (v[j].z * v[j].z + v[j].w * v[j].w);
        const float rs = __builtin_amdgcn_rsqf(wave_sum(s) * (1.f / DM) + EPS);
        unsigned long long* o8 = (unsigned long long*)(h + (size_t)m * DM) + lane;
#pragma unroll
        for (int j = 0; j < 4; ++j) { v[j] = v[j] * rs * gv[j]; o8[64 * j] = (unsigned long long)pk2(v[j].x, v[j].y) | ((unsigned long long)pk2(v[j].z, v[j].w) << 32); }
        if (ROUTE) {
            float lg[8];
#pragma unroll
            for (int e = 0; e < 8; ++e) lg[e] = 0.f;
#pragma unroll
            for (int j = 0; j < 4; ++j)
#pragma unroll
                for (int cc = 0; cc < 4; ++cc) { const float xv = v[j][cc]; const f32x4 a = wv[(j * 4 + cc) * 2], b = wv[(j * 4 + cc) * 2 + 1];
                    lg[0] += xv * a.x; lg[1] += xv * a.y; lg[2] += xv * a.z; lg[3] += xv * a.w; lg[4] += xv * b.x; lg[5] += xv * b.y; lg[6] += xv * b.z; lg[7] += xv * b.w; }
#pragma unroll
            for (int e = 0; e < 8; ++e) lg[e] = wave_sum(lg[e]) + br[e];
            int e0 = 0; float v0 = lg[0];
#pragma unroll
            for (int e = 1; e < 8; ++e) if (lg[e] > v0) { v0 = lg[e]; e0 = e; }
            int e1 = -1; float v1 = -3.0e38f;
#pragma unroll
            for (int e = 0; e < 8; ++e) if (e != e0 && lg[e] > v1) { v1 = lg[e]; e1 = e; }
            const float t = ex2((v1 - v0) * LOG2E);
            const float w0 = 1.f / (1.f + t), w1 = t / (1.f + t);
            if (lane == nmine) { my_tok = m; my_e0 = e0; my_e1 = e1; my_w0 = w0; my_w1 = w1; }
            ++nmine;
            if (nmine == 64 || (!wg_agg && m + c.NGW >= NTOK)) { ROUTE_FLUSH(false); nmine = 0; }
        }
    }
    if (ROUTE && wg_agg) { ROUTE_FLUSH(true); }
#undef ROUTE_FLUSH
}

constexpr int SLOT_BYTES = 24576, SLOT_BOFF = 8192, NSLOT = 6;
struct Unit { int pm, pn, e, sa, sb; };
#define DMA16(m0v, voff, rsrc, soff) asm volatile("s_mov_b32 m0, %0\n\ts_nop 0\n\tbuffer_load_dwordx4 %1, %2, %3 offen lds" :: "s"(m0v), "v"(voff), "s"(rsrc), "s"(soff) : "m0", "memory")

template <int BM>
struct SubFrags { bf16x8 xf[2][BM / 64], wf[2][2]; };
template <int BM>
__device__ __forceinline__ void ld_frags(const LAS unsigned char* sl, SubFrags<BM>& F, int ks, int wr, int wc, int r32, int hi) {
    constexpr int MB = BM / 64;
    const int s32 = sigma32(r32);
    const unsigned xrow = (unsigned)(wr * (BM / 2) + r32) * 64u, kx = (r32 >> 2) & 3;
    const unsigned wrow = SLOT_BOFF + (unsigned)(wc * 64 + s32) * 64u, kw = (s32 >> 2) & 3;
#pragma unroll
    for (int mb = 0; mb < MB; ++mb) F.xf[ks][mb] = *(const LAS bf16x8*)(sl + xrow + mb * 2048 + (((2 * ks + hi) ^ kx) << 4));
#pragma unroll
    for (int nb = 0; nb < 2; ++nb) F.wf[ks][nb] = *(const LAS bf16x8*)(sl + wrow + nb * 2048 + (((2 * ks + hi) ^ kw) << 4));
}
template <int BM>
__device__ __forceinline__ void mma_sub_pipe(const LAS unsigned char* nxt, SubFrags<BM>& F, f32x16 (&acc)[BM / 64][2], int wr, int wc, int r32, int hi) {
    constexpr int MB = BM / 64;
#pragma unroll
    for (int ks = 0; ks < 2; ++ks) {
        __builtin_amdgcn_s_setprio(1);
#pragma unroll
        for (int mb = 0; mb < MB; ++mb)
#pragma unroll
            for (int nb = 0; nb < 2; ++nb) acc[mb][nb] = __builtin_amdgcn_mfma_f32_32x32x16_bf16(F.wf[ks][nb], F.xf[ks][mb], acc[mb][nb], 0, 0, 0);
        __builtin_amdgcn_s_setprio(0);
        __builtin_amdgcn_sched_barrier(0);
        ld_frags<BM>(nxt, F, ks, wr, wc, r32, hi);
        __builtin_amdgcn_sched_barrier(0);
    }
}

namespace pg8 {
constexpr int HALF = 128, HTB = HALF * 64 * 2;
__device__ __forceinline__ int lds_byte(int r, int c) { const int st = (r >> 4) * 2 + (c >> 5), rr = r & 15, cc = c & 31, ob = rr * 64 + cc * 2; return st * 1024 + (ob ^ (((ob >> 9) & 1) << 5)); }
__device__ __forceinline__ void stage_rc(int b, int& R, int& C) { const int st = b / 1024, sb = b % 1024, swz = sb ^ (((sb >> 9) & 1) << 5); R = (st >> 1) * 16 + swz / 64; C = (st & 1) * 32 + (swz % 64) / 2; }
__device__ __forceinline__ int perm32(int rho) { const int n = rho >> 4, i = rho & 15; return 8 * (i >> 2) + 4 * n + (i & 3); }

__device__ __forceinline__ const char* uni_ptr(const char* q) {
    const unsigned long long v = (unsigned long long)q;
    const unsigned lo = (unsigned)__builtin_amdgcn_readfirstlane((int)(unsigned)v), hi = (unsigned)__builtin_amdgcn_readfirstlane((int)(unsigned)(v >> 32));
    return (const char*)(((unsigned long long)hi << 32) | lo);
}
template <class Epi, class Sched, bool ALIGN_EPI, int SUB = 0>
__device__ __forceinline__ void gemm_phase(const Ctx& c0, const char* Abase, int K, const Sched& S, const Epi& E) {
    const Ctx c = launder(c0);
    LAS unsigned char* lds = c.lds + LDS_STAGE;
    const int tid = c.tid, wid = c.wid, lane = c.lane, wr = wid >> 2, wc = wid & 3, fr = lane & 15, fq = lane >> 4;
    int nt = K / 64; asm volatile("" : "+s"(nt));
    int R[2], C[2]; unsigned voffB[2];
#pragma unroll
    for (int i = 0; i < 2; ++i) { stage_rc(tid * 16 + i * 8192, R[i], C[i]); const int Rb = (R[i] & ~31) + perm32(R[i] & 31); voffB[i] = (unsigned)(Rb * S.ldb2 + C[i] * 2); }
    const size_t kstep = 128;
    const size_t hstepB = (size_t)HALF * S.ldb2;
    const unsigned ldsw = (unsigned)wid * 1024u;
    const int aoff = lds_byte(wr * 64 + fr, fq * 8), boff = lds_byte(wc * 32 + fr, fq * 8);
#define PG8_SA(b, h) (((b) * 2 + (h)) * HTB)
#define PG8_SB(b, h) ((4 + (b) * 2 + (h)) * HTB)
#define PG8_STAGE(bufoff, gbase, voff) do { const char* gb_ = (const char*)(gbase); asm volatile("" : "+s"(gb_));     \
        _Pragma("unroll") for (int _i = 0; _i < 2; ++_i) { unsigned vo_ = (voff)[_i]; asm volatile("" : "+v"(vo_)); \
        __builtin_amdgcn_global_load_lds((const unsigned*)(gb_ + vo_), (LAS unsigned*)(lds + (bufoff) + ldsw + _i * 8192), 16, 0, 0); } } while (0)
#define PG8_LDA(dst, b, h) do { _Pragma("unroll") for (int m = 0; m < 4; ++m) _Pragma("unroll") for (int k = 0; k < 2; ++k) dst[m][k] = *(const LAS bf16x8*)(lds + PG8_SA(b, h) + aoff + m * 2048 + k * 1024); } while (0)
#define PG8_LDB(dst, b, h) do { _Pragma("unroll") for (int n = 0; n < 2; ++n) _Pragma("unroll") for (int k = 0; k < 2; ++k) dst[n][k] = *(const LAS bf16x8*)(lds + PG8_SB(b, h) + boff + n * 2048 + k * 1024); } while (0)
#define PG8_MMA(ai, bj, At, Bt) do { __builtin_amdgcn_s_setprio(1); _Pragma("unroll") for (int m = 0; m < 4; ++m) _Pragma("unroll") for (int n = 0; n < 2; ++n) _Pragma("unroll") for (int k = 0; k < 2; ++k) \
        acc[ai][bj][m][n] = __builtin_amdgcn_mfma_f32_16x16x32_bf16(Bt[n][k], At[m][k], acc[ai][bj][m][n], 0, 0, 0); __builtin_amdgcn_s_setprio(0); } while (0)
#define PG8_WAIT_V(n) asm volatile("s_waitcnt vmcnt(" #n ")" ::: "memory")
#define PG8_WAIT_L(n) asm volatile("s_waitcnt lgkmcnt(" #n ")" ::: "memory")
#define PG8_BAR __builtin_amdgcn_s_barrier()
#define PG8_SCHED __builtin_amdgcn_sched_barrier(0)
    constexpr bool AFF = Sched::AFFINE;
    unsigned voffA[2] = {0u, 0u}; size_t hstepA = 0;
    if constexpr (AFF) {
#pragma unroll
        for (int i = 0; i < 2; ++i) voffA[i] = (unsigned)(R[i] * S.lda2 + C[i] * 2);
        hstepA = (size_t)HALF * S.lda2;
    }
#define PG8_STA(bufoff, abase, h, vv) do { if constexpr (AFF) PG8_STAGE(bufoff, (abase) + (h) * hstepA, voffA); else PG8_STAGE(bufoff, abase, (vv)[h]); } while (0)
    Unit cur, nxt; int ui = 0;
    if (!S.next(0, cur)) return;
    f32x4 acc[2][2][4][2];
    if constexpr (SUB == 0) E.init(acc, cur, wr, wc, fr, fq);
    else E.template init_sub<SUB>(acc, cur, wr, wc, fr, fq);
    bf16x8 At[4][2], B0[2][2], B1[2][2];
    unsigned vA[2][2] = {{0u, 0u}, {0u, 0u}}, vAn[2][2] = {{0u, 0u}, {0u, 0u}};
    const char* uA = Abase;
    if constexpr (AFF) uA = Abase + S.a_unit_off(cur) + (SUB ? (size_t)cur.sa * hstepA : (size_t)0); else S.a_offs(cur, R, C, vA);
    const char* cB = S.b_ptr(cur) + (SUB == 2 ? (size_t)cur.sb * hstepB : (size_t)0);
    PG8_STAGE(PG8_SB(0, 0), cB, voffB); PG8_STAGE(PG8_SB(0, 1), cB + hstepB, voffB); PG8_STA(PG8_SA(0, 0), uA, 0, vA); PG8_STA(PG8_SA(0, 1), uA, 1, vA);
    if (wr == 1) PG8_BAR;
    PG8_WAIT_V(2); PG8_BAR;
    PG8_STAGE(PG8_SB(1, 0), cB + kstep, voffB); PG8_STA(PG8_SA(1, 0), uA + kstep, 0, vA); PG8_STAGE(PG8_SB(1, 1), cB + hstepB + kstep, voffB);
    PG8_WAIT_V(6); PG8_BAR;
#define PG8_WAIT_N(n) asm volatile("s_waitcnt vmcnt(%0)" :: "n"(n) : "memory")
#define PG8_WAIT_R() do { if (rlx) PG8_WAIT_N(NS + 8); else PG8_WAIT_N(8); } while (0)
    constexpr int NS = SUB ? 0 : Epi::NSTORE;
    for (;;) {
        const bool has_next = S.next(ui + 1, nxt);
        const char* nuA = uA;
        if constexpr (AFF) { if (has_next) nuA = Abase + S.a_unit_off(nxt) + (SUB ? (size_t)nxt.sa * hstepA : (size_t)0); }
        else {
            if (has_next) { int td = tid; asm volatile("" : "+v"(td)); int R2[2], C2[2]; stage_rc(td * 16, R2[0], C2[0]); stage_rc(td * 16 + 8192, R2[1], C2[1]); S.a_offs(nxt, R2, C2, vAn); }
            else {
#pragma unroll
                for (int h = 0; h < 2; ++h) { vAn[h][0] = vA[h][0]; vAn[h][1] = vA[h][1]; }
            }
        }
        const char* nB = has_next ? S.b_ptr(nxt) + (SUB == 2 ? (size_t)nxt.sb * hstepB : (size_t)0) : cB;
        for (int t = 0; t < nt; t += 2) {
            const bool last = (t == nt - 2);
            const bool rlx = NS > 0 && t == 0 && ui > 0;
            const char* a1 = uA + (size_t)(t + 1) * kstep;
            const char* a2 = last ? nuA : uA + (size_t)(t + 2) * kstep; const char* b2 = last ? nB : cB + (size_t)(t + 2) * kstep;
            const char* a3 = a2 + kstep; const char* b3 = b2 + kstep;
            unsigned va2[2][2] = {{0u, 0u}, {0u, 0u}};
            if constexpr (!AFF) {
#pragma unroll
                for (int h = 0; h < 2; ++h) { va2[h][0] = last ? vAn[h][0] : vA[h][0]; va2[h][1] = last ? vAn[h][1] : vA[h][1]; }
            }
            PG8_LDB(B0, 0, 0); if constexpr (SUB < 2) PG8_LDB(B1, 0, 1); PG8_SCHED; PG8_LDA(At, 0, 0); if (NS == 0 || t > 0 || ui == 0) PG8_STA(PG8_SA(1, 1), a1, 1, vA);
            PG8_WAIT_R(); PG8_WAIT_L(0); PG8_BAR; PG8_MMA(0, 0, At, B0); if constexpr (SUB < 2) PG8_MMA(0, 1, At, B1); PG8_BAR; PG8_SCHED;
            if constexpr (SUB == 0) PG8_LDA(At, 0, 1); PG8_STAGE(PG8_SB(0, 0), b2, voffB); PG8_STAGE(PG8_SB(0, 1), b2 + hstepB, voffB); PG8_STA(PG8_SA(0, 0), a2, 0, va2);
            PG8_WAIT_R(); PG8_WAIT_L(0); PG8_BAR; if constexpr (SUB == 0) { PG8_MMA(1, 0, At, B0); PG8_MMA(1, 1, At, B1); } PG8_BAR; PG8_SCHED;
            PG8_LDB(B0, 1, 0); if constexpr (SUB < 2) PG8_LDB(B1, 1, 1); PG8_SCHED; PG8_LDA(At, 1, 0); PG8_STA(PG8_SA(0, 1), a2, 1, va2);
            PG8_WAIT_R(); PG8_WAIT_L(0); PG8_BAR; PG8_MMA(0, 0, At, B0); if constexpr (SUB < 2) PG8_MMA(0, 1, At, B1); PG8_BAR; PG8_SCHED;
            if constexpr (SUB == 0) PG8_LDA(At, 1, 1); PG8_STAGE(PG8_SB(1, 0), b3, voffB); PG8_STAGE(PG8_SB(1, 1), b3 + hstepB, voffB); PG8_STA(PG8_SA(1, 0), a3, 0, va2);
            PG8_WAIT_V(8); PG8_WAIT_L(0); PG8_BAR; if constexpr (SUB == 0) { PG8_MMA(1, 0, At, B0); PG8_MMA(1, 1, At, B1); } PG8_BAR; PG8_SCHED;
        }
        if constexpr (ALIGN_EPI) { if (wr == 0) PG8_BAR; }
        if (NS > 0) PG8_STA(PG8_SA(1, 1), nuA + kstep, 1, vAn);
        int ln = tid; asm volatile("" : "+v"(ln)); ln &= 63;
        if constexpr (SUB == 0) E(acc, cur, wr, wc, ln & 15, ln >> 4); else E.template run_sub<SUB>(acc, cur, wr, wc, ln & 15, ln >> 4);
        if (!has_next) break;
        if constexpr (SUB == 0) E.init(acc, nxt, wr, wc, ln & 15, ln >> 4); else E.template init_sub<SUB>(acc, nxt, wr, wc, ln & 15, ln >> 4);
        cur = nxt; cB = nB; uA = nuA; ++ui;
        if constexpr (!AFF) {
#pragma unroll
            for (int h = 0; h < 2; ++h) { vA[h][0] = vAn[h][0]; vA[h][1] = vAn[h][1]; }
        }
        if constexpr (ALIGN_EPI) { if (wr == 1) PG8_BAR; }
    }
    PG8_WAIT_V(0);
    if constexpr (!ALIGN_EPI) { if (wr == 0) PG8_BAR; }
    PG8_BAR;
#undef PG8_SA
#undef PG8_SB
#undef PG8_STAGE
#undef PG8_STA
#undef PG8_LDA
#undef PG8_LDB
#undef PG8_MMA
#undef PG8_WAIT_V
#undef PG8_WAIT_L
#undef PG8_BAR
#undef PG8_SCHED
#undef PG8_WAIT_R
#undef PG8_WAIT_N
}

__device__ __forceinline__ u32x4 pack8(const f32x4& a, const f32x4& b) { u32x4 w; w.x = pk2(a[0], a[1]); w.y = pk2(a[2], a[3]); w.z = pk2(b[0], b[1]); w.w = pk2(b[2], b[3]); return w; }

struct SchedPlain {
    static constexpr bool AFFINE = true;
    const char* Bt; int lda2, ldb2; int nM, nN, G, c;
    __device__ __forceinline__ size_t a_unit_off(const Unit& u) const { return (size_t)u.pm * 256 * lda2; }
    __device__ __forceinline__ bool next(int i, Unit& u) const {
        const int L = i * G + c; if (L >= nM * nN) return false;
        const int nig = 8 * nN, gid = L / nig, fm = gid * 8, wi = L % nig; int gsz = nM - fm; gsz = gsz < 8 ? gsz : 8;
        u.pm = fm + wi % gsz; u.pn = wi / gsz; u.e = 0; u.sa = 0; u.sb = 0; return true;
    }
    __device__ __forceinline__ void a_offs(const Unit& u, const int (&R)[2], const int (&C)[2], unsigned (&v)[2][2]) const {
#pragma unroll
        for (int h = 0; h < 2; ++h)
#pragma unroll
            for (int i = 0; i < 2; ++i) v[h][i] = (unsigned)(u.pm * 256 + h * 128 + R[i]) * (unsigned)lda2 + (unsigned)(C[i] * 2);
    }
    __device__ __forceinline__ const char* b_ptr(const Unit& u) const { return Bt + (size_t)u.pn * 256 * ldb2; }
};

struct EpiInProj {
    static constexpr int NSTORE = 16;
    bf16_t* O; const float* gtab;
    __device__ __forceinline__ void init(f32x4 (&acc)[2][2][4][2], const Unit&, int, int, int, int) const {
#pragma unroll
        for (int a = 0; a < 2; ++a)
#pragma unroll
            for (int b = 0; b < 2; ++b)
#pragma unroll
                for (int m = 0; m < 4; ++m)
#pragma unroll
                    for (int n = 0; n < 2; ++n) acc[a][b][m][n] = (f32x4){0.f, 0.f, 0.f, 0.f};
    }
    __device__ __forceinline__ void operator()(const f32x4 (&acc)[2][2][4][2], const Unit& u, int wr, int wc, int fr, int fq) const {
#pragma unroll
        for (int bj = 0; bj < 2; ++bj) {
            const int col = u.pn * 256 + bj * 128 + wc * 32, grp = col >> 5;
            int t = -1;
            if (grp >= 40 && grp < 48) t = 0; else if (grp >= 48 && grp < 50) t = 1; else if (grp >= 56 && grp < 68) t = 2; else if (grp >= 68 && grp < 80) t = 3;
            int sh = 0;
            if (grp >= 56 && grp < 92) { const int gg = ((grp - 56) % 12) >> 2; sh = 2 * gg; }
            const int smask = (1 << sh) - 1, sstr = SEQ >> sh;
            bf16_t* const Ob = O + col + 8 * fq;
            const int row0 = u.pm * 256 + wr * 64 + fr;
            if (t >= 0) {
                const f32x4 g0 = *(const f32x4*)(gtab + t * 32 + 8 * fq), g1 = *(const f32x4*)(gtab + t * 32 + 8 * fq + 4);
#pragma unroll
                for (int ai = 0; ai < 2; ++ai)
#pragma unroll
                    for (int m = 0; m < 4; ++m) {
                        f32x4 v0 = acc[ai][bj][m][0], v1 = acc[ai][bj][m][1];
                        float s = (v0[0] * v0[0] + v0[1] * v0[1]) + (v0[2] * v0[2] + v0[3] * v0[3]) + (v1[0] * v1[0] + v1[1] * v1[1]) + (v1[2] * v1[2] + v1[3] * v1[3]);
                        s = x32_add(x16_add(s));
                        const float rs = __builtin_amdgcn_rsqf(s * (1.f / 32.f) + EPS);
                        v0 = v0 * rs * g0; v1 = v1 * rs * g1;
                        const int row = row0 + ai * 128 + m * 16, sq = row & (SEQ - 1);
                        *(u32x4*)(Ob + (size_t)((row & ~(SEQ - 1)) + (sq & smask) * sstr + (sq >> sh)) * PW) = pack8(v0, v1);
                    }
            } else {
#pragma unroll
                for (int ai = 0; ai < 2; ++ai)
#pragma unroll
                    for (int m = 0; m < 4; ++m) {
                        const int row = row0 + ai * 128 + m * 16, sq = row & (SEQ - 1);
                        *(u32x4*)(Ob + (size_t)((row & ~(SEQ - 1)) + (sq & smask) * sstr + (sq >> sh)) * PW) = pack8(acc[ai][bj][m][0], acc[ai][bj][m][1]);
                    }
            }
        }
    }
};
struct EpiBf16 {
    static constexpr int NSTORE = 16;
    bf16_t* O; int ldo; int coff;
    __device__ __forceinline__ void init(f32x4 (&acc)[2][2][4][2], const Unit&, int, int, int, int) const {
#pragma unroll
        for (int a = 0; a < 2; ++a)
#pragma unroll
            for (int b = 0; b < 2; ++b)
#pragma unroll
                for (int m = 0; m < 4; ++m)
#pragma unroll
                    for (int n = 0; n < 2; ++n) acc[a][b][m][n] = (f32x4){0.f, 0.f, 0.f, 0.f};
    }
    __device__ __forceinline__ void operator()(const f32x4 (&acc)[2][2][4][2], const Unit& u, int wr, int wc, int fr, int fq) const {
#pragma unroll
        for (int ai = 0; ai < 2; ++ai)
#pragma unroll
            for (int m = 0; m < 4; ++m) {
                const int row = u.pm * 256 + ai * 128 + wr * 64 + m * 16 + fr;
#pragma unroll
                for (int bj = 0; bj < 2; ++bj) *(u32x4*)(O + (size_t)row * ldo + coff + u.pn * 256 + bj * 128 + wc * 32 + 8 * fq) = pack8(acc[ai][bj][m][0], acc[ai][bj][m][1]);
            }
    }
};
struct EpiResid {
    static constexpr int NSTORE = 16;
    const void* res; int res_f32; bf16_t* out;
    __device__ __forceinline__ void init(f32x4 (&acc)[2][2][4][2], const Unit& u, int wr, int wc, int fr, int fq) const {
        if (res_f32) {
            const float* rf = (const float*)res;
#pragma unroll
            for (int ai = 0; ai < 2; ++ai)
#pragma unroll
                for (int m = 0; m < 4; ++m) {
                    const int row = u.pm * 256 + ai * 128 + wr * 64 + m * 16 + fr;
#pragma unroll
                    for (int bj = 0; bj < 2; ++bj) {
                        const size_t o = (size_t)row * DM + u.pn * 256 + bj * 128 + wc * 32 + 8 * fq;
                        acc[ai][bj][m][0] = *(const f32x4*)(rf + o); acc[ai][bj][m][1] = *(const f32x4*)(rf + o + 4);
                    }
                }
        } else {
            const bf16_t* rb = (const bf16_t*)res;
#pragma unroll
            for (int ai = 0; ai < 2; ++ai)
#pragma unroll
                for (int m = 0; m < 4; ++m) {
                    const int row = u.pm * 256 + ai * 128 + wr * 64 + m * 16 + fr;
#pragma unroll
                    for (int bj = 0; bj < 2; ++bj) {
                        const u32x4 w = *(const u32x4*)(rb + (size_t)row * DM + u.pn * 256 + bj * 128 + wc * 32 + 8 * fq);
                        acc[ai][bj][m][0] = unpk4(w.x, w.y); acc[ai][bj][m][1] = unpk4(w.z, w.w);
                    }
                }
        }
    }
    __device__ __forceinline__ void operator()(const f32x4 (&acc)[2][2][4][2], const Unit& u, int wr, int wc, int fr, int fq) const {
#pragma unroll
        for (int ai = 0; ai < 2; ++ai)
#pragma unroll
            for (int m = 0; m < 4; ++m) {
                const int row = u.pm * 256 + ai * 128 + wr * 64 + m * 16 + fr;
#pragma unroll
                for (int bj = 0; bj < 2; ++bj)
                    *(u32x4*)(out + (size_t)row * DM + u.pn * 256 + bj * 128 + wc * 32 + 8 * fq) = pack8(acc[ai][bj][m][0], acc[ai][bj][m][1]);
            }
    }
};
struct EpiSwiglu {
    static constexpr int NSTORE = 8;
    bf16_t* O; int ldo;
    __device__ __forceinline__ void init(f32x4 (&acc)[2][2][4][2], const Unit&, int, int, int, int) const {
#pragma unroll
        for (int a = 0; a < 2; ++a)
#pragma unroll
            for (int b = 0; b < 2; ++b)
#pragma unroll
                for (int m = 0; m < 4; ++m)
#pragma unroll
                    for (int n = 0; n < 2; ++n) acc[a][b][m][n] = (f32x4){0.f, 0.f, 0.f, 0.f};
    }
    __device__ __forceinline__ void operator()(const f32x4 (&acc)[2][2][4][2], const Unit& u, int wr, int wc, int fr, int fq) const {
#pragma unroll
        for (int ai = 0; ai < 2; ++ai)
#pragma unroll
            for (int m = 0; m < 4; ++m) {
                f32x4 v[2];
#pragma unroll
                for (int n = 0; n < 2; ++n)
#pragma unroll
                    for (int q = 0; q < 4; ++q) { const float g = acc[ai][0][m][n][q], uu = acc[ai][1][m][n][q]; v[n][q] = g * uu * rcpf(1.f + ex2(-g * LOG2E)); }
                const int row = u.pm * 256 + ai * 128 + wr * 64 + m * 16 + fr;
                *(u32x4*)(O + (size_t)row * ldo + u.pn * 128 + wc * 32 + 8 * fq) = pack8(v[0], v[1]);
            }
    }
};

struct MoeInfo {
    int cnt[16], ts[17];
    __device__ __forceinline__ void load(const unsigned* ctl) {
        int s = 0;
#pragma unroll
        for (int g = 0; g < 16; ++g) { cnt[g] = (int)__builtin_amdgcn_readfirstlane(ctl[CW_MOE + 64 * g]); ts[g] = s; s += (cnt[g] + 255) >> 8; }
        ts[16] = s;
    }
    __device__ __forceinline__ void find(int rt, int& g, int& t0, int& n) const {
        g = 0; t0 = 0; n = cnt[0];
#pragma unroll
        for (int q = 1; q < 16; ++q) if (rt >= ts[q]) { g = q; t0 = ts[q]; n = cnt[q]; }
    }
};
struct SchedMoeUp {
    static constexpr bool AFFINE = false; static constexpr int lda2 = 0;
    MoeInfo mi; const char* W; const int* mtok; int ldb2; int G, c; int u0, nu, sh;
    __device__ __forceinline__ size_t a_unit_off(const Unit&) const { return 0; }
    __device__ __forceinline__ bool next(int i, Unit& u) const {
        const int nM = mi.ts[16], nN = 6; const int q = i * G + c; if (q >= (nu << sh)) return false;
        const int L = u0 + (q >> sh);
        const int nig = 8 * nN, gid = L / nig, fm = gid * 8, wi = L % nig; int gsz = nM - fm; gsz = gsz < 8 ? gsz : 8;
        u.pm = fm + wi % gsz; u.pn = wi / gsz; int g, t0, n; mi.find(u.pm, g, t0, n); u.e = g; u.sa = q & ((1 << sh) - 1); u.sb = 0; return true;
    }
    __device__ __forceinline__ void a_offs(const Unit& u, const int (&R)[2], const int (&C)[2], unsigned (&v)[2][2]) const {
        int g, t0, n; mi.find(u.pm, g, t0, n);
#pragma unroll
        for (int h = 0; h < 2; ++h)
#pragma unroll
            for (int i = 0; i < 2; ++i) { const int pos = (u.pm - t0) * 256 + (u.sa + h) * 128 + R[i]; const int tok = pos < n ? mtok[g * NTOK + pos] : 0; v[h][i] = (unsigned)tok * 2048u + (unsigned)(C[i] * 2); }
    }
    __device__ __forceinline__ const char* b_ptr(const Unit& u) const { return W + (size_t)(u.e & 7) * (1536 * 1024 * 2) + (size_t)u.pn * 256 * 2048; }
};
struct SchedMoeDown {
    static constexpr bool AFFINE = true; static constexpr int lda2 = 1536;
    MoeInfo mi; const char* W; int ldb2; int r0, nM, G, c; int u0, nu, sh;
    __device__ __forceinline__ size_t a_unit_off(const Unit& u) const { return (size_t)u.pm * 256 * 1536; }
    __device__ __forceinline__ bool next(int i, Unit& u) const {
        const int nN = 4; const int q = i * G + c; if (q >= (nu << sh)) return false;
        const int L = u0 + (q >> sh), sub = q & ((1 << sh) - 1);
        const int nig = 8 * nN, gid = L / nig, fm = gid * 8, wi = L % nig; int gsz = nM - fm; gsz = gsz < 8 ? gsz : 8;
        u.pm = r0 + fm + wi % gsz; u.pn = wi / gsz; int g, t0, n; mi.find(u.pm, g, t0, n); u.e = g;
        u.sa = sh == 2 ? (sub >> 1) : sub; u.sb = sh == 2 ? (sub & 1) : 0; return true;
    }
    __device__ __forceinline__ void a_offs(const Unit& u, const int (&R)[2], const int (&C)[2], unsigned (&v)[2][2]) const {
#pragma unroll
        for (int h = 0; h < 2; ++h)
#pragma unroll
            for (int i = 0; i < 2; ++i) v[h][i] = (unsigned)(u.pm * 256 + h * 128 + R[i]) * 1536u + (unsigned)(C[i] * 2);
    }
    __device__ __forceinline__ const char* b_ptr(const Unit& u) const { return W + (size_t)(u.e & 7) * (1024 * 768 * 2) + (size_t)u.pn * 256 * 1536; }
};
struct EpiSwigluMoe {
    static constexpr int NSTORE = 8;
    MoeInfo mi; bf16_t* O; const float* mw;
    template <int SUB>
    __device__ __forceinline__ void init_sub(f32x4 (&acc)[2][2][4][2], const Unit&, int, int, int, int) const {
#pragma unroll
        for (int a = 0; a < (SUB ? 1 : 2); ++a)
#pragma unroll
            for (int b = 0; b < 2; ++b)
#pragma unroll
                for (int m = 0; m < 4; ++m)
#pragma unroll
                    for (int n = 0; n < 2; ++n) acc[a][b][m][n] = (f32x4){0.f, 0.f, 0.f, 0.f};
    }
    template <int SUB>
    __device__ __forceinline__ void run_sub(const f32x4 (&acc)[2][2][4][2], const Unit& u, int wr, int wc, int fr, int fq) const {
        constexpr int NA = SUB ? 1 : 2;
        int g, t0, n; mi.find(u.pm, g, t0, n);
        float wv[NA][4];
#pragma unroll
        for (int ai = 0; ai < NA; ++ai)
#pragma unroll
            for (int m = 0; m < 4; ++m) { const int pos = (u.pm - t0) * 256 + (u.sa + ai) * 128 + wr * 64 + m * 16 + fr; wv[ai][m] = pos < n ? mw[g * NTOK + pos] : 0.f; }
#pragma unroll
        for (int ai = 0; ai < NA; ++ai)
#pragma unroll
            for (int m = 0; m < 4; ++m) {
                f32x4 v[2];
#pragma unroll
                for (int nn = 0; nn < 2; ++nn)
#pragma unroll
                    for (int q = 0; q < 4; ++q) { const float gg = acc[ai][0][m][nn][q], uu = acc[ai][1][m][nn][q]; v[nn][q] = wv[ai][m] * gg * uu * rcpf(1.f + ex2(-gg * LOG2E)); }
                const int row = u.pm * 256 + (u.sa + ai) * 128 + wr * 64 + m * 16 + fr;
                *(u32x4*)(O + (size_t)row * 768 + u.pn * 128 + wc * 32 + 8 * fq) = pack8(v[0], v[1]);
            }
    }
    __device__ __forceinline__ void init(f32x4 (&acc)[2][2][4][2], const Unit& u, int wr, int wc, int fr, int fq) const { init_sub<0>(acc, u, wr, wc, fr, fq); }
    __device__ __forceinline__ void operator()(const f32x4 (&acc)[2][2][4][2], const Unit& u, int wr, int wc, int fr, int fq) const { run_sub<0>(acc, u, wr, wc, fr, fq); }
};
struct EpiMoeDown {
    static constexpr int NSTORE = 0;
    MoeInfo mi; const bf16_t* src; void* dst; int dst_f32; const int* mtok;
    template <int SUB>
    __device__ __forceinline__ void init_sub(f32x4 (&acc)[2][2][4][2], const Unit& u, int wr, int wc, int fr, int fq) const {
        constexpr int NA = SUB ? 1 : 2, NB = SUB == 2 ? 1 : 2;
        int g, t0, n; mi.find(u.pm, g, t0, n);
#pragma unroll
        for (int ai = 0; ai < NA; ++ai)
#pragma unroll
            for (int m = 0; m < 4; ++m) {
                const int pos = (u.pm - t0) * 256 + (u.sa + ai) * 128 + wr * 64 + m * 16 + fr;
                const int tok = pos < n ? mtok[g * NTOK + pos] : -1;
#pragma unroll
                for (int bj = 0; bj < NB; ++bj) {
                    if (tok >= 0) { const u32x4 w = *(const u32x4*)(src + (size_t)tok * DM + u.pn * 256 + (u.sb + bj) * 128 + wc * 32 + 8 * fq); acc[ai][bj][m][0] = unpk4(w.x, w.y); acc[ai][bj][m][1] = unpk4(w.z, w.w); }
                    else { acc[ai][bj][m][0] = (f32x4){0.f, 0.f, 0.f, 0.f}; acc[ai][bj][m][1] = (f32x4){0.f, 0.f, 0.f, 0.f}; }
                }
            }
    }
    template <int SUB>
    __device__ __forceinline__ void run_sub(const f32x4 (&acc)[2][2][4][2], const Unit& u, int wr, int wc, int fr, int fq) const {
        constexpr int NA = SUB ? 1 : 2, NB = SUB == 2 ? 1 : 2;
        int g, t0, n; mi.find(u.pm, g, t0, n);
        int tk[NA][4];
#pragma unroll
        for (int ai = 0; ai < NA; ++ai)
#pragma unroll
            for (int m = 0; m < 4; ++m) { const int pos = (u.pm - t0) * 256 + (u.sa + ai) * 128 + wr * 64 + m * 16 + fr; tk[ai][m] = pos < n ? mtok[g * NTOK + pos] : -1; }
        if (dst_f32) {
            float* out = (float*)dst;
#pragma unroll
            for (int ai = 0; ai < NA; ++ai)
#pragma unroll
                for (int m = 0; m < 4; ++m) {
                    if (tk[ai][m] >= 0) {
#pragma unroll
                        for (int bj = 0; bj < NB; ++bj) {
                            const size_t o = (size_t)tk[ai][m] * DM + u.pn * 256 + (u.sb + bj) * 128 + wc * 32 + 8 * fq;
                            *(f32x4*)(out + o) = acc[ai][bj][m][0]; *(f32x4*)(out + o + 4) = acc[ai][bj][m][1];
                        }
                    }
                }
        } else {
            bf16_t* out = (bf16_t*)dst;
#pragma unroll
            for (int ai = 0; ai < NA; ++ai)
#pragma unroll
                for (int m = 0; m < 4; ++m) {
                    if (tk[ai][m] >= 0) {
#pragma unroll
                        for (int bj = 0; bj < NB; ++bj)
                            *(u32x4*)(out + (size_t)tk[ai][m] * DM + u.pn * 256 + (u.sb + bj) * 128 + wc * 32 + 8 * fq) = pack8(acc[ai][bj][m][0], acc[ai][bj][m][1]);
                    }
                }
        }
    }
    __device__ __forceinline__ void init(f32x4 (&acc)[2][2][4][2], const Unit& u, int wr, int wc, int fr, int fq) const { init_sub<0>(acc, u, wr, wc, fr, fq); }
    __device__ __forceinline__ void operator()(const f32x4 (&acc)[2][2][4][2], const Unit& u, int wr, int wc, int fr, int fq) const { run_sub<0>(acc, u, wr, wc, fr, fq); }
};
}

__device__ __forceinline__ void st16_bf16(bf16_t* p, const f32x16& v) {
    u32x4 a, b;
    a.x = pk2(v[0], v[1]); a.y = pk2(v[2], v[3]); a.z = pk2(v[4], v[5]); a.w = pk2(v[6], v[7]);
    b.x = pk2(v[8], v[9]); b.y = pk2(v[10], v[11]); b.z = pk2(v[12], v[13]); b.w = pk2(v[14], v[15]);
    *(u32x4*)p = a; *(u32x4*)(p + 8) = b;
}
__device__ __forceinline__ void merge_phase(const Params& p, const Ctx& c0, int l) {
    const Ctx c = launder(c0);
    unsigned char* const wsl = launder_ptr(p.ws);
    LAS unsigned char* lds = c.lds + LDS_STAGE;
    const int tid = c.tid, lane = c.lane, wid = c.wid, wr = wid >> 2, wc = wid & 3, fr = lane & 15, fq = lane >> 4;
    const float* bneg = (const float*)(wsl + WS_TAB) + 20 * 132 + 256 + l * 4096; bf16_t* Y = (bf16_t*)(wsl + WS_Y);
    constexpr int HTB = 16384, KTB = 3 * HTB;
    const int NU = 256 * 4;
    int R[2], C[2];
    unsigned vAg[2], vAb[2], vB1[2], vB2[2];
#pragma unroll
    for (int i = 0; i < 2; ++i) { pg8::stage_rc(tid * 16 + i * 8192, R[i], C[i]); const int Rb = (R[i] & ~31) + pg8::perm32(R[i] & 31);
        vAg[i] = (unsigned)(R[i] * (PW * 2) + C[i] * 2); vAb[i] = (unsigned)(R[i] * (AOW * 2) + C[i] * 2); vB1[i] = (unsigned)(Rb * 256 + C[i] * 2); vB2[i] = (unsigned)(Rb * 512 + C[i] * 2); }
    const char* pPG = (const char*)(wsl + WS_PROJ) + PC_GLOW * 2; const char* pAO = (const char*)(wsl + WS_AO);
    const char* pGB = (const char*)(wsl + WS_WGB) + (size_t)l * 4096 * 128 * 2; const char* pBR = (const char*)(wsl + WS_WBR) + (size_t)l * 1024 * 1024 * 2;
    const unsigned ldsw = (unsigned)wid * 1024u;
    const int aoff = pg8::lds_byte(wr * 64 + fr, fq * 8), boff = pg8::lds_byte(wc * 32 + fr, fq * 8);
#define UNIT_OF(i, pm, pn, ok) do { const int L_ = (i) * c.G + (int)blockIdx.x; ok = L_ < NU; if (ok) { const int gid_ = L_ / 32, wi_ = L_ % 32; pm = gid_ * 8 + wi_ % 8; pn = wi_ / 8; } } while (0)
    int pml = 0, pnl = 0, jl = 0, iul = 0, bl = 0; bool okl = false;
    UNIT_OF(0, pml, pnl, okl);
    if (!okl) return;
#define L_STAGE_ISSUE() do { const int i_ = jl < 18 ? jl / 6 : 3, jj_ = jl - 6 * i_, nkb_ = i_ < 3 ? 4 : 2; const bool isg_ = jj_ >= nkb_; const int kc_ = isg_ ? jj_ - nkb_ : jj_; \
        const size_t lda2_ = isg_ ? PW * 2 : AOW * 2, ldb2_ = isg_ ? 256 : (i_ < 3 ? 512 : 256); \
        const char* ua_ = (isg_ ? pPG : pAO + i_ * 512) + kc_ * 128 + (size_t)pml * 128 * lda2_; \
        const char* ub_ = (isg_ ? pGB + (size_t)i_ * (1024 * 128 * 2) : pBR + (size_t)i_ * (1024 * 256 * 2)) + kc_ * 128 + (size_t)pnl * 256 * ldb2_; \
        LAS unsigned char* d_ = lds + bl * KTB + ldsw; \
        _Pragma("unroll") for (int q_ = 0; q_ < 2; ++q_) { \
            __builtin_amdgcn_global_load_lds((const unsigned*)(ua_ + (isg_ ? vAg[q_] : vAb[q_])), (LAS unsigned*)(d_ + q_ * 8192), 16, 0, 0); \
            __builtin_amdgcn_global_load_lds((const unsigned*)(ub_ + (ldb2_ == 256 ? vB1[q_] : vB2[q_])), (LAS unsigned*)(d_ + HTB + q_ * 8192), 16, 0, 0); \
            __builtin_amdgcn_global_load_lds((const unsigned*)(ub_ + 128 * ldb2_ + (ldb2_ == 256 ? vB1[q_] : vB2[q_])), (LAS unsigned*)(d_ + 2 * HTB + q_ * 8192), 16, 0, 0); } \
        } while (0)
#define L_STAGE_ADV() do { bl = bl == 2 ? 0 : bl + 1; \
        if (jl + 1 < 22) ++jl; else { int pm2_ = 0, pn2_ = 0; bool ok2_; UNIT_OF(iul + 1, pm2_, pn2_, ok2_); if (ok2_) { ++iul; jl = 0; pml = pm2_; pnl = pn2_; } } } while (0)
#define L_STAGE() do { L_STAGE_ISSUE(); L_STAGE_ADV(); } while (0)
#define L_WAITV(n) asm volatile("s_waitcnt vmcnt(" #n ")" ::: "memory")
#define L_BAR __builtin_amdgcn_s_barrier()
    bf16x8 At[4][2], B0[2][2], B1[2][2];
    f32x4 acc[2][4][2];
#define L_STEP() do { const LAS unsigned char* b_ = lds + bc * KTB; \
        _Pragma("unroll") for (int n = 0; n < 2; ++n) _Pragma("unroll") for (int k = 0; k < 2; ++k) { B0[n][k] = *(const LAS bf16x8*)(b_ + HTB + boff + n * 2048 + k * 1024); B1[n][k] = *(const LAS bf16x8*)(b_ + 2 * HTB + boff + n * 2048 + k * 1024); } \
        __builtin_amdgcn_sched_barrier(0); \
        _Pragma("unroll") for (int m = 0; m < 4; ++m) _Pragma("unroll") for (int k = 0; k < 2; ++k) At[m][k] = *(const LAS bf16x8*)(b_ + aoff + m * 2048 + k * 1024); \
          \
        if (wr == 1) { L_STAGE_ISSUE(); L_WAITV(6); } \
        asm volatile("s_waitcnt lgkmcnt(0)" ::: "memory"); L_BAR; \
        __builtin_amdgcn_s_setprio(1); \
        _Pragma("unroll") for (int m = 0; m < 2; ++m) _Pragma("unroll") for (int n = 0; n < 2; ++n) _Pragma("unroll") for (int k = 0; k < 2; ++k) { \
            acc[0][m][n] = __builtin_amdgcn_mfma_f32_16x16x32_bf16(B0[n][k], At[m][k], acc[0][m][n], 0, 0, 0); \
            acc[1][m][n] = __builtin_amdgcn_mfma_f32_16x16x32_bf16(B1[n][k], At[m][k], acc[1][m][n], 0, 0, 0); } \
        __builtin_amdgcn_sched_barrier(0); \
        if (wr == 0) { L_STAGE_ISSUE(); }            \
        __builtin_amdgcn_sched_barrier(0); \
        _Pragma("unroll") for (int m = 2; m < 4; ++m) _Pragma("unroll") for (int n = 0; n < 2; ++n) _Pragma("unroll") for (int k = 0; k < 2; ++k) { \
            acc[0][m][n] = __builtin_amdgcn_mfma_f32_16x16x32_bf16(B0[n][k], At[m][k], acc[0][m][n], 0, 0, 0); \
            acc[1][m][n] = __builtin_amdgcn_mfma_f32_16x16x32_bf16(B1[n][k], At[m][k], acc[1][m][n], 0, 0, 0); } \
        __builtin_amdgcn_sched_barrier(0); \
        if (wr == 0) { L_WAITV(6); } \
        __builtin_amdgcn_s_setprio(0); \
        L_BAR; __builtin_amdgcn_sched_barrier(0); \
        L_STAGE_ADV(); \
        bc = bc == 2 ? 0 : bc + 1; } while (0)
    L_STAGE(); L_STAGE();
    L_WAITV(6); L_BAR;
    if (wr == 1) L_BAR;
    int bc = 0, pm = pml, pn = pnl; bool ok = true;
    pm = 0; pn = 0; UNIT_OF(0, pm, pn, ok);
#pragma unroll 1
    for (int iu = 0; ok; ++iu) {
        unsigned yy[2][4][2][2];
#pragma unroll
        for (int a = 0; a < 2; ++a)
#pragma unroll
            for (int m = 0; m < 4; ++m) { yy[a][m][0][0] = 0u; yy[a][m][0][1] = 0u; yy[a][m][1][0] = 0u; yy[a][m][1][1] = 0u; }
#pragma unroll 1
        for (int i = 0; i < 4; ++i) {
            const int nkb = i < 3 ? 4 : 2;
#pragma unroll
            for (int a = 0; a < 2; ++a)
#pragma unroll
                for (int m = 0; m < 4; ++m) { acc[a][m][0] = (f32x4){0.f, 0.f, 0.f, 0.f}; acc[a][m][1] = (f32x4){0.f, 0.f, 0.f, 0.f}; }
            f32x4 bb[2][2];
#pragma unroll
            for (int bj = 0; bj < 2; ++bj) {
                int fqb = fq; asm volatile("" : "+v"(fqb));
                const float* bp = bneg + i * 1024 + pn * 256 + bj * 128 + wc * 32 + 8 * fqb;
                bb[bj][0] = *(const f32x4*)bp; bb[bj][1] = *(const f32x4*)(bp + 4);
            }
#pragma unroll 1
            for (int kc = 0; kc < nkb; ++kc) L_STEP();
            unsigned tpk[2][4][2][2];
            __builtin_amdgcn_sched_barrier(0);
#pragma unroll
            for (int bj = 0; bj < 2; ++bj) {
#pragma unroll
                for (int m = 0; m < 4; ++m) {
#pragma unroll
                    for (int n = 0; n < 2; ++n) { tpk[bj][m][n][0] = pk2(acc[bj][m][n][0], acc[bj][m][n][1]); tpk[bj][m][n][1] = pk2(acc[bj][m][n][2], acc[bj][m][n][3]); }
                    acc[bj][m][0] = bb[bj][0]; acc[bj][m][1] = bb[bj][1];
                }
            }
            __builtin_amdgcn_sched_barrier(0);
#pragma unroll 1
            for (int kc = 0; kc < 2; ++kc) L_STEP();
#pragma unroll
            for (int bj = 0; bj < 2; ++bj)
#pragma unroll
                for (int m = 0; m < 4; ++m)
#pragma unroll
                    for (int n = 0; n < 2; ++n) {
                        const float y0 = bflo(yy[bj][m][n][0]) + bflo(tpk[bj][m][n][0]) * rcpf(1.f + ex2(acc[bj][m][n][0]));
                        const float y1 = bfhi(yy[bj][m][n][0]) + bfhi(tpk[bj][m][n][0]) * rcpf(1.f + ex2(acc[bj][m][n][1]));
                        const float y2 = bflo(yy[bj][m][n][1]) + bflo(tpk[bj][m][n][1]) * rcpf(1.f + ex2(acc[bj][m][n][2]));
                        const float y3 = bfhi(yy[bj][m][n][1]) + bfhi(tpk[bj][m][n][1]) * rcpf(1.f + ex2(acc[bj][m][n][3]));
                        yy[bj][m][n][0] = pk2(y0, y1); yy[bj][m][n][1] = pk2(y2, y3);
                    }
        }
#pragma unroll
        for (int m = 0; m < 4; ++m) {
            int lb = lane; asm volatile("" : "+v"(lb));
            const int row = pm * 128 + wr * 64 + m * 16 + (lb & 15);
#pragma unroll
            for (int bj = 0; bj < 2; ++bj)
                *(u32x4*)(Y + (size_t)row * DM + pn * 256 + bj * 128 + wc * 32 + 8 * (lb >> 4)) = (u32x4){yy[bj][m][0][0], yy[bj][m][0][1], yy[bj][m][1][0], yy[bj][m][1][1]};
        }
        UNIT_OF(iu + 1, pm, pn, ok);
    }
    if (wr == 0) L_BAR;
    L_WAITV(0); L_BAR;
#undef UNIT_OF
#undef L_STAGE
#undef L_STAGE_ISSUE
#undef L_STAGE_ADV
#undef L_WAITV
#undef L_BAR
#undef L_STEP
}

__device__ __forceinline__ void mla_finalize(const Params& p, const Ctx& c0, int l) {
    const Ctx c = launder(c0);
    unsigned char* const wsl = launder_ptr(p.ws);
    const bf16_t* PROJ = (const bf16_t*)(wsl + WS_PROJ); const bf16_t* RAW = (const bf16_t*)(wsl + WS_H);
    bf16_t* QM = (bf16_t*)(wsl + WS_Y); bf16_t* KM = QM + (size_t)NTOK * 384; bf16_t* VM = KM + (size_t)NTOK * 384;
    const f32x2* rope = (const f32x2*)(wsl + WS_ROPE);
    const float* gq = p.in[I_GMLA] + l * 192; const float* gk = gq + 96;
    const int lane = c.lane, hd = lane >> 4, sub = lane & 15;
    const float SC = 0.10206207261596575f * LOG2E;
    f32x4 gqn = *(const f32x4*)(gq + 4 * sub), gkn = *(const f32x4*)(gk + 4 * sub);
    const float gq1 = gq[64 + sub], gq2 = gq[80 + sub], gk1 = gk[64 + sub], gk2 = gk[80 + sub];
    u32x2 n_cq, n_ck, n_qn, n_kn, n_vn; unsigned short n_x1, n_x2, n_p1, n_p2; f32x2 n_cs;
#define FIN_LOAD(m_) do { const bf16_t* pr_ = PROJ + (size_t)(m_) * PW; const bf16_t* rw_ = RAW + (size_t)(m_) * 1024; \
        n_cq = *(const u32x2*)(pr_ + PC_CQ + 4 * lane); n_ck = *(const u32x2*)(pr_ + PC_CKV + 4 * lane); n_cs = rope[(size_t)((m_) & (SEQ - 1)) * 16 + sub]; \
        n_qn = *(const u32x2*)(rw_ + hd * 96 + 4 * sub); n_x1 = rw_[hd * 96 + 64 + sub]; n_x2 = rw_[hd * 96 + 80 + sub]; \
        n_kn = *(const u32x2*)(rw_ + 512 + hd * 128 + 4 * sub); n_vn = *(const u32x2*)(rw_ + 512 + hd * 128 + 64 + 4 * sub); n_p1 = pr_[PC_KPE + sub]; n_p2 = pr_[PC_KPE + 16 + sub]; } while (0)
    if (c.gw < NTOK) FIN_LOAD(c.gw);
    for (int m = c.gw; m < NTOK; m += c.NGW) {
        const u32x2 cq = n_cq, ck = n_ck, qn = n_qn, kn = n_kn, vn = n_vn; const f32x2 cs = n_cs;
        const float x1r = bf2f(n_x1), x2r = bf2f(n_x2), p1 = bf2f(n_p1), p2 = bf2f(n_p2);
        if (m + c.NGW < NTOK) FIN_LOAD(m + c.NGW);
        float sq = bflo(cq.x) * bflo(cq.x) + bfhi(cq.x) * bfhi(cq.x) + bflo(cq.y) * bflo(cq.y) + bfhi(cq.y) * bfhi(cq.y);
        float sk = bflo(ck.x) * bflo(ck.x) + bfhi(ck.x) * bfhi(ck.x) + bflo(ck.y) * bflo(ck.y) + bfhi(ck.y) * bfhi(ck.y);
        const float rsq = __builtin_amdgcn_rsqf(wave_sum(sq) * (1.f / 256.f) + EPS), rsk = __builtin_amdgcn_rsqf(wave_sum(sk) * (1.f / 256.f) + EPS);
        float q0 = bflo(qn.x) * rsq, q1 = bfhi(qn.x) * rsq, q2 = bflo(qn.y) * rsq, q3 = bfhi(qn.y) * rsq;
        const float x1 = x1r * rsq, x2 = x2r * rsq;
        const float y1 = x1 * cs.x - x2 * cs.y, y2 = x2 * cs.x + x1 * cs.y;
        float ss = q0 * q0 + q1 * q1 + q2 * q2 + q3 * q3 + y1 * y1 + y2 * y2;
        ss = row16_sum(ss);
        float rr = __builtin_amdgcn_rsqf(ss * (1.f / 96.f) + EPS) * SC;
        bf16_t* qo = QM + (size_t)m * 384 + hd * 96;
        *(u32x2*)(qo + 4 * sub) = (u32x2){pk2(q0 * rr * gqn.x, q1 * rr * gqn.y), pk2(q2 * rr * gqn.z, q3 * rr * gqn.w)};
        qo[64 + sub] = (bf16_t)(pk2(y1 * rr * gq1, 0.f) & 0xffffu); qo[80 + sub] = (bf16_t)(pk2(y2 * rr * gq2, 0.f) & 0xffffu);
        float k0 = bflo(kn.x) * rsk, k1 = bfhi(kn.x) * rsk, k2 = bflo(kn.y) * rsk, k3 = bfhi(kn.y) * rsk;
        const float z1 = p1 * cs.x - p2 * cs.y, z2 = p2 * cs.x + p1 * cs.y;
        float sk2 = k0 * k0 + k1 * k1 + k2 * k2 + k3 * k3 + z1 * z1 + z2 * z2;
        sk2 = row16_sum(sk2);
        const float rk = __builtin_amdgcn_rsqf(sk2 * (1.f / 96.f) + EPS);
        const int bb = m >> 14, pos = m & (SEQ - 1), T = pos >> 6, kk = pos & 63;
        bf16_t* kt = KM + ((size_t)((bb * 4 + hd) * 256 + T)) * (12 * 64 * 8) + kk * 8;
        *(u32x2*)(kt + (sub >> 1) * 512 + 4 * (sub & 1)) = (u32x2){pk2(k0 * rk * gkn.x, k1 * rk * gkn.y), pk2(k2 * rk * gkn.z, k3 * rk * gkn.w)};
        kt[(8 + (sub >> 3)) * 512 + (sub & 7)] = (bf16_t)(pk2(z1 * rk * gk1, 0.f) & 0xffffu); kt[(10 + (sub >> 3)) * 512 + (sub & 7)] = (bf16_t)(pk2(z2 * rk * gk2, 0.f) & 0xffffu);
        bf16_t* vt_ = VM + ((size_t)((bb * 4 + hd) * 256 + T)) * (8 * 16 * 32) + ((sub >> 3) * 4 + (kk >> 4)) * 512 + (kk & 15) * 32 + (4 * sub & 31);
        *(u32x2*)vt_ = (u32x2){pk2(bflo(vn.x) * rsk, bfhi(vn.x) * rsk), pk2(bflo(vn.y) * rsk, bfhi(vn.y) * rsk)};
    }
#undef FIN_LOAD
}

__device__ __forceinline__ s16x4 tr16(const LAS unsigned char* p) { return __builtin_bit_cast(s16x4, __builtin_amdgcn_ds_read_tr16_b64_v4i16((LAS s16x4*)p)); }
__device__ __forceinline__ bf16x8 vfrag(const LAS unsigned char* vt, int VP, int s, int db, int lane) {
    const int hi = lane >> 5, q4 = (lane & 15) >> 2, pp = lane & 3, g1 = (lane >> 4) & 1;
    const LAS unsigned char* a = vt + (16 * s + 8 * hi + q4) * VP + (32 * db + 16 * g1 + 4 * pp) * 2;
    const s16x4 lo = tr16(a), hh = tr16(a + 4 * VP);
    return (bf16x8){lo[0], lo[1], lo[2], lo[3], hh[0], hh[1], hh[2], hh[3]};
}
__device__ __forceinline__ bf16x8 pfrag(const f32x16& pv, int s) {
    u32x4 w; w.x = pk2(pv[8 * s], pv[8 * s + 1]); w.y = pk2(pv[8 * s + 2], pv[8 * s + 3]); w.z = pk2(pv[8 * s + 4], pv[8 * s + 5]); w.w = pk2(pv[8 * s + 6], pv[8 * s + 7]);
    return mk8(w);
}
__device__ __forceinline__ float dot2_ones(unsigned pk, float c) { return __builtin_amdgcn_fdot2_f32_bf16(__builtin_bit_cast(bf16x2_t, pk), __builtin_bit_cast(bf16x2_t, 0x3F803F80u), c, false); }
__device__ __forceinline__ int keyof(int r, int hi) { return 16 * (r >> 3) + 8 * hi + (r & 7); }
__device__ __forceinline__ void store_ot(bf16_t* rowp, const f32x16& o, float sc, int hi) {
#pragma unroll
    for (int g = 0; g < 4; ++g) *(u32x2*)(rowp + 8 * g + 4 * hi) = (u32x2){pk2(o[4 * g] * sc, o[4 * g + 1] * sc), pk2(o[4 * g + 2] * sc, o[4 * g + 3] * sc)};
}

__device__ __forceinline__ void sb_unit(const Params& p, const Ctx& c0, int b, int h, int qt) {
    const Ctx c = launder(c0);
    unsigned char* const wsl = launder_ptr(p.ws);
    const bf16_t* PROJ = (const bf16_t*)(wsl + WS_PROJ); bf16_t* AO = (bf16_t*)(wsl + WS_AO);
    LAS unsigned char* vt = c.lds + LDS_VSCR + c.wid * 4608;
    const int lane = c.lane, r32 = lane & 31, hi = lane >> 5;
    const size_t tb = (size_t)b * SEQ;
    const bf16_t* qp = PROJ + (tb + qt * 32 + r32) * PW + PC_AQ + h * 64 + 8 * hi;
    bf16x8 qr[4];
#pragma unroll
    for (int d0 = 0; d0 < 4; ++d0) qr[d0] = *(const bf16x8*)(qp + 16 * d0);
    f32x16 o0 = (f32x16){}, o1 = (f32x16){};
    float R = 0.f;
    const int prow = pi32(r32);
    bf16x8 kf[4], nkf[4]; u32x4 vr[4], nvr[4];
#define SB_LOAD(KF, VR, kt_) do { const bf16_t* kp_ = PROJ + (tb + (kt_) * 32 + prow) * PW + PC_AK + h * 64 + 8 * hi; \
        _Pragma("unroll") for (int d0 = 0; d0 < 4; ++d0) KF[d0] = *(const bf16x8*)(kp_ + 16 * d0); \
        _Pragma("unroll") for (int i = 0; i < 4; ++i) { const int id = lane + 64 * i; VR[i] = *(const u32x4*)(PROJ + (tb + (kt_) * 32 + (id >> 3)) * PW + PC_AV + h * 64 + (id & 7) * 8); } } while (0)
    SB_LOAD(kf, vr, qt);
    for (int kt = qt; kt >= 0; --kt) {
        if (kt > 0) SB_LOAD(nkf, nvr, kt - 1);
        f32x16 z = (f32x16){};
#pragma unroll
        for (int d0 = 0; d0 < 4; ++d0) z = __builtin_amdgcn_mfma_f32_32x32x16_bf16(kf[d0], qr[d0], z, 0, 0, 0);
#pragma unroll
        for (int i = 0; i < 4; ++i) { const int id = lane + 64 * i; *(LAS u32x4*)(vt + (id >> 3) * 144 + (id & 7) * 16) = vr[i]; }
        f32x16 L; const bool diag = kt == qt;
#pragma unroll
        for (int r = 0; r < 16; ++r) {
            const float zz = z[r];
            float lv = -(fmaxf(zz, 0.f) + lg2(1.f + ex2(-fabsf(zz))));
            if (diag && keyof(r, hi) >= r32) lv = 0.f;
            L[r] = lv;
        }
        float ta = 0.f, tb2 = 0.f;
#pragma unroll
        for (int r = 0; r < 8; ++r) { ta += L[r]; tb2 += L[8 + r]; }
        const float pa = x32_other(ta, hi), pb = x32_other(tb2, hi);
        const float afterA = hi ? (pb + tb2) : (pa + tb2 + pb);
        const float afterB = hi ? 0.f : pb;
        f32x16 a;
        {
            float run = R + afterA;
#pragma unroll
            for (int r = 7; r >= 0; --r) { a[r] = ex2(z[r] + L[r] + run); run += L[r]; }
            run = R + afterB;
#pragma unroll
            for (int r = 15; r >= 8; --r) { a[r] = ex2(z[r] + L[r] + run); run += L[r]; }
        }
        if (diag) {
#pragma unroll
            for (int r = 0; r < 16; ++r) if (keyof(r, hi) >= r32) a[r] = 0.f;
        }
        R += (ta + pa) + (tb2 + pb);
#pragma unroll
        for (int s = 0; s < 2; ++s) {
            const bf16x8 pf = pfrag(a, s);
            o0 = __builtin_amdgcn_mfma_f32_32x32x16_bf16(vfrag(vt, 144, s, 0, lane), pf, o0, 0, 0, 0);
            o1 = __builtin_amdgcn_mfma_f32_32x32x16_bf16(vfrag(vt, 144, s, 1, lane), pf, o1, 0, 0, 0);
        }
        if (__all(R < -160.f)) break;
#pragma unroll
        for (int i = 0; i < 4; ++i) { kf[i] = nkf[i]; vr[i] = nvr[i]; }
    }
#undef SB_LOAD
    bf16_t* op = AO + (tb + qt * 32 + r32) * AOW + h * 64;
    store_ot(op, o0, 1.f, hi); store_ot(op + 32, o1, 1.f, hi);
}

__device__ __forceinline__ void local_attn(const bf16_t* PROJ, LAS unsigned char* vt, const LAS float* btab, int qcol, int kcol, int vcol,
                                           size_t tb, int dil, int rr, int m0, int W, int lane, f32x16& o, float& m, float& lsum) {
    const int r32 = lane & 31, hi = lane >> 5, prow = pi32(r32);
    const bf16_t* qp = PROJ + (tb + (size_t)(m0 + r32) * dil + rr) * PW + qcol + 8 * hi;
    const bf16x8 q0 = *(const bf16x8*)qp, q1 = *(const bf16x8*)(qp + 16);
    bf16x8 kf[5][2]; u32x4 vr[5][2];
#pragma unroll
    for (int ti = 0; ti < 5; ++ti) {
        const int k0 = m0 - 128 + 32 * ti;
        if (k0 >= 0) {
            const bf16_t* kp = PROJ + (tb + (size_t)(k0 + prow) * dil + rr) * PW + kcol + 8 * hi;
            kf[ti][0] = *(const bf16x8*)kp; kf[ti][1] = *(const bf16x8*)(kp + 16);
#pragma unroll
            for (int i = 0; i < 2; ++i) { const int id = lane + 64 * i; vr[ti][i] = *(const u32x4*)(PROJ + (tb + (size_t)(k0 + (id >> 2)) * dil + rr) * PW + vcol + (id & 3) * 8); }
        } else { kf[ti][0] = kf[ti][1] = (bf16x8){}; vr[ti][0] = vr[ti][1] = (u32x4){0u, 0u, 0u, 0u}; }
    }
    o = (f32x16){}; m = -1e30f; lsum = 0.f;
#pragma unroll
    for (int ti = 0; ti < 5; ++ti) {
        const int dl = 128 - 32 * ti, k0 = m0 - dl;
        if (k0 < 0) continue;
        f32x16 s = (f32x16){};
        s = __builtin_amdgcn_mfma_f32_32x32x16_bf16(kf[ti][0], q0, s, 0, 0, 0);
        s = __builtin_amdgcn_mfma_f32_32x32x16_bf16(kf[ti][1], q1, s, 0, 0, 0);
#pragma unroll
        for (int i = 0; i < 2; ++i) { const int id = lane + 64 * i; *(LAS u32x4*)(vt + (id >> 2) * 80 + (id & 3) * 16) = vr[ti][i]; }
        float mx = -INFINITY;
#pragma unroll
        for (int r = 0; r < 16; ++r) {
            const int dist = dl + r32 - keyof(r, hi);
            const int di = dist < 0 ? 0 : (dist > 131 ? 131 : dist);
            float v = s[r] + btab[di];
            if (dl == 0) { if (dist < 0) v = -INFINITY; }
            if (dl == 128) { if (dist > W) v = -INFINITY; }
            s[r] = v; mx = fmaxf(mx, v);
        }
        mx = x32_max(mx);
        const float mn = fmaxf(m, mx), f = ex2(m - mn);
        m = mn;
        float ps = 0.f;
#pragma unroll
        for (int r = 0; r < 16; ++r) { s[r] = ex2(s[r] - mn); ps += s[r]; }
        lsum = lsum * f + ps;
#pragma unroll
        for (int r = 0; r < 16; ++r) o[r] *= f;
#pragma unroll
        for (int st = 0; st < 2; ++st) o = __builtin_amdgcn_mfma_f32_32x32x16_bf16(vfrag(vt, 80, st, 0, lane), pfrag(s, st), o, 0, 0, 0);
    }
}

__device__ __forceinline__ void sw_unit(const Params& p, const Ctx& c0, int l, int b, int hq, int qt) {
    const Ctx c = launder(c0);
    unsigned char* const wsl = launder_ptr(p.ws);
    const bf16_t* PROJ = (const bf16_t*)(wsl + WS_PROJ); bf16_t* AO = (bf16_t*)(wsl + WS_AO);
    LAS unsigned char* vt = c.lds + LDS_VSCR + c.wid * 4608;
    const LAS float* btab = (const LAS float*)(c.lds + LDS_BTAB) + hq * 132;
    const int lane = c.lane, r32 = lane & 31, hi = lane >> 5, kv = hq >> 2;
    f32x16 o; float m, ls;
    local_attn(PROJ, vt, btab, PC_SWQ + hq * 32, PC_SWK + kv * 32, PC_SWV + kv * 32, (size_t)b * SEQ, 1, 0, qt * 32, 127, lane, o, m, ls);
    ls = x32_add(ls);
    const float sk = p.in[I_SINKS][l * 8 + hq] * LOG2E;
    const float mf = fmaxf(m, sk), f = ex2(m - mf);
    const float den = ls * f + ex2(sk - mf);
    store_ot(AO + ((size_t)b * SEQ + qt * 32 + r32) * AOW + 512 + hq * 32, o, f * rcpf(den), hi);
}

__device__ __forceinline__ void dil_unit(const Params& p, const Ctx& c0, int b, int tblk, int h) {
    const Ctx c = launder(c0);
    unsigned char* const wsl = launder_ptr(p.ws);
    const bf16_t* PROJ = (const bf16_t*)(wsl + WS_PROJ); bf16_t* AO = (bf16_t*)(wsl + WS_AO);
    LAS unsigned char* vt = c.lds + LDS_VSCR + c.wid * 4608;
    LAS bf16_t* obuf = (LAS bf16_t*)(c.lds + LDS_DOBUF); LAS float* lse = (LAS float*)(c.lds + LDS_DLSE);
    const int lane = c.lane, r32 = lane & 31, hi = lane >> 5;
    const int T0 = tblk * 512;
#pragma unroll 1
    for (int g = 0; g < 3; ++g) {
        const int dil = g == 0 ? 1 : (g == 1 ? 4 : 16), sh = g == 0 ? 0 : (g == 1 ? 2 : 4);
        const LAS float* btab = (const LAS float*)(c.lds + LDS_BTAB) + (8 + 4 * g + h) * 132;
#pragma unroll 1
        for (int jj = 0; jj < 2; ++jj) {
            const int j = 2 * c.wid + jj;
            const int ntr = 16 >> sh;
            const int rr = j / ntr, sub = j % ntr;
            const int m0 = (T0 >> sh) + 32 * sub;
            f32x16 o; float m, ls;
            local_attn(PROJ, vt, btab, PC_DQ + g * 128 + h * 32, PC_DK + g * 128 + h * 32, PC_DV + g * 128 + h * 32, (size_t)b * SEQ + (size_t)rr * (SEQ >> sh), 1, 0, m0, 128, lane, o, m, ls);
            ls = x32_add(ls);
            const float inv = rcpf(ls);
            const int tl = ((m0 + r32) << sh) + rr - T0;
            LAS bf16_t* ob = obuf + (tl * 3 + g) * 32;
#pragma unroll
            for (int q = 0; q < 4; ++q) *(LAS u32x2*)(ob + 8 * q + 4 * hi) = (u32x2){pk2(o[4 * q] * inv, o[4 * q + 1] * inv), pk2(o[4 * q + 2] * inv, o[4 * q + 3] * inv)};
            if (hi == 0) lse[tl * 3 + g] = m + lg2(ls);
        }
    }
    __syncthreads();
    {
        const int tl = c.tid;
        const float l0 = lse[tl * 3], l1 = lse[tl * 3 + 1], l2 = lse[tl * 3 + 2];
        const float mx = fmaxf(l0, fmaxf(l1, l2));
        float w0 = ex2(l0 - mx), w1 = ex2(l1 - mx), w2 = ex2(l2 - mx); const float iv = rcpf(w0 + w1 + w2); w0 *= iv; w1 *= iv; w2 *= iv;
        const LAS u32x4* ob = (const LAS u32x4*)(obuf + tl * 96);
        u32x4* dst = (u32x4*)(AO + ((size_t)b * SEQ + T0 + tl) * AOW + 768 + h * 32);
#pragma unroll
        for (int q = 0; q < 4; ++q) {
            const u32x4 a = ob[q], bq = ob[4 + q], cq = ob[8 + q];
            u32x4 r;
            r.x = pk2(w0 * bflo(a.x) + w1 * bflo(bq.x) + w2 * bflo(cq.x), w0 * bfhi(a.x) + w1 * bfhi(bq.x) + w2 * bfhi(cq.x));
            r.y = pk2(w0 * bflo(a.y) + w1 * bflo(bq.y) + w2 * bflo(cq.y), w0 * bfhi(a.y) + w1 * bfhi(bq.y) + w2 * bfhi(cq.y));
            r.z = pk2(w0 * bflo(a.z) + w1 * bflo(bq.z) + w2 * bflo(cq.z), w0 * bfhi(a.z) + w1 * bfhi(bq.z) + w2 * bfhi(cq.z));
            r.w = pk2(w0 * bflo(a.w) + w1 * bflo(bq.w) + w2 * bflo(cq.w), w0 * bfhi(a.w) + w1 * bfhi(bq.w) + w2 * bfhi(cq.w));
            dst[q] = r;
        }
    }
    __syncthreads();
}

#ifndef MLA_BIG
#define MLA_BIG 1.0995116e12f
#endif
constexpr int MK_SLOT = 12288, MV_SLOT = 8192, MLA_VOFF = 5 * MK_SLOT;
__device__ __forceinline__ void mla_qk(const LAS unsigned char* ks, const bf16x8 (&qr)[6], const f32x16& negm, int prow, int hi, f32x16& s0, f32x16& s1) {
    bf16x8 kf[12];
    const LAS unsigned char* kp = ks + hi * 1024 + prow * 16;
#pragma unroll
    for (int d0 = 0; d0 < 6; ++d0) { kf[2 * d0] = *(const LAS bf16x8*)(kp + d0 * 2048); kf[2 * d0 + 1] = *(const LAS bf16x8*)(kp + d0 * 2048 + 512); }
    __builtin_amdgcn_sched_barrier(0);
    s0 = __builtin_amdgcn_mfma_f32_32x32x16_bf16(kf[0], qr[0], negm, 0, 0, 0);
    s1 = __builtin_amdgcn_mfma_f32_32x32x16_bf16(kf[1], qr[0], negm, 0, 0, 0);
#pragma unroll
    for (int d0 = 1; d0 < 6; ++d0) {
        s0 = __builtin_amdgcn_mfma_f32_32x32x16_bf16(kf[2 * d0], qr[d0], s0, 0, 0, 0);
        s1 = __builtin_amdgcn_mfma_f32_32x32x16_bf16(kf[2 * d0 + 1], qr[d0], s1, 0, 0, 0);
    }
    __builtin_amdgcn_sched_barrier(0);
}
__device__ __forceinline__ bf16x8 mla_vfrag(const LAS unsigned char* vs, int s, int db, int lane) {
    const int hi = lane >> 5, q4 = (lane & 15) >> 2, pp = lane & 3, g1 = (lane >> 4) & 1;
    const LAS unsigned char* a = vs + (db * 4 + s) * 1024 + (8 * hi + q4) * 64 + (16 * g1 + 4 * pp) * 2;
    const s16x4 lo = tr16(a), hh = tr16(a + 256);
    return (bf16x8){lo[0], lo[1], lo[2], lo[3], hh[0], hh[1], hh[2], hh[3]};
}
__device__ __forceinline__ float max3f(float a, float b, float c) { return fmaxf(fmaxf(a, b), c); }
__device__ __forceinline__ float rowmax32(const f32x16& a, const f32x16& b) {
    float x = max3f(a[0], a[1], a[2]), y = max3f(b[0], b[1], b[2]);
    x = max3f(x, a[3], a[4]); y = max3f(y, b[3], b[4]); x = max3f(x, a[5], a[6]); y = max3f(y, b[5], b[6]);
    x = max3f(x, a[7], a[8]); y = max3f(y, b[7], b[8]); x = max3f(x, a[9], a[10]); y = max3f(y, b[9], b[10]);
    x = max3f(x, a[11], a[12]); y = max3f(y, b[11], b[12]); x = max3f(x, a[13], a[14]); y = max3f(y, b[13], b[14]);
    return max3f(x, y, fmaxf(a[15], b[15]));
}
__device__ __forceinline__ void mla_unit(const Params& p, const Ctx& c0, int b, int h, int qb) {
    const Ctx c = launder(c0);
    unsigned char* const wsl = launder_ptr(p.ws);
    const bf16_t* QM = (const bf16_t*)(wsl + WS_Y);
    bf16_t* AO = (bf16_t*)(wsl + WS_AO);
    LAS unsigned char* buf = c.lds + LDS_MLA;
    const int lane = c.lane, wid = c.wid, r32 = lane & 31, hi = lane >> 5, prow = pi32(r32);
    const size_t tb = (size_t)b * SEQ; const int q0 = qb * 256, qw0 = q0 + wid * 32;
    const bf16_t* qp = QM + (tb + qw0 + r32) * 384 + h * 96 + 8 * hi;
    bf16x8 qr[6];
#pragma unroll
    for (int d0 = 0; d0 < 6; ++d0) qr[d0] = *(const bf16x8*)(qp + 16 * d0);
    const int NT = (q0 + 256) / 64;
    const __amdgpu_buffer_rsrc_t rs = __builtin_amdgcn_make_buffer_rsrc((void*)wsl, (short)0, 0x7fffffff, 0x00020000);
    const unsigned ldsb = (unsigned)(__SIZE_TYPE__)buf;
    const unsigned kvo = (unsigned)lane * 16u;
    const unsigned kso = (unsigned)(WS_Y + (size_t)NTOK * 384 * 2) + (unsigned)(((size_t)(b * 4 + h) * 256) * (12 * 1024)), vso = (unsigned)(WS_Y + (size_t)NTOK * 768 * 2) + (unsigned)(((size_t)(b * 4 + h) * 256) * (8 * 1024));
#define MLA_DMA_K(t) do { if (wid < 4) { const unsigned m0_ = ldsb + (unsigned)((t) % 5) * MK_SLOT + (unsigned)wid * 1024u, so_ = kso + (unsigned)(t) * 12288u + (unsigned)wid * 1024u; \
        DMA16(m0_, kvo, rs, so_); DMA16(m0_ + 4096u, kvo, rs, so_ + 4096u); DMA16(m0_ + 8192u, kvo, rs, so_ + 8192u); } } while (0)
#define MLA_DMA_V(t) do { if (wid < 4) { const unsigned m0_ = ldsb + MLA_VOFF + (unsigned)((t) & 3) * MV_SLOT + (unsigned)wid * 1024u, so_ = vso + (unsigned)(t) * 8192u + (unsigned)wid * 1024u; \
        DMA16(m0_, kvo, rs, so_); DMA16(m0_ + 4096u, kvo, rs, so_ + 4096u); } } while (0)
#define MLA_SYNC() asm volatile("s_waitcnt vmcnt(0)\n\ts_barrier" ::: "memory")
    MLA_DMA_K(0); MLA_DMA_V(0); MLA_DMA_K(1); MLA_DMA_V(1); MLA_DMA_K(2); MLA_DMA_K(3);
    MLA_SYNC();
    f32x16 o0 = (f32x16){}, o1 = (f32x16){}, sA0, sA1, sB0, sB1, negm = (f32x16){};
    unsigned pkA[16], pkB[16];
    float m, ls = 0.f;
    {
        mla_qk(buf, qr, negm, prow, hi, sA0, sA1);
        if (qw0 < 63) {
            const int q8 = qw0 + r32 - 8 * hi;
#pragma unroll
            for (int r = 0; r < 16; ++r) { if (16 * (r >> 3) + (r & 7) > q8) sA0[r] = -INFINITY; if (32 + 16 * (r >> 3) + (r & 7) > q8) sA1[r] = -INFINITY; }
        }
        float mx = rowmax32(sA0, sA1);
        mx = x32_max(mx);
        m = mx;
#pragma unroll
        for (int r = 0; r < 16; ++r) { sA0[r] -= m; sA1[r] -= m; negm[r] = -m; }
    }
#define MLA_PV_HALF(PKP, vs_, sh) do { \
          const bf16x8 pa_ = mk8((u32x4){PKP[8 * (sh)], PKP[8 * (sh) + 1], PKP[8 * (sh) + 2], PKP[8 * (sh) + 3]}), pb_ = mk8((u32x4){PKP[8 * (sh) + 4], PKP[8 * (sh) + 5], PKP[8 * (sh) + 6], PKP[8 * (sh) + 7]}); \
          o0 = __builtin_amdgcn_mfma_f32_32x32x16_bf16(vf_[0], pa_, o0, 0, 0, 0); o1 = __builtin_amdgcn_mfma_f32_32x32x16_bf16(vf_[1], pa_, o1, 0, 0, 0); \
          o0 = __builtin_amdgcn_mfma_f32_32x32x16_bf16(vf_[2], pb_, o0, 0, 0, 0); o1 = __builtin_amdgcn_mfma_f32_32x32x16_bf16(vf_[3], pb_, o1, 0, 0, 0); } while (0)
#define MLA_VLOAD(vs_, sh) do { vf_[0] = mla_vfrag(vs_, 2 * (sh), 0, lane); vf_[1] = mla_vfrag(vs_, 2 * (sh), 1, lane); vf_[2] = mla_vfrag(vs_, 2 * (sh) + 1, 0, lane); vf_[3] = mla_vfrag(vs_, 2 * (sh) + 1, 1, lane); } while (0)
#define MLA_STEP(C0, C1, N0, N1, PKP, PKC, t, PVON) do { \
        const bool deep_ = (t) + 4 < NT; \
        if (64 * ((t) - 1) <= qw0 + 31) {            \
        if ((t) > 0 && 64 * (t) + 63 > qw0) { const int q8_ = qw0 + r32 - 64 * (t) - 8 * hi; \
            _Pragma("unroll") for (int r = 0; r < 16; ++r) { if (16 * (r >> 3) + (r & 7) > q8_) C0[r] = -INFINITY; if (32 + 16 * (r >> 3) + (r & 7) > q8_) C1[r] = -INFINITY; } } \
        float ps_ = 0.f, pt_ = 0.f; \
        { const LAS unsigned char* kp_ = buf + (((t) + 1) % 5) * MK_SLOT + hi * 1024 + prow * 16; \
          const LAS unsigned char* vs_ = buf + MLA_VOFF + (((t) + 3) & 3) * MV_SLOT;        \
          bf16x8 kf_[6], vf_[4]; \
          _Pragma("unroll") for (int d0 = 0; d0 < 3; ++d0) { kf_[2 * d0] = *(const LAS bf16x8*)(kp_ + d0 * 2048); kf_[2 * d0 + 1] = *(const LAS bf16x8*)(kp_ + d0 * 2048 + 512); } \
          if (PVON) MLA_VLOAD(vs_, 0); \
          __builtin_amdgcn_sched_barrier(0); \
          N0 = __builtin_amdgcn_mfma_f32_32x32x16_bf16(kf_[0], qr[0], negm, 0, 0, 0); \
          N1 = __builtin_amdgcn_mfma_f32_32x32x16_bf16(kf_[1], qr[0], negm, 0, 0, 0); \
          _Pragma("unroll") for (int d0 = 1; d0 < 3; ++d0) { \
              N0 = __builtin_amdgcn_mfma_f32_32x32x16_bf16(kf_[2 * d0], qr[d0], N0, 0, 0, 0); \
              N1 = __builtin_amdgcn_mfma_f32_32x32x16_bf16(kf_[2 * d0 + 1], qr[d0], N1, 0, 0, 0); } \
          if (PVON) MLA_PV_HALF(PKP, vs_, 0); \
          _Pragma("unroll") for (int r = 0; r < 8; ++r) { PKC[r] = pk2(ex2(C0[2 * r]), ex2(C0[2 * r + 1])); ps_ = dot2_ones(PKC[r], ps_); } \
          _Pragma("unroll") for (int g_ = 0; g_ < (PVON ? 10 : 6); ++g_) { __builtin_amdgcn_sched_group_barrier(0x008, 1, 0); __builtin_amdgcn_sched_group_barrier(0x002, (PVON ? 3 : 4), 0); } \
          __builtin_amdgcn_sched_barrier(0); \
          _Pragma("unroll") for (int d0 = 3; d0 < 6; ++d0) { kf_[2 * d0 - 6] = *(const LAS bf16x8*)(kp_ + d0 * 2048); kf_[2 * d0 - 5] = *(const LAS bf16x8*)(kp_ + d0 * 2048 + 512); } \
          if (PVON) MLA_VLOAD(vs_, 1); \
          __builtin_amdgcn_sched_barrier(0); \
          _Pragma("unroll") for (int d0 = 3; d0 < 6; ++d0) { \
              N0 = __builtin_amdgcn_mfma_f32_32x32x16_bf16(kf_[2 * d0 - 6], qr[d0], N0, 0, 0, 0); \
              N1 = __builtin_amdgcn_mfma_f32_32x32x16_bf16(kf_[2 * d0 - 5], qr[d0], N1, 0, 0, 0); } \
          if (PVON) MLA_PV_HALF(PKP, vs_, 1); \
          _Pragma("unroll") for (int r = 0; r < 8; ++r) { PKC[8 + r] = pk2(ex2(C1[2 * r]), ex2(C1[2 * r + 1])); pt_ = dot2_ones(PKC[8 + r], pt_); } \
          _Pragma("unroll") for (int g_ = 0; g_ < (PVON ? 10 : 6); ++g_) { __builtin_amdgcn_sched_group_barrier(0x008, 1, 0); __builtin_amdgcn_sched_group_barrier(0x002, (PVON ? 3 : 4), 0); } \
          __builtin_amdgcn_sched_barrier(0); } \
          \
        if (__any(!(ps_ + pt_ < MLA_BIG))) { \
            mla_qk(buf + ((t) % 5) * MK_SLOT, qr, negm, prow, hi, C0, C1); \
            if (64 * (t) + 63 > qw0) { const int q8_ = qw0 + r32 - 64 * (t) - 8 * hi; \
                _Pragma("unroll") for (int r = 0; r < 16; ++r) { if (16 * (r >> 3) + (r & 7) > q8_) C0[r] = -INFINITY; if (32 + 16 * (r >> 3) + (r & 7) > q8_) C1[r] = -INFINITY; } } \
            float mx_ = rowmax32(C0, C1); \
            mx_ = x32_max(mx_); \
            const float d_ = fmaxf(mx_, 0.f), f_ = ex2(-d_); m += d_; ls *= f_; \
            ps_ = 0.f; pt_ = 0.f; \
            _Pragma("unroll") for (int r = 0; r < 16; ++r) { o0[r] *= f_; o1[r] *= f_; negm[r] = -m; N0[r] -= d_; N1[r] -= d_; } \
            _Pragma("unroll") for (int r = 0; r < 8; ++r) { PKC[r] = pk2(ex2(C0[2 * r] - d_), ex2(C0[2 * r + 1] - d_)); PKC[8 + r] = pk2(ex2(C1[2 * r] - d_), ex2(C1[2 * r + 1] - d_)); ps_ = dot2_ones(PKC[r], ps_); pt_ = dot2_ones(PKC[8 + r], pt_); } \
        } \
        ls += ps_ + pt_; \
        } \
          \
        if (deep_) { MLA_DMA_K((t) + 4); MLA_DMA_V((t) + 2); } else if ((t) + 2 < NT) MLA_DMA_V((t) + 2); \
        if (deep_) asm volatile("s_waitcnt vmcnt(10)\n\ts_barrier" ::: "memory"); \
        else MLA_SYNC(); \
    } while (0)
    MLA_STEP(sA0, sA1, sB0, sB1, pkB, pkA, 0, false);
#pragma unroll 1
    for (int t = 1; t < NT; t += 2) {
        MLA_STEP(sB0, sB1, sA0, sA1, pkA, pkB, t, true);
        MLA_STEP(sA0, sA1, sB0, sB1, pkB, pkA, t + 1, true);
    }
    ls = x32_add(ls);
    const float inv = rcpf(ls);
    bf16_t* op = AO + (tb + qw0 + r32) * AOW + 256 + h * 64;
    store_ot(op, o0, inv, hi); store_ot(op + 32, o1, inv, hi);
#undef MLA_STEP
#undef MLA_VLOAD
#undef MLA_PV_HALF
#undef MLA_DMA_K
#undef MLA_DMA_V
#undef MLA_SYNC
}

__device__ __forceinline__ void attention_phase(const Params& p, const Ctx& c0, int l) {
    const Ctx c = launder(c0);
    unsigned char* const wsl = launder_ptr(p.ws);
    { const float* bt = (const float*)(wsl + WS_TAB); LAS float* lb = (LAS float*)(c.lds + LDS_BTAB); for (int i = c.tid; i < 20 * 132; i += NWG_THREADS) lb[i] = bt[i]; }
    __syncthreads();
    for (int rep = 0; rep < REPS(16); ++rep) for (int u = c.gw; u < 4096; u += c.NGW) { const int qt = u & 511, h = (u >> 9) & 3, b = u >> 11; sb_unit(p, c, b, h, qt); }
    for (int rep = 0; rep < REPS(16); ++rep) for (int u = c.gw; u < 8192; u += c.NGW) { const int qt = u & 511, hq = (u >> 9) & 7, b = u >> 12; sw_unit(p, c, l, b, hq, qt); }
    for (int rep = 0; rep < REPS(18); ++rep) for (int u = c.vcu; u < 256; u += c.G) { const int h = u & 3, tblk = (u >> 2) & 31, b = u >> 7; dil_unit(p, c, b, tblk, h); }
    for (int rep = 0; rep < REPS(19); ++rep) for (int v = c.vcu; v < 256; v += c.G) {
        const int bh = v >> 5, s = v & 31;
#pragma unroll 1
        for (int i = 0; i < 2; ++i) mla_unit(p, c, bh >> 2, bh & 3, i ? s : 63 - s);
    }
}

__global__ void __launch_bounds__(NWG_THREADS, 2) fwd_kernel(Params p) {
    extern __shared__ __attribute__((aligned(16))) unsigned char lds_raw[];
    Ctx c;
    c.lds = (LAS unsigned char*)lds_raw;
    c.tid = threadIdx.x; c.lane = c.tid & 63; c.wid = __builtin_amdgcn_readfirstlane(c.tid >> 6);
    c.G = gridDim.x; { const int bx = blockIdx.x; c.vcu = (c.G % 8 == 0) ? (bx % 8) * (c.G / 8) + bx / 8 : bx; }
    c.gw = blockIdx.x * 8 + c.wid; c.NGW = c.G * 8;
    volatile LAS unsigned* lctl = (volatile LAS unsigned*)(c.lds + LDS_CTL);
    if (c.tid < 64) lctl[c.tid] = 0u;
    __syncthreads();
    unsigned* ctl = (unsigned*)(p.ws + WS_CTL);
    XcdBarrier bar = xcd_barrier_post(ctl + CW_BAR, lctl + 8);
    bar.x = (unsigned)__builtin_amdgcn_readfirstlane((int)bar.x);
    const int bx = blockIdx.x;

    for (int rep = 0; rep < REPS(0); ++rep) prologue(p, c);
#pragma unroll 1
    for (int l = 0; l < 2; ++l) {
        unsigned char* ws = launder_ptr(p.ws);
        bf16_t* H = (bf16_t*)(ws + WS_H); bf16_t* PROJ = (bf16_t*)(ws + WS_PROJ); bf16_t* Y = (bf16_t*)(ws + WS_Y);
        bf16_t* const RS = (bf16_t*)p.out;
        const void* xin = l == 0 ? (const void*)p.in[I_X] : (const void*)RS;
        for (int rep = 0; rep < REPS(1); ++rep) rmsnorm_phase<false>(p, c, xin, l == 0, p.in[I_N1G] + l * DM, H, nullptr, nullptr);
        xcd_barrier(bar);
        if (PH(2)) for (int rep = 0; rep < REPS(2); ++rep) {
            if (rep) xcd_barrier(bar);
            pg8::SchedPlain S{(const char*)(ws + WS_WIN) + (size_t)l * PW * 1024 * 2, DM * 2, 1024 * 2, 128, 12, c.G, bx};
            pg8::EpiInProj E{PROJ, (const float*)(ws + WS_TAB) + 20 * 132 + l * 128};
            pg8::gemm_phase<pg8::EpiInProj, pg8::SchedPlain, true>(c, (const char*)H, 1024, S, E);
        }
        xcd_barrier(bar);
        for (int rep = 0; rep < REPS(3); ++rep) {
#pragma unroll 1
            for (int q = 0; q < 2; ++q) {
                pg8::SchedPlain S{(const char*)(ws + (q ? WS_WKV : WS_WQ)) + (size_t)l * 512 * 256 * 2, PW * 2, 256 * 2, 128, 2, c.G, bx};
                pg8::EpiBf16 E{H, 1024, q * 512};
                pg8::gemm_phase<pg8::EpiBf16, pg8::SchedPlain, true>(c, (const char*)(PROJ + (q ? PC_CKV : PC_CQ)), 256, S, E);
            }
        }
        xcd_barrier(bar);
        for (int rep = 0; rep < REPS(4); ++rep) mla_finalize(p, c, l);
        xcd_barrier(bar);
        if (PH(5)) for (int rep = 0; rep < REPS(5); ++rep) { if (rep) xcd_barrier(bar); attention_phase(p, c, l); }
        xcd_barrier(bar);
        if (PH(6)) for (int rep = 0; rep < REPS(6); ++rep) { if (rep) xcd_barrier(bar); merge_phase(p, c, l); }
        xcd_barrier(bar);
        if (PH(7)) {
            pg8::SchedPlain S{(const char*)(ws + WS_WOUT) + (size_t)l * 1024 * 1024 * 2, DM * 2, 1024 * 2, 128, 4, c.G, bx};
            pg8::EpiResid E{xin, l == 0, RS};
            pg8::gemm_phase<pg8::EpiResid, pg8::SchedPlain, true>(c, (const char*)Y, 1024, S, E);
        }
        xcd_barrier(bar);
        if (l == 0) {
            if (PH(8)) rmsnorm_phase<false>(p, c, RS, 0, p.in[I_N2G], H, nullptr, nullptr);
            xcd_barrier(bar);
            if (PH(9)) for (int rep = 0; rep < REPS(9); ++rep) {
                if (rep) xcd_barrier(bar);
                pg8::SchedPlain S{(const char*)(ws + WS_WGUD), DM * 2, 1024 * 2, 128, 16, c.G, bx};
                pg8::EpiSwiglu E{PROJ, 2048};
                pg8::gemm_phase<pg8::EpiSwiglu, pg8::SchedPlain, true>(c, (const char*)H, 1024, S, E);
            }
            xcd_barrier(bar);
            if (PH(10)) {
                pg8::SchedPlain S{(const char*)(ws + WS_WDD), 2048 * 2, 2048 * 2, 128, 4, c.G, bx};
                pg8::EpiResid E{RS, 0, RS};
                pg8::gemm_phase<pg8::EpiResid, pg8::SchedPlain, true>(c, (const char*)PROJ, 2048, S, E);
            }
            xcd_barrier(bar);
        } else {
            if (PH(11)) rmsnorm_phase<true>(p, c, RS, 0, p.in[I_N2G] + DM, H, p.in[I_WR], p.in[I_BR]);
            xcd_barrier(bar);
            pg8::MoeInfo mi; mi.load((const unsigned*)(ws + WS_CTL));
            if (PH(12)) {
                const int U = mi.ts[16] * 6, T0 = __builtin_amdgcn_readfirstlane(U % c.G), hv = (T0 > 0 && 2 * T0 <= c.G) ? 1 : 0, Uf = hv ? U - T0 : U;
                pg8::EpiSwigluMoe E{mi, PROJ, (const float*)(ws + WS_MW)};
                if (Uf > 0) {
                    pg8::SchedMoeUp S{mi, (const char*)(ws + WS_WGUE), (const int*)(ws + WS_MTOK), 2048, c.G, bx, 0, Uf, 0};
                    pg8::gemm_phase<pg8::EpiSwigluMoe, pg8::SchedMoeUp, true>(c, (const char*)H, 1024, S, E);
                }
                if (hv) {
                    pg8::SchedMoeUp S{mi, (const char*)(ws + WS_WGUE), (const int*)(ws + WS_MTOK), 2048, c.G, bx, Uf, T0, 1};
                    pg8::gemm_phase<pg8::EpiSwigluMoe, pg8::SchedMoeUp, true, 1>(c, (const char*)H, 1024, S, E);
                }
            }
            xcd_barrier(bar);
#pragma unroll 1
            for (int k = 0; k < 2; ++k) {
                if (k) xcd_barrier(bar);
                const int r0 = k ? mi.ts[8] : mi.ts[0], nMk = (k ? mi.ts[16] : mi.ts[8]) - r0, U = nMk * 4;
                const int T0 = __builtin_amdgcn_readfirstlane(U % c.G), nsub = T0 == 0 ? 1 : (4 * T0 <= c.G ? 4 : (2 * T0 <= c.G ? 2 : 1)), Uf = nsub == 1 ? U : U - T0;
                pg8::EpiMoeDown E{mi, k ? (const bf16_t*)H : (const bf16_t*)RS, k ? (void*)p.out : (void*)H, k, (const int*)(ws + WS_MTOK)};
                if (Uf > 0) {
                    pg8::SchedMoeDown S{mi, (const char*)(ws + WS_WDE), 1536, r0, nMk, c.G, bx, 0, Uf, 0};
                    pg8::gemm_phase<pg8::EpiMoeDown, pg8::SchedMoeDown, true>(c, (const char*)PROJ, 768, S, E);
                }
                if (nsub == 4) {
                    pg8::SchedMoeDown S{mi, (const char*)(ws + WS_WDE), 1536, r0, nMk, c.G, bx, Uf, T0, 2};
                    pg8::gemm_phase<pg8::EpiMoeDown, pg8::SchedMoeDown, true, 2>(c, (const char*)PROJ, 768, S, E);
                } else if (nsub == 2) {
                    pg8::SchedMoeDown S{mi, (const char*)(ws + WS_WDE), 1536, r0, nMk, c.G, bx, Uf, T0, 1};
                    pg8::gemm_phase<pg8::EpiMoeDown, pg8::SchedMoeDown, true, 1>(c, (const char*)PROJ, 768, S, E);
                }
            }
        }
    }
}

extern "C" void kernel_launch(void* const* d_in, const int* in_sizes, int n_in, void* d_out, int out_size, void* d_ws, size_t ws_size, hipStream_t stream) {
    static int grid = 0;
    if (grid == 0) {
        if (n_in != 24 || ws_size < WS_END) { fprintf(stderr, "kernel_launch: unexpected inputs (n_in %d, ws %zu)\n", n_in, ws_size); grid = -1; return; }
        int dev = 0, cus = 0, per_cu = 0;
        hipGetDevice(&dev); hipDeviceGetAttribute(&cus, hipDeviceAttributeMultiprocessorCount, dev);
        hipFuncSetAttribute((const void*)fwd_kernel, hipFuncAttributeMaxDynamicSharedMemorySize, LDS_BYTES);
        hipOccupancyMaxActiveBlocksPerMultiprocessor(&per_cu, (const void*)fwd_kernel, NWG_THREADS, LDS_BYTES);
        (void)hipGetLastError();
        grid = cus;
    }
    if (grid < 0) return;
    hipMemsetAsync((char*)d_ws + WS_CTL, 0, CTL_BYTES, stream);
    Params p{};
    for (int i = 0; i < 24; ++i) p.in[i] = (const float*)d_in[i];
    p.out = (float*)d_out; p.ws = (unsigned char*)d_ws;
    hipLaunchKernelGGL(fwd_kernel, dim3(grid), dim3(NWG_THREADS), LDS_BYTES, stream, p);
}
```
